# Optimizing an MI355X kernel written in HIP

```python
import math
import jax, jax.numpy as jnp
from jax import lax
import numpy as np

D_MODEL = 1024
BATCH = 8
SEQ = 8192
DEPTH = 1

CHUNK = 64
EPS = 1e-6
MLSTM_WIDTH = D_MODEL // 2
MLSTM_HEAD_DIM = 128
MLSTM_HEADS = MLSTM_WIDTH // MLSTM_HEAD_DIM
CONV_WIDTH = 4
S5_WIDTH = D_MODEL - MLSTM_WIDTH
S5_GROUP_CH = 16
S5_GROUPS = S5_WIDTH // S5_GROUP_CH
S5_STATE = 64
MIX_WIDTH = MLSTM_WIDTH + S5_WIDTH
N_PROJ = 4 * MLSTM_WIDTH + 2 * MLSTM_HEADS + S5_WIDTH
N_EXPERTS = 32
TOP_K = 4
D_FF = D_MODEL
SWIGLU_LIMIT = 7.0
SWIGLU_ALPHA = 1.702
BLK = 512

kernel_name = "hybrid_mlstm_s5_moe_layer"


def rms_norm(x, g):
    xf = x.astype(jnp.float32)
    y = xf * lax.rsqrt(jnp.mean(xf * xf, axis=-1, keepdims=True) + EPS)
    return (y * g.astype(jnp.float32)).astype(x.dtype)


def causal_conv(x, w, b):
    L = x.shape[1]
    xp = jnp.pad(x, ((0, 0), (CONV_WIDTH - 1, 0), (0, 0)))
    out = b
    for j in range(CONV_WIDTH):
        out = out + xp[:, j:j + L] * w[j]
    return out


def mlstm_chunkwise(q, k, v, ig, fg):
    Bt, L, H, dh = q.shape
    nc = L // CHUNK

    def to_chunks(t):
        return t.astype(jnp.float32).reshape(Bt, nc, CHUNK, H, -1).transpose(1, 0, 3, 2, 4)

    qc, kc, vc = to_chunks(q), to_chunks(k) * (dh ** -0.5), to_chunks(v)
    ic = ig.astype(jnp.float32).reshape(Bt, nc, CHUNK, H).transpose(1, 0, 3, 2)
    logf = jax.nn.log_sigmoid(fg.astype(jnp.float32)).reshape(Bt, nc, CHUNK, H).transpose(1, 0, 3, 2)
    bc = jnp.cumsum(logf, axis=-1)
    mask = jnp.tril(jnp.ones((CHUNK, CHUNK), dtype=bool))

    def step(carry, xs):
        C, n, m = carry
        qb, kb, vb, ib, bb = xs
        dlog = bb[..., :, None] - bb[..., None, :] + ib[..., None, :]
        dlog = jnp.where(mask, dlog, -jnp.inf)
        inter = bb + m[..., None]
        m_t = jnp.maximum(jnp.max(dlog, axis=-1), inter)
        s = jnp.einsum('bhtd,bhsd->bhts', qb, kb) * jnp.exp(dlog - m_t[..., None])
        sc = jnp.exp(inter - m_t)
        num = jnp.einsum('bhts,bhsd->bhtd', s, vb) + sc[..., None] * jnp.einsum('bhvk,bhtk->bhtv', C, qb)
        den = jnp.sum(s, axis=-1) + sc * jnp.einsum('bhk,bhtk->bht', n, qb)
        h = num / jnp.maximum(jnp.abs(den), jnp.exp(-m_t))[..., None]
        g = bb[..., -1]
        wlog = g[..., None] - bb + ib
        m_new = jnp.maximum(g + m, jnp.max(wlog, axis=-1))
        wk = jnp.exp(wlog - m_new[..., None])
        decay = jnp.exp(g + m - m_new)
        C_new = decay[..., None, None] * C + jnp.einsum('bhs,bhsv,bhsk->bhvk', wk, vb, kb)
        n_new = decay[..., None] * n + jnp.einsum('bhs,bhsk->bhk', wk, kb)
        return (C_new, n_new, m_new), h

    init = (jnp.zeros((Bt, H, dh, dh), jnp.float32), jnp.zeros((Bt, H, dh), jnp.float32),
            jnp.zeros((Bt, H), jnp.float32))
    _, hs = lax.scan(step, init, (qc, kc, vc, ic, bc))
    return hs.transpose(1, 0, 3, 2, 4).reshape(Bt, L, H, dh)


def _lin_rec(e1, e2):
    a1, b1 = e1
    a2, b2 = e2
    return a2 * a1, a2 * b1 + b2


def s5_group(u, lam_re, lam_im, log_dt, b_re, b_im, c_re, c_im, d_skip, w_glu, b_glu):
    Bt, L, _ = u.shape
    f32 = jnp.float32
    uf = u.astype(f32)
    lam = lax.complex(lam_re.astype(f32), lam_im.astype(f32))
    dt = jnp.exp(log_dt.astype(f32))
    lam_bar = jnp.exp(lam * dt[:, None])
    b_bar = ((lam_bar - 1.0) / lam)[:, :, None] * lax.complex(b_re.astype(f32), b_im.astype(f32))
    c = lax.complex(c_re.astype(f32), c_im.astype(f32))
    ug = uf.reshape(Bt, L, S5_GROUPS, S5_GROUP_CH).astype(jnp.complex64)
    bu = jnp.einsum('gph,blgh->blgp', b_bar, ug)
    a = jnp.broadcast_to(lam_bar, (1, L, S5_GROUPS, S5_STATE))
    _, states = lax.associative_scan(_lin_rec, (a, bu), axis=1)
    y = jnp.einsum('ghp,blgp->blgh', c, states).real.reshape(Bt, L, S5_WIDTH) + d_skip.astype(f32) * uf
    y = jax.nn.gelu(y)
    y = y * jax.nn.sigmoid(y @ w_glu.astype(f32) + b_glu.astype(f32))
    return y.astype(u.dtype)


def moe(h, w_router, b_router, w_gu, b_gu, w_down, b_down):
    Bt, L, D = h.shape
    T = Bt * L
    TK = T * TOP_K
    xf = h.reshape(T, D)
    logits = (xf @ w_router + b_router).astype(jnp.float32)
    top_v, top_i = lax.top_k(logits, TOP_K)
    gates = jax.nn.softmax(top_v, axis=-1)
    flat_e = top_i.reshape(TK).astype(jnp.int32)
    flat_tok = jnp.arange(TK, dtype=jnp.int32) // TOP_K
    flat_g = gates.reshape(TK)
    order = jnp.argsort(flat_e)
    sorted_e = flat_e[order]
    counts = jnp.bincount(flat_e, length=N_EXPERTS).astype(jnp.int32)
    padded = ((counts + BLK - 1) // BLK) * BLK
    pad_end = jnp.cumsum(padded)
    pad_start = pad_end - padded
    start = jnp.cumsum(counts) - counts
    dest = pad_start[sorted_e] + (jnp.arange(TK, dtype=jnp.int32) - start[sorted_e])
    n_blocks = -(-TK // BLK) + N_EXPERTS
    R = n_blocks * BLK
    row_tok = jnp.full((R,), T, jnp.int32).at[dest].set(flat_tok[order])
    row_gate = jnp.zeros((R,), jnp.float32).at[dest].set(flat_g[order])
    block_start = jnp.arange(n_blocks, dtype=jnp.int32) * BLK
    block_e = jnp.minimum(jnp.sum(pad_end[None, :] <= block_start[:, None], axis=1), N_EXPERTS - 1)
    xpad = jnp.concatenate([xf, jnp.zeros((1, D), xf.dtype)], axis=0)
    xb = xpad[row_tok].reshape(n_blocks, BLK, D)

    def expert_block(args):
        xblk, e = args
        gu = xblk @ w_gu[e] + b_gu[e]
        gate, up = gu[:, :D_FF], gu[:, D_FF:]
        gate = jnp.minimum(gate, SWIGLU_LIMIT)
        up = jnp.clip(up, -SWIGLU_LIMIT, SWIGLU_LIMIT)
        glu = gate * jax.nn.sigmoid(SWIGLU_ALPHA * gate)
        return ((up + 1.0) * glu) @ w_down[e] + b_down[e]

    yb = lax.map(expert_block, (xb, block_e))
    y = yb.reshape(R, D) * row_gate[:, None].astype(yb.dtype)
    out = jax.ops.segment_sum(y, row_tok, num_segments=T + 1)[:T]
    return out.reshape(Bt, L, D)


def mixer(h, w_in, b_if, conv_w, conv_b, head_norm_g, lam_re, lam_im, log_dt,
          b_re, b_im, c_re, c_im, d_skip, w_glu, b_glu, w_out):
    Bt, L, _ = h.shape
    proj = h @ w_in
    W = MLSTM_WIDTH
    qk_pre = proj[..., :2 * W]
    v = proj[..., 2 * W:3 * W]
    o_pre = proj[..., 3 * W:4 * W]
    if_pre = proj[..., 4 * W:4 * W + 2 * MLSTM_HEADS]
    u = proj[..., 4 * W + 2 * MLSTM_HEADS:]
    qk = jax.nn.silu(causal_conv(qk_pre, conv_w, conv_b))
    q, k = qk[..., :W], qk[..., W:]
    gates = if_pre.astype(jnp.float32) + b_if.astype(jnp.float32)
    ig, fg = gates[..., :MLSTM_HEADS], gates[..., MLSTM_HEADS:]
    shp = (Bt, L, MLSTM_HEADS, MLSTM_HEAD_DIM)
    hm = mlstm_chunkwise(q.reshape(shp), k.reshape(shp), v.reshape(shp), ig, fg)
    hm = hm * lax.rsqrt(jnp.mean(hm * hm, axis=-1, keepdims=True) + EPS)
    hm = hm.reshape(Bt, L, W) * head_norm_g.astype(jnp.float32)
    hm = (jax.nn.sigmoid(o_pre.astype(jnp.float32)) * hm).astype(h.dtype)
    ys = s5_group(u, lam_re, lam_im, log_dt, b_re, b_im, c_re, c_im, d_skip, w_glu, b_glu)
    return jnp.concatenate([hm, ys], axis=-1) @ w_out


def setup_inputs(seed: int = 0) -> dict:
    key = jax.random.key(seed)
    ks = iter(jax.random.split(key, 32))
    nrm = lambda shape, s: jax.random.normal(next(ks), shape, jnp.float32) * s
    Dp = DEPTH
    lam_im0 = jnp.broadcast_to(jnp.pi * jnp.arange(S5_STATE, dtype=jnp.float32), (Dp, S5_GROUPS, S5_STATE))
    b_f = jnp.broadcast_to(jnp.linspace(3.0, 6.0, MLSTM_HEADS, dtype=jnp.float32), (Dp, MLSTM_HEADS))
    return {
        "x": nrm((BATCH, SEQ, D_MODEL), 1.0),
        "norm1_g": 1.0 + nrm((Dp, D_MODEL), 0.02),
        "w_in": nrm((Dp, D_MODEL, N_PROJ), D_MODEL ** -0.5),
        "b_if": jnp.concatenate([nrm((Dp, MLSTM_HEADS), 0.1), b_f + nrm((Dp, MLSTM_HEADS), 0.1)], axis=-1),
        "conv_w": nrm((Dp, CONV_WIDTH, 2 * MLSTM_WIDTH), CONV_WIDTH ** -0.5),
        "conv_b": nrm((Dp, 2 * MLSTM_WIDTH), 0.01),
        "head_norm_g": 1.0 + nrm((Dp, MLSTM_WIDTH), 0.02),
        "lam_re": -0.5 + nrm((Dp, S5_GROUPS, S5_STATE), 0.01),
        "lam_im": lam_im0 + nrm((Dp, S5_GROUPS, S5_STATE), 0.01),
        "log_dt": jax.random.uniform(next(ks), (Dp, S5_GROUPS), jnp.float32, math.log(1e-3), math.log(1e-1)),
        "b_re": nrm((Dp, S5_GROUPS, S5_STATE, S5_GROUP_CH), (2 * S5_GROUP_CH) ** -0.5),
        "b_im": nrm((Dp, S5_GROUPS, S5_STATE, S5_GROUP_CH), (2 * S5_GROUP_CH) ** -0.5),
        "c_re": nrm((Dp, S5_GROUPS, S5_GROUP_CH, S5_STATE), S5_STATE ** -0.5),
        "c_im": nrm((Dp, S5_GROUPS, S5_GROUP_CH, S5_STATE), S5_STATE ** -0.5),
        "d_skip": nrm((Dp, S5_WIDTH), 1.0),
        "w_glu": nrm((Dp, S5_WIDTH, S5_WIDTH), S5_WIDTH ** -0.5),
        "b_glu": nrm((Dp, S5_WIDTH), 0.01),
        "w_out": nrm((Dp, MIX_WIDTH, D_MODEL), MIX_WIDTH ** -0.5),
        "norm2_g": 1.0 + nrm((Dp, D_MODEL), 0.02),
        "w_router": nrm((Dp, D_MODEL, N_EXPERTS), D_MODEL ** -0.5),
        "b_router": nrm((Dp, N_EXPERTS), 0.01),
        "w_gate_up": nrm((Dp, N_EXPERTS, D_MODEL, 2 * D_FF), D_MODEL ** -0.5),
        "b_gate_up": nrm((Dp, N_EXPERTS, 2 * D_FF), 0.01),
        "w_down": nrm((Dp, N_EXPERTS, D_FF, D_MODEL), D_FF ** -0.5),
        "b_down": nrm((Dp, N_EXPERTS, D_MODEL), 0.01),
        "norm_f_g": 1.0 + nrm((D_MODEL,), 0.02),
    }


def reference(x, norm1_g, w_in, b_if, conv_w, conv_b, head_norm_g, lam_re, lam_im, log_dt,
              b_re, b_im, c_re, c_im, d_skip, w_glu, b_glu, w_out, norm2_g, w_router, b_router,
              w_gate_up, b_gate_up, w_down, b_down, norm_f_g):
    for l in range(DEPTH):
        h = rms_norm(x, norm1_g[l])
        x = x + mixer(h, w_in[l], b_if[l], conv_w[l], conv_b[l], head_norm_g[l], lam_re[l], lam_im[l],
                      log_dt[l], b_re[l], b_im[l], c_re[l], c_im[l], d_skip[l], w_glu[l], b_glu[l], w_out[l])
        h = rms_norm(x, norm2_g[l])
        x = x + moe(h, w_router[l], b_router[l], w_gate_up[l], b_gate_up[l], w_down[l], b_down[l])
    return rms_norm(x, norm_f_g)
```

```cpp
#include <hip/hip_runtime.h>
#include <hip/hip_cooperative_groups.h>
#include <cstdio>
#include <cstdint>
namespace cg = cooperative_groups;
__device__ __forceinline__ int otid() { int t = (int)threadIdx.x; asm volatile("" : "+v"(t)); return t; }

namespace pg8 {
#define PG8_LAS __attribute__((address_space(3)))
typedef unsigned short bf16_t;
typedef short bf16x8 __attribute__((ext_vector_type(8)));
typedef float f32x4 __attribute__((ext_vector_type(4)));
typedef unsigned u32x4 __attribute__((ext_vector_type(4)));
constexpr int BM = 256, BK = 64, HALF = 128, HTB = HALF * BK * 2  , STAGE_BYTES = 8 * HTB, NXCD = 8, WGM = 8;

__host__ __device__ __forceinline__ int lds_byte(int r, int c) { const int st = (r >> 4) * 2 + (c >> 5), rr = r & 15, cc = c & 31, ob = rr * 64 + cc * 2; return st * 1024 + (ob ^ (((ob >> 9) & 1) << 5)); }
__host__ __device__ __forceinline__ void stage_rc(int b, int& R, int& C) { const int st = b / 1024, sb = b % 1024, swz = sb ^ (((sb >> 9) & 1) << 5); R = (st >> 1) * 16 + swz / 64; C = (st & 1) * 32 + (swz % 64) / 2; }
__host__ __device__ __forceinline__ int perm32(int rho) { const int n = rho >> 4, i = rho & 15; return 8 * (i >> 2) + 4 * n + (i & 3); }

struct Unit { int pm, pn; };
struct Gemm { const bf16_t* A; const bf16_t* Bt; int lda, ldb, K; };

struct StaticOrder {
    int nM, nN, nwg, G, c;
    __host__ __device__ void init(int M, int N, int G_, int c_) { nM = M / BM; nN = N / BM; nwg = nM * nN; G = G_; c = c_; }
    __host__ __device__ bool next(int i, Unit& u) const {
        const long L = (long)i * G + c; if (L >= nwg) return false;
        int wgid = (int)L; { const int q = nwg / NXCD, r = nwg % NXCD, xcd = wgid % NXCD, off = wgid / NXCD; wgid = (xcd < r ? xcd * (q + 1) : r * (q + 1) + (xcd - r) * q) + off; }
        const int nig = WGM * nN, gid = wgid / nig, fm = gid * WGM, gsz = (nM - fm) < WGM ? (nM - fm) : WGM;
        u.pm = fm + ((wgid % nig) % gsz); u.pn = (wgid % nig) / gsz; return true;
    }
    __device__ __forceinline__ void a_ready(const Unit&) const {}
    __device__ __forceinline__ void done(const Unit&) const {}
};

__device__ __forceinline__ unsigned cvt_pk_bf16(float lo, float hi) { unsigned r; asm volatile("v_cvt_pk_bf16_f32 %0, %1, %2" : "=v"(r) : "v"(lo), "v"(hi)); return r; }

template <class Epi, class Sched, bool ALIGN_EPI = false, bool SP2 = false>
__device__ __forceinline__ void gemm_phase(PG8_LAS unsigned char* lds, const Gemm g, const Sched& S, const Epi& E) {
    const int tid = otid(), wid = __builtin_amdgcn_readfirstlane(tid >> 6), lane = tid & 63, wr = wid >> 2, wc = wid & 3, fr = lane & 15, fq = lane >> 4;
    const int K = g.K, nt = K / BK;
    unsigned voffA[2], voffB[2];
#pragma unroll
    for (int i = 0; i < 2; ++i) { int R, C; stage_rc(tid * 16 + i * 8192, R, C); const int Rb = Epi::PERM ? ((R & ~31) + perm32(R & 31)) : R;
        voffA[i] = (unsigned)(R * g.lda + C) * 2u; voffB[i] = (unsigned)(Rb * g.ldb + C) * 2u; }
    const size_t kstep = (size_t)(BK * 2);
    const size_t hstepA = (size_t)HALF * g.lda * 2, hstepB = (size_t)HALF * g.ldb * 2;
    const size_t tstepA = 2 * hstepA, tstepB = 2 * hstepB;
    const unsigned ldsw = (unsigned)wid * 1024u;
    const int aoff = lds_byte(wr * 64 + fr, fq * 8), boff = lds_byte(wc * 32 + fr, fq * 8);
#define PG8_SA(b, h) (((b) * 2 + (h)) * HTB)
#define PG8_SB(b, h) ((4 + (b) * 2 + (h)) * HTB)
#define PG8_STAGE(bufoff, gbase, voff) do { _Pragma("unroll") for (int _i = 0; _i < 2; ++_i) \
        __builtin_amdgcn_global_load_lds((const unsigned*)((const char*)(gbase) + (voff)[_i]), (PG8_LAS unsigned*)(lds + (bufoff) + ldsw + _i * 8192), 16, 0, 0); } while (0)
#define PG8_LDA(dst, b, h) do { _Pragma("unroll") for (int m = 0; m < 4; ++m) _Pragma("unroll") for (int k = 0; k < 2; ++k) dst[m][k] = *(const PG8_LAS bf16x8*)(lds + PG8_SA(b, h) + aoff + m * 2048 + k * 1024); } while (0)
#define PG8_LDB(dst, b, h) do { _Pragma("unroll") for (int n = 0; n < 2; ++n) _Pragma("unroll") for (int k = 0; k < 2; ++k) dst[n][k] = *(const PG8_LAS bf16x8*)(lds + PG8_SB(b, h) + boff + n * 2048 + k * 1024); } while (0)
#define PG8_MMA(ai, bj, At, Bt) do { __builtin_amdgcn_s_setprio(1); _Pragma("unroll") for (int m = 0; m < 4; ++m) _Pragma("unroll") for (int n = 0; n < 2; ++n) _Pragma("unroll") for (int k = 0; k < 2; ++k) \
        acc[ai][bj][m][n] = __builtin_amdgcn_mfma_f32_16x16x32_bf16(Bt[n][k], At[m][k], acc[ai][bj][m][n], 0, 0, 0); __builtin_amdgcn_s_setprio(0); } while (0)
#define PG8_WAIT_V(n) asm volatile("s_waitcnt vmcnt(" #n ")" ::: "memory")
#define PG8_WAIT_L(n) asm volatile("s_waitcnt lgkmcnt(" #n ")" ::: "memory")
#define PG8_BAR __builtin_amdgcn_s_barrier()
#define PG8_SCHED __builtin_amdgcn_sched_barrier(0)
    Unit cur, nxt; int ui = 0;
    if (!S.next(0, cur)) return;
    f32x4 acc[2][2][4][2];
#pragma unroll
    for (int a = 0; a < 2; ++a)
#pragma unroll
        for (int b = 0; b < 2; ++b)
#pragma unroll
            for (int m = 0; m < 4; ++m)
#pragma unroll
                for (int n = 0; n < 2; ++n) acc[a][b][m][n] = (f32x4){0.f, 0.f, 0.f, 0.f};
    bf16x8 At[4][2], B0[2][2], B1[2][2];
    const char* cA = (const char*)g.A + (size_t)cur.pm * tstepA; const char* cB = (const char*)g.Bt + (size_t)cur.pn * tstepB;
    S.a_ready(cur);
    if constexpr (SP2) {
        PG8_STAGE(PG8_SB(0, 0), cB, voffB); PG8_STAGE(PG8_SB(0, 1), cB + hstepB, voffB); PG8_STAGE(PG8_SA(0, 0), cA, voffA); PG8_STAGE(PG8_SA(0, 1), cA + hstepA, voffA);
        if (wr == 1) PG8_BAR;
        PG8_WAIT_V(2); PG8_BAR;
        PG8_STAGE(PG8_SB(1, 0), cB + kstep, voffB); PG8_STAGE(PG8_SA(1, 0), cA + kstep, voffA); PG8_STAGE(PG8_SB(1, 1), cB + hstepB + kstep, voffB);
        PG8_WAIT_V(6); PG8_BAR;
    } else {
        PG8_STAGE(PG8_SB(0, 0), cB, voffB); PG8_STAGE(PG8_SA(0, 0), cA, voffA); PG8_STAGE(PG8_SB(0, 1), cB + hstepB, voffB); PG8_STAGE(PG8_SA(0, 1), cA + hstepA, voffA);
        if (wr == 1) PG8_BAR;
        PG8_WAIT_V(4); PG8_BAR;
        PG8_STAGE(PG8_SB(1, 0), cB + kstep, voffB); PG8_STAGE(PG8_SA(1, 0), cA + kstep, voffA); PG8_STAGE(PG8_SB(1, 1), cB + hstepB + kstep, voffB);
        PG8_WAIT_V(6); PG8_BAR;
    }
    for (;;) {
        const bool has_next = S.next(ui + 1, nxt);
        const char* nA = has_next ? (const char*)g.A + (size_t)nxt.pm * tstepA : cA; const char* nB = has_next ? (const char*)g.Bt + (size_t)nxt.pn * tstepB : cB;
        for (int t = 0; t < nt; t += 2) {
            const bool last = (t == nt - 2);
            const char* a1 = cA + (size_t)(t + 1) * kstep;
            const char* a2 = last ? nA : cA + (size_t)(t + 2) * kstep; const char* b2 = last ? nB : cB + (size_t)(t + 2) * kstep;
            const char* a3 = a2 + kstep; const char* b3 = b2 + kstep;
            if (last && has_next) S.a_ready(nxt);
            if constexpr (SP2) {
            PG8_LDB(B0, 0, 0); PG8_LDB(B1, 0, 1); PG8_SCHED; PG8_LDA(At, 0, 0); PG8_STAGE(PG8_SA(1, 1), a1 + hstepA, voffA);
            PG8_WAIT_V(8); PG8_WAIT_L(0); PG8_BAR; PG8_MMA(0, 0, At, B0); PG8_MMA(0, 1, At, B1); PG8_BAR; PG8_SCHED;
            PG8_LDA(At, 0, 1); PG8_STAGE(PG8_SB(0, 0), b2, voffB); PG8_STAGE(PG8_SB(0, 1), b2 + hstepB, voffB); PG8_STAGE(PG8_SA(0, 0), a2, voffA);
            PG8_WAIT_V(8); PG8_WAIT_L(0); PG8_BAR; PG8_MMA(1, 0, At, B0); PG8_MMA(1, 1, At, B1); PG8_BAR; PG8_SCHED;
            PG8_LDB(B0, 1, 0); PG8_LDB(B1, 1, 1); PG8_SCHED; PG8_LDA(At, 1, 0); PG8_STAGE(PG8_SA(0, 1), a2 + hstepA, voffA);
            PG8_WAIT_V(8); PG8_WAIT_L(0); PG8_BAR; PG8_MMA(0, 0, At, B0); PG8_MMA(0, 1, At, B1); PG8_BAR; PG8_SCHED;
            PG8_LDA(At, 1, 1); PG8_STAGE(PG8_SB(1, 0), b3, voffB); PG8_STAGE(PG8_SB(1, 1), b3 + hstepB, voffB); PG8_STAGE(PG8_SA(1, 0), a3, voffA);
            PG8_WAIT_V(8); PG8_WAIT_L(0); PG8_BAR; PG8_MMA(1, 0, At, B0); PG8_MMA(1, 1, At, B1); PG8_BAR; PG8_SCHED;
            } else {
            PG8_LDB(B0, 0, 0); PG8_SCHED; PG8_LDA(At, 0, 0); PG8_STAGE(PG8_SA(1, 1), a1 + hstepA, voffA);
            PG8_WAIT_L(8); PG8_BAR; PG8_WAIT_L(0); PG8_MMA(0, 0, At, B0); PG8_BAR; PG8_SCHED;
            PG8_LDB(B1, 0, 1); PG8_STAGE(PG8_SB(0, 0), b2, voffB);
            PG8_BAR; PG8_WAIT_L(0); PG8_MMA(0, 1, At, B1); PG8_BAR;
            PG8_LDA(At, 0, 1); PG8_STAGE(PG8_SA(0, 0), a2, voffA);
            PG8_BAR; PG8_WAIT_L(0); PG8_MMA(1, 0, At, B0); PG8_BAR; PG8_SCHED;
            PG8_STAGE(PG8_SB(0, 1), b2 + hstepB, voffB);
            PG8_WAIT_V(6); PG8_BAR; PG8_MMA(1, 1, At, B1); PG8_BAR;
            PG8_LDB(B0, 1, 0); PG8_SCHED; PG8_LDA(At, 1, 0); PG8_STAGE(PG8_SA(0, 1), a2 + hstepA, voffA);
            PG8_WAIT_L(8); PG8_BAR; PG8_WAIT_L(0); PG8_MMA(0, 0, At, B0); PG8_BAR; PG8_SCHED;
            PG8_LDB(B1, 1, 1); PG8_STAGE(PG8_SB(1, 0), b3, voffB);
            PG8_BAR; PG8_WAIT_L(0); PG8_MMA(0, 1, At, B1); PG8_BAR;
            PG8_LDA(At, 1, 1); PG8_STAGE(PG8_SA(1, 0), a3, voffA);
            PG8_BAR; PG8_WAIT_L(0); PG8_MMA(1, 0, At, B0); PG8_BAR; PG8_SCHED;
            PG8_STAGE(PG8_SB(1, 1), b3 + hstepB, voffB);
            PG8_WAIT_V(6); PG8_BAR; PG8_MMA(1, 1, At, B1); PG8_BAR;
            }
        }
        if constexpr (ALIGN_EPI) { if (wr == 0) PG8_BAR; }
        E(acc, cur, wr, wc, fr, fq); S.done(cur);
        if (!has_next) break;
#pragma unroll
        for (int a = 0; a < 2; ++a)
#pragma unroll
            for (int b = 0; b < 2; ++b)
#pragma unroll
                for (int m = 0; m < 4; ++m)
#pragma unroll
                    for (int n = 0; n < 2; ++n) acc[a][b][m][n] = (f32x4){0.f, 0.f, 0.f, 0.f};
        cur = nxt; cA = nA; cB = nB; ++ui;
        if constexpr (ALIGN_EPI) { if (wr == 1) PG8_BAR; }
    }
    PG8_WAIT_V(0);
    if constexpr (!ALIGN_EPI) { if (wr == 0) PG8_BAR; }
    PG8_BAR;
#undef PG8_SA
#undef PG8_SB
#undef PG8_STAGE
#undef PG8_LDA
#undef PG8_LDB
#undef PG8_MMA
#undef PG8_WAIT_V
#undef PG8_WAIT_L
#undef PG8_BAR
#undef PG8_SCHED
}
}

#define LAS __attribute__((address_space(3)))
typedef unsigned short bf16;
typedef float f4 __attribute__((ext_vector_type(4)));
typedef float f2 __attribute__((ext_vector_type(2)));
typedef float f32x16 __attribute__((ext_vector_type(16)));
typedef short bf16x8 __attribute__((ext_vector_type(8)));
typedef unsigned v4u __attribute__((ext_vector_type(4)));
typedef unsigned v2u __attribute__((ext_vector_type(2)));

constexpr int T = 65536, DM = 1024, SEQ = 8192, NPROJ = 2568;
constexpr int NE = 32;
constexpr float EPS = 1e-6f;
constexpr int NPH = 15;
constexpr int RCAP = 139264;
constexpr int LDS_BYTES = 155648;

constexpr size_t MiB = (size_t)1 << 20;
constexpr size_t OFF_GATES = 1 * MiB, OFF_MLG = 3 * MiB, OFF_MLA = 3 * MiB + 16384, OFF_MLM = 3 * MiB + 32768;
constexpr size_t OFF_MLNP = 4 * MiB, OFF_MLN = 6 * MiB, OFF_KT = 8 * MiB, OFF_S5E = 10 * MiB, OFF_RSTD2 = 26 * MiB;
constexpr size_t OFF_ENTE = 27 * MiB, OFF_ENTG = 28 * MiB, OFF_ENTR = 29 * MiB, OFF_SDEST = 30 * MiB;
constexpr size_t OFF_CNT = 31 * MiB, OFF_TILEE = 31 * MiB + 65536, OFF_NTILE = 31 * MiB + 131072, OFF_RGATE = 32 * MiB;
constexpr size_t OFF_WIN = 64 * MiB, OFF_WGLU = 70 * MiB, OFF_WOUT = 71 * MiB, OFF_WGU = 74 * MiB, OFF_WDN = 202 * MiB;
constexpr size_t OFF_S5M = 266 * MiB, OFF_S5P = 338 * MiB, OFF_H1 = 354 * MiB, OFF_QK = 482 * MiB, OFF_V = 610 * MiB, OFF_O = 674 * MiB, OFF_UG = 738 * MiB, OFF_YSG = 810 * MiB;
constexpr size_t OFF_R1 = 266 * MiB, OFF_R2 = 538 * MiB, WS_NEED = 874 * MiB;
constexpr size_t OUT_UP = 0, OUT_CST = 134217728;

struct KArgs { const float* in[26]; float* out; unsigned char* ws; int ph_lo, ph_hi; };
enum { I_X = 0, I_N1G, I_WIN, I_BIF, I_CONVW, I_CONVB, I_HNG, I_LRE, I_LIM, I_LDT, I_BRE, I_BIM, I_CRE, I_CIM, I_DSKIP, I_WGLU, I_BGLU, I_WOUT, I_N2G, I_WR, I_BR, I_WGU, I_BGU, I_WDN, I_BDN, I_NFG };

__device__ __forceinline__ unsigned f2bf(float f) { unsigned u = __builtin_bit_cast(unsigned, f); return (u + 0x7fffu + ((u >> 16) & 1u)) >> 16; }
__device__ __forceinline__ unsigned pk2(float lo, float hi) { return f2bf(lo) | (f2bf(hi) << 16); }
__device__ __forceinline__ float bf2f(unsigned b) { return __builtin_bit_cast(float, b << 16); }
__device__ __forceinline__ float bflo(unsigned w) { return __builtin_bit_cast(float, w << 16); }
__device__ __forceinline__ float bfhi(unsigned w) { return __builtin_bit_cast(float, w & 0xffff0000u); }
__device__ __forceinline__ float wave_sum(float v) {
#pragma unroll
    for (int o = 1; o < 64; o <<= 1) v += __shfl_xor(v, o);
    return v;
}
__device__ __forceinline__ float wave_max(float v) {
#pragma unroll
    for (int o = 1; o < 64; o <<= 1) v = fmaxf(v, __shfl_xor(v, o));
    return v;
}
__device__ __forceinline__ float sigmoidf_(float x) { return 1.f / (1.f + __expf(-x)); }
__device__ __forceinline__ float siluf_(float x) { return x / (1.f + __expf(-x)); }
__device__ __forceinline__ float logsigmoidf_(float x) { return x >= 0.f ? -log1pf(expf(-x)) : x - log1pf(expf(x)); }
__device__ __forceinline__ float gelu_tanh(float x) { const float z = 0.7978845608028654f * (x + 0.044715f * x * x * x); const float e = __expf(2.f * z); return 0.5f * x * (2.f - 2.f / (e + 1.f)); }
#define LDS_WAIT() asm volatile("s_waitcnt lgkmcnt(0)" ::: "memory")

__device__ __forceinline__ void tr_item(const float* Wsrc, int ldw, bf16* WTdst, int ldt, int k0, LAS float* scr, int lane) {
#pragma unroll 8
    for (int i = 0; i < 32; ++i) { const int kk = 2 * i + (lane >> 5); scr[kk * 33 + (lane & 31)] = Wsrc[(size_t)(k0 + kk) * ldw + (lane & 31)]; }
    LDS_WAIT(); asm volatile("" ::: "memory");
    const int c = lane & 7;
#pragma unroll
    for (int j = 0; j < 4; ++j) { const int n = (lane >> 3) + 8 * j; const LAS float* s = scr + (8 * c) * 33 + n;
        v4u o; o.x = pk2(s[0 * 33], s[1 * 33]); o.y = pk2(s[2 * 33], s[3 * 33]); o.z = pk2(s[4 * 33], s[5 * 33]); o.w = pk2(s[6 * 33], s[7 * 33]);
        *(v4u*)(WTdst + (size_t)n * ldt + k0 + 8 * c) = o; }
    LDS_WAIT(); asm volatile("" ::: "memory");
}

__device__ __forceinline__ void lam_pow(float lre, float lim, float dt, int n, float& re, float& im) {
    const float mag = expf(lre * dt * (float)n);
    double th = (double)lim * (double)dt * (double)n;
    th -= 6.283185307179586476925 * rint(th * 0.15915494309189533577);
    float s, c; sincosf((float)th, &s, &c);
    re = mag * c; im = mag * s;
}

__device__ __forceinline__ void phase0(const KArgs& a, LAS unsigned char* L, int G) {
    const int tid = otid(), lane = tid & 63, wave = tid >> 6;
    const int gw = blockIdx.x * 8 + wave, NGW = G * 8;
    unsigned char* ws = a.ws;
    {
        LAS float* scr = (LAS float*)(L + wave * 8448);
        constexpr int N_IN = 16 * 80, N_GLU = 8 * 16, N_OUT = 16 * 32, N_GU = 32 * 16 * 64, N_DN = 32 * 16 * 32;
        constexpr int NITEMS = N_IN + N_GLU + N_OUT + N_GU + N_DN;
        for (int it = gw; it < NITEMS; it += NGW) {
            int r = it;
            if (r < N_IN) { const int kb = r / 80, nb = r % 80, n0 = 32 * nb, sc = n0 < 2048 ? n0 : n0 + 8;
                tr_item(a.in[I_WIN] + sc, NPROJ, (bf16*)(ws + OFF_WIN) + (size_t)n0 * 1024, 1024, 64 * kb, scr, lane); continue; } r -= N_IN;
            if (r < N_GLU) { const int kb = r / 16, nb = r % 16, n0 = 32 * nb;
                tr_item(a.in[I_WGLU] + n0, 512, (bf16*)(ws + OFF_WGLU) + (size_t)n0 * 512, 512, 64 * kb, scr, lane); continue; } r -= N_GLU;
            if (r < N_OUT) { const int kb = r / 32, nb = r % 32, n0 = 32 * nb;
                tr_item(a.in[I_WOUT] + n0, 1024, (bf16*)(ws + OFF_WOUT) + (size_t)n0 * 1024, 1024, 64 * kb, scr, lane); continue; } r -= N_OUT;
            if (r < N_GU) { const int e = r / 1024, q = r % 1024, kb = q / 64, nb = q % 64, n0 = 32 * nb, pn = n0 >> 8, wi = n0 & 255;
                const int sc = wi < 128 ? 128 * pn + wi : 1024 + 128 * pn + (wi - 128);
                tr_item(a.in[I_WGU] + (size_t)e * 1024 * 2048 + sc, 2048, (bf16*)(ws + OFF_WGU) + ((size_t)e * 2048 + n0) * 1024, 1024, 64 * kb, scr, lane); continue; } r -= N_GU;
            { const int e = r / 512, q = r % 512, kb = q / 32, nb = q % 32, n0 = 32 * nb;
                tr_item(a.in[I_WDN] + (size_t)e * 1024 * 1024 + n0, 1024, (bf16*)(ws + OFF_WDN) + ((size_t)e * 1024 + n0) * 1024, 1024, 64 * kb, scr, lane); }
        }
    }
    __syncthreads();
    {
        const float* lre = a.in[I_LRE]; const float* lim = a.in[I_LIM]; const float* ldt = a.in[I_LDT];
        const float* bre = a.in[I_BRE]; const float* bim = a.in[I_BIM]; const float* cre = a.in[I_CRE]; const float* cim = a.in[I_CIM];
        const int gt = blockIdx.x * 512 + tid, GT = G * 512;
        float* KT = (float*)(ws + OFF_KT);
        for (int task = gt; task < 32 * 64 * 16; task += GT) {
            const int g = task >> 10, tau = (task >> 4) & 63, i = task & 15;
            const float dt = expf(ldt[g]);
            float acc[16];
#pragma unroll
            for (int j = 0; j < 16; ++j) acc[j] = 0.f;
            for (int p = 0; p < 64; ++p) {
                const float lr = lre[g * 64 + p], li = lim[g * 64 + p];
                float pr, pi; lam_pow(lr, li, dt, tau, pr, pi);
                float l1r, l1i; lam_pow(lr, li, dt, 1, l1r, l1i);
                const float nr = l1r - 1.f, ni = l1i, den = lr * lr + li * li;
                const float fr = (nr * lr + ni * li) / den, fi = (ni * lr - nr * li) / den;
                const float cr = cre[(g * 16 + i) * 64 + p], ci = cim[(g * 16 + i) * 64 + p];
                const float zr = cr * pr - ci * pi, zi = cr * pi + ci * pr;
                const float yr = zr * fr - zi * fi, yi = zr * fi + zi * fr;
                const f4* br4 = (const f4*)(bre + (size_t)(g * 64 + p) * 16); const f4* bi4 = (const f4*)(bim + (size_t)(g * 64 + p) * 16);
#pragma unroll
                for (int q = 0; q < 4; ++q) { const f4 x = br4[q], y = bi4[q];
                    acc[4 * q + 0] += yr * x.x - yi * y.x; acc[4 * q + 1] += yr * x.y - yi * y.y; acc[4 * q + 2] += yr * x.z - yi * y.z; acc[4 * q + 3] += yr * x.w - yi * y.w; }
            }
            f4* o = (f4*)(KT + (size_t)task * 16);
#pragma unroll
            for (int q = 0; q < 4; ++q) o[q] = (f4){acc[4 * q], acc[4 * q + 1], acc[4 * q + 2], acc[4 * q + 3]};
        }
        bf16* S5P = (bf16*)(ws + OFF_S5P);
        for (int task = gt; task < 32 * 64 * 64; task += GT) {
            const int g = task >> 12, p = (task >> 6) & 63, s = task & 63;
            const float dt = expf(ldt[g]); const float lr = lre[g * 64 + p], li = lim[g * 64 + p];
            float pr, pi; lam_pow(lr, li, dt, 63 - s, pr, pi);
            float l1r, l1i; lam_pow(lr, li, dt, 1, l1r, l1i);
            const float nr = l1r - 1.f, ni = l1i, den = lr * lr + li * li;
            const float fr = (nr * lr + ni * li) / den, fi = (ni * lr - nr * li) / den;
            const float yr = pr * fr - pi * fi, yi = pr * fi + pi * fr;
            const float* br = bre + (size_t)(g * 64 + p) * 16; const float* bi = bim + (size_t)(g * 64 + p) * 16;
            unsigned ore[8], oim[8];
#pragma unroll
            for (int j = 0; j < 8; ++j) { const float x0 = br[2 * j], y0 = bi[2 * j], x1 = br[2 * j + 1], y1 = bi[2 * j + 1];
                ore[j] = pk2(yr * x0 - yi * y0, yr * x1 - yi * y1); oim[j] = pk2(yr * y0 + yi * x0, yr * y1 + yi * x1); }
            v4u* d0 = (v4u*)(S5P + ((size_t)(g * 256 + 2 * p) * 1024 + s * 16)); v4u* d1 = (v4u*)(S5P + ((size_t)(g * 256 + 2 * p + 1) * 1024 + s * 16));
            d0[0] = (v4u){ore[0], ore[1], ore[2], ore[3]}; d0[1] = (v4u){ore[4], ore[5], ore[6], ore[7]};
            d1[0] = (v4u){oim[0], oim[1], oim[2], oim[3]}; d1[1] = (v4u){oim[4], oim[5], oim[6], oim[7]};
        }
        for (int task = gt; task < 32 * 128 * 128; task += GT) {
            const int g = task >> 14, r = (task >> 7) & 127, c8 = task & 127;
            *(v4u*)(S5P + ((size_t)(g * 256 + 128 + r) * 1024 + c8 * 8)) = (v4u){0u, 0u, 0u, 0u};
        }
        bf16* S5M = (bf16*)(ws + OFF_S5M);
        for (int task = gt; task < 32 * 64 * 64; task += GT) {
            const int g = task >> 12, t = (task >> 6) & 63, p = task & 63;
            const float dt = expf(ldt[g]); const float lr = lre[g * 64 + p], li = lim[g * 64 + p];
            float pr, pi; lam_pow(lr, li, dt, t + 1, pr, pi);
#pragma unroll
            for (int i = 0; i < 16; ++i) { const float cr = cre[(g * 16 + i) * 64 + p], ci = cim[(g * 16 + i) * 64 + p];
                *(unsigned*)(S5M + ((size_t)(g * 1024 + t * 16 + i) * 1152 + 1024 + 2 * p)) = pk2(cr * pr - ci * pi, -(cr * pi + ci * pr)); }
        }
    }
    {
        LAS float* wif = (LAS float*)(L + 69632);
        const float* win = a.in[I_WIN];
        for (int idx = tid; idx < 8192; idx += 512) wif[idx] = win[(size_t)(idx >> 3) * NPROJ + 2048 + (idx & 7)];
        __syncthreads();
        const float* x = a.in[I_X]; const float* g1 = a.in[I_N1G]; const float* bif = a.in[I_BIF];
        bf16* H1 = (bf16*)(ws + OFF_H1); float* GATES = (float*)(ws + OFF_GATES);
        f4 gv[4];
#pragma unroll
        for (int j = 0; j < 4; ++j) gv[j] = ((const f4*)g1)[lane + 64 * j];
        for (int m = gw; m < T; m += NGW) {
            const f4* xr = (const f4*)(x + (size_t)m * DM) + lane;
            f4 v[4]; float ss = 0.f;
#pragma unroll
            for (int j = 0; j < 4; ++j) { v[j] = xr[64 * j]; ss += (v[j].x * v[j].x + v[j].y * v[j].y) + (v[j].z * v[j].z + v[j].w * v[j].w); }
            const float rstd = rsqrtf(wave_sum(ss) * (1.f / DM) + EPS);
            float ga[8];
#pragma unroll
            for (int c = 0; c < 8; ++c) ga[c] = 0.f;
            unsigned long long* o8 = (unsigned long long*)(H1 + (size_t)m * DM) + lane;
#pragma unroll
            for (int j = 0; j < 4; ++j) { v[j] = v[j] * rstd * gv[j];
                o8[64 * j] = (unsigned long long)pk2(v[j].x, v[j].y) | ((unsigned long long)pk2(v[j].z, v[j].w) << 32);
#pragma unroll
                for (int e = 0; e < 4; ++e) { const int k = 4 * lane + 256 * j + e; const f4 w0 = *(const LAS f4*)(wif + k * 8), w1 = *(const LAS f4*)(wif + k * 8 + 4); const float hv = v[j][e];
                    ga[0] += hv * w0.x; ga[1] += hv * w0.y; ga[2] += hv * w0.z; ga[3] += hv * w0.w; ga[4] += hv * w1.x; ga[5] += hv * w1.y; ga[6] += hv * w1.z; ga[7] += hv * w1.w; }
            }
            float r4[4], r2[2], r1;
            { const bool hi = lane & 32;
#pragma unroll
              for (int i = 0; i < 4; ++i) { const float send = hi ? ga[i] : ga[i + 4], keep = hi ? ga[i + 4] : ga[i]; r4[i] = keep + __shfl_xor(send, 32); } }
            { const bool hi = lane & 16;
#pragma unroll
              for (int i = 0; i < 2; ++i) { const float send = hi ? r4[i] : r4[i + 2], keep = hi ? r4[i + 2] : r4[i]; r2[i] = keep + __shfl_xor(send, 16); } }
            { const bool hi = lane & 8; const float send = hi ? r2[0] : r2[1], keep = hi ? r2[1] : r2[0]; r1 = keep + __shfl_xor(send, 8); }
            r1 += __shfl_xor(r1, 4); r1 += __shfl_xor(r1, 2); r1 += __shfl_xor(r1, 1);
            if ((lane & 7) == 0) { const int c = (lane >> 3) & 7; GATES[(size_t)m * 8 + c] = r1 + bif[c]; }
        }
    }
}

__device__ __forceinline__ void s5_expand(const KArgs& a, int G) {
    const float* KT = (const float*)(a.ws + OFF_KT); bf16* S5M = (bf16*)(a.ws + OFF_S5M);
    const int gt = blockIdx.x * 512 + otid(), GT = G * 512;
    for (int task = gt; task < 32 * 1024 * 64; task += GT) {
        const int s = task & 63, row = task >> 6, g = row >> 10, t = (row >> 4) & 63, i = row & 15;
        v4u o0 = (v4u){0u, 0u, 0u, 0u}, o1 = o0;
        if (s <= t) { const f4* k4 = (const f4*)(KT + ((size_t)((g * 64 + (t - s)) * 16 + i)) * 16); const f4 a0 = k4[0], a1 = k4[1], a2 = k4[2], a3 = k4[3];
            o0 = (v4u){pk2(a0.x, a0.y), pk2(a0.z, a0.w), pk2(a1.x, a1.y), pk2(a1.z, a1.w)}; o1 = (v4u){pk2(a2.x, a2.y), pk2(a2.z, a2.w), pk2(a3.x, a3.y), pk2(a3.z, a3.w)}; }
        v4u* d = (v4u*)(S5M + ((size_t)row * 1152 + s * 16)); d[0] = o0; d[1] = o1;
    }
}

using pg8::Unit; using pg8::cvt_pk_bf16;
struct EpiInProj {
    static constexpr bool PERM = true;
    bf16 *QK, *V, *O, *UG;
    __device__ __forceinline__ void operator()(const pg8::f32x4 (&acc)[2][2][4][2], const Unit& u, int wr, int wc, int fr, int fq) const {
        const int row0 = u.pm * 256 + wr * 64 + fr, c0 = wc * 32 + 8 * fq;
#pragma unroll
        for (int ai = 0; ai < 2; ++ai)
#pragma unroll
            for (int m = 0; m < 4; ++m) { const int row = row0 + ai * 128 + m * 16;
#pragma unroll
                for (int bj = 0; bj < 2; ++bj) { const pg8::f32x4 v0 = acc[ai][bj][m][0], v1 = acc[ai][bj][m][1];
                    v4u w; w.x = cvt_pk_bf16(v0[0], v0[1]); w.y = cvt_pk_bf16(v0[2], v0[3]); w.z = cvt_pk_bf16(v1[0], v1[1]); w.w = cvt_pk_bf16(v1[2], v1[3]);
                    const int col = c0 + bj * 128;
                    bf16* dst;
                    if (u.pn < 4) dst = QK + (size_t)row * 1024 + u.pn * 256 + col;
                    else if (u.pn < 6) dst = V + (size_t)row * 512 + (u.pn - 4) * 256 + col;
                    else if (u.pn < 8) dst = O + (size_t)row * 512 + (u.pn - 6) * 256 + col;
                    else { const int uc = (u.pn - 8) * 256 + col, g = uc >> 4, j = uc & 15; dst = UG + ((size_t)(g * 1024 + (row >> 6)) * 1152 + (row & 63) * 16 + j); }
                    *(v4u*)dst = w; } }
    }
};
struct EpiS5E {
    static constexpr bool PERM = false;
    float* E;
    __device__ __forceinline__ void operator()(const pg8::f32x4 (&acc)[2][2][4][2], const Unit& u, int wr, int wc, int fr, int fq) const {
        const int row0 = u.pm * 256 + wr * 64 + fr, col0 = wc * 32 + 4 * fq;
#pragma unroll
        for (int ai = 0; ai < 2; ++ai)
#pragma unroll
            for (int m = 0; m < 4; ++m) { float* rowp = E + (size_t)(row0 + ai * 128 + m * 16) * 128 + col0;
#pragma unroll
                for (int n = 0; n < 2; ++n) *(pg8::f32x4*)(rowp + n * 16) = acc[ai][0][m][n]; }
    }
};
struct EpiS5Y {
    static constexpr bool PERM = true;
    const bf16* UG; const float* dskip; bf16* YSG;
    __device__ __forceinline__ void operator()(const pg8::f32x4 (&acc)[2][2][4][2], const Unit& u, int wr, int wc, int fr, int fq) const {
        const int g = u.pm >> 2, row0 = u.pm * 256 + wr * 64 + fr, c0 = (u.pn & 3) * 256 + wc * 32 + 8 * fq;
#pragma unroll
        for (int ai = 0; ai < 2; ++ai)
#pragma unroll
            for (int m = 0; m < 4; ++m) { const int row = row0 + ai * 128 + m * 16, chunk = row & 1023;
#pragma unroll
                for (int bj = 0; bj < 2; ++bj) { const int n = c0 + bj * 128, t = n >> 4, i0 = n & 15;
                    const v4u uw = *(const v4u*)(UG + ((size_t)row * 1152 + n));
                    const f4 d0 = *(const f4*)(dskip + g * 16 + i0), d1 = *(const f4*)(dskip + g * 16 + i0 + 4);
                    const pg8::f32x4 v0 = acc[ai][bj][m][0], v1 = acc[ai][bj][m][1];
                    float y[8];
                    y[0] = v0[0] + d0.x * bflo(uw.x); y[1] = v0[1] + d0.y * bfhi(uw.x); y[2] = v0[2] + d0.z * bflo(uw.y); y[3] = v0[3] + d0.w * bfhi(uw.y);
                    y[4] = v1[0] + d1.x * bflo(uw.z); y[5] = v1[1] + d1.y * bfhi(uw.z); y[6] = v1[2] + d1.z * bflo(uw.w); y[7] = v1[3] + d1.w * bfhi(uw.w);
#pragma unroll
                    for (int e = 0; e < 8; ++e) y[e] = gelu_tanh(y[e]);
                    v4u w; w.x = cvt_pk_bf16(y[0], y[1]); w.y = cvt_pk_bf16(y[2], y[3]); w.z = cvt_pk_bf16(y[4], y[5]); w.w = cvt_pk_bf16(y[6], y[7]);
                    *(v4u*)(YSG + ((size_t)(chunk * 64 + t) * 512 + g * 16 + i0)) = w; } }
    }
};
struct EpiGlu {
    static constexpr bool PERM = true;
    const bf16* YSG; const float* bglu; bf16* MIX;
    __device__ __forceinline__ void operator()(const pg8::f32x4 (&acc)[2][2][4][2], const Unit& u, int wr, int wc, int fr, int fq) const {
        const int row0 = u.pm * 256 + wr * 64 + fr, c0 = u.pn * 256 + wc * 32 + 8 * fq;
#pragma unroll
        for (int ai = 0; ai < 2; ++ai)
#pragma unroll
            for (int m = 0; m < 4; ++m) { const int row = row0 + ai * 128 + m * 16;
#pragma unroll
                for (int bj = 0; bj < 2; ++bj) { const int col = c0 + bj * 128;
                    const v4u yw = *(const v4u*)(YSG + (size_t)row * 512 + col);
                    const f4 b0 = *(const f4*)(bglu + col), b1 = *(const f4*)(bglu + col + 4);
                    const pg8::f32x4 v0 = acc[ai][bj][m][0], v1 = acc[ai][bj][m][1];
                    float y[8];
                    y[0] = bflo(yw.x) * sigmoidf_(v0[0] + b0.x); y[1] = bfhi(yw.x) * sigmoidf_(v0[1] + b0.y); y[2] = bflo(yw.y) * sigmoidf_(v0[2] + b0.z); y[3] = bfhi(yw.y) * sigmoidf_(v0[3] + b0.w);
                    y[4] = bflo(yw.z) * sigmoidf_(v1[0] + b1.x); y[5] = bfhi(yw.z) * sigmoidf_(v1[1] + b1.y); y[6] = bflo(yw.w) * sigmoidf_(v1[2] + b1.z); y[7] = bfhi(yw.w) * sigmoidf_(v1[3] + b1.w);
                    v4u w; w.x = cvt_pk_bf16(y[0], y[1]); w.y = cvt_pk_bf16(y[2], y[3]); w.z = cvt_pk_bf16(y[4], y[5]); w.w = cvt_pk_bf16(y[6], y[7]);
                    *(v4u*)(MIX + (size_t)row * 1024 + 512 + col) = w; } }
    }
};
struct EpiOut {
    static constexpr bool PERM = false;
    const float* X; float* X1;
    __device__ __forceinline__ void operator()(const pg8::f32x4 (&acc)[2][2][4][2], const Unit& u, int wr, int wc, int fr, int fq) const {
        const int row0 = u.pm * 256 + wr * 64 + fr, col0 = u.pn * 256 + wc * 32 + 4 * fq;
#pragma unroll
        for (int ai = 0; ai < 2; ++ai)
#pragma unroll
            for (int m = 0; m < 4; ++m) { const size_t off = (size_t)(row0 + ai * 128 + m * 16) * 1024 + col0;
#pragma unroll
                for (int bj = 0; bj < 2; ++bj)
#pragma unroll
                    for (int n = 0; n < 2; ++n) { const pg8::f32x4 xv = *(const pg8::f32x4*)(X + off + bj * 128 + n * 16); *(pg8::f32x4*)(X1 + off + bj * 128 + n * 16) = xv + acc[ai][bj][m][n]; } }
    }
};
struct EpiMoeGU {
    static constexpr bool PERM = true;
    const float* bgu; bf16* ACT;
    __device__ __forceinline__ void operator()(const pg8::f32x4 (&acc)[2][2][4][2], const Unit& u, int wr, int wc, int fr, int fq) const {
        const int e = u.pn >> 3, pnl = u.pn & 7, row0 = u.pm * 256 + wr * 64 + fr, c0 = pnl * 128 + wc * 32 + 8 * fq;
        const float* bg = bgu + (size_t)e * 2048 + c0; const float* bu = bg + 1024;
        const f4 g0 = *(const f4*)bg, g1 = *(const f4*)(bg + 4), u0 = *(const f4*)bu, u1 = *(const f4*)(bu + 4);
        const float gb[8] = {g0.x, g0.y, g0.z, g0.w, g1.x, g1.y, g1.z, g1.w}, ub[8] = {u0.x, u0.y, u0.z, u0.w, u1.x, u1.y, u1.z, u1.w};
#pragma unroll
        for (int ai = 0; ai < 2; ++ai)
#pragma unroll
            for (int m = 0; m < 4; ++m) { const int row = row0 + ai * 128 + m * 16;
                float y[8];
#pragma unroll
                for (int n = 0; n < 2; ++n)
#pragma unroll
                    for (int q = 0; q < 4; ++q) { const int k = 4 * n + q;
                        const float gate = fminf(acc[ai][0][m][n][q] + gb[k], 7.0f); const float up = fminf(fmaxf(acc[ai][1][m][n][q] + ub[k], -7.0f), 7.0f);
                        y[k] = (up + 1.0f) * gate * sigmoidf_(1.702f * gate); }
                v4u w; w.x = cvt_pk_bf16(y[0], y[1]); w.y = cvt_pk_bf16(y[2], y[3]); w.z = cvt_pk_bf16(y[4], y[5]); w.w = cvt_pk_bf16(y[6], y[7]);
                *(v4u*)(ACT + (size_t)row * 1024 + c0) = w; }
    }
};
struct EpiMoeDN {
    static constexpr bool PERM = true;
    const float* bdn; const float* rgate; bf16* YS;
    __device__ __forceinline__ void operator()(const pg8::f32x4 (&acc)[2][2][4][2], const Unit& u, int wr, int wc, int fr, int fq) const {
        const int e = u.pn >> 2, pnl = u.pn & 3, row0 = u.pm * 256 + wr * 64 + fr, c0 = pnl * 256 + wc * 32 + 8 * fq;
#pragma unroll
        for (int bj = 0; bj < 2; ++bj) { const int col = c0 + bj * 128;
            const f4 b0 = *(const f4*)(bdn + (size_t)e * 1024 + col), b1 = *(const f4*)(bdn + (size_t)e * 1024 + col + 4);
#pragma unroll
            for (int ai = 0; ai < 2; ++ai)
#pragma unroll
                for (int m = 0; m < 4; ++m) { const int row = row0 + ai * 128 + m * 16; const float gt = rgate[row];
                    const pg8::f32x4 v0 = acc[ai][bj][m][0], v1 = acc[ai][bj][m][1];
                    v4u w; w.x = cvt_pk_bf16((v0[0] + b0.x) * gt, (v0[1] + b0.y) * gt); w.y = cvt_pk_bf16((v0[2] + b0.z) * gt, (v0[3] + b0.w) * gt);
                    w.z = cvt_pk_bf16((v1[0] + b1.x) * gt, (v1[1] + b1.y) * gt); w.w = cvt_pk_bf16((v1[2] + b1.z) * gt, (v1[3] + b1.w) * gt);
                    *(v4u*)(YS + (size_t)row * 1024 + col) = w; } }
    }
};

struct S5EOrder {
    int G, c;
    __device__ __forceinline__ bool next(int i, Unit& u) const { const int Lq = i * G + c; if (Lq >= 128) return false; u.pm = Lq; u.pn = Lq >> 2; return true; }
    __device__ __forceinline__ void a_ready(const Unit&) const {}
    __device__ __forceinline__ void done(const Unit&) const {}
};
struct S5YOrder {
    int G, c;
    __device__ __forceinline__ bool next(int i, Unit& u) const { const int Lq = i * G + c; if (Lq >= 512) return false; const int g = Lq >> 4, r = Lq & 15; u.pm = g * 4 + (r >> 2); u.pn = g * 4 + (r & 3); return true; }
    __device__ __forceinline__ void a_ready(const Unit&) const {}
    __device__ __forceinline__ void done(const Unit&) const {}
};
struct MoeOrder {
    const int* tile_e; int ntile, NT, G, c;
    __device__ __forceinline__ bool next(int i, Unit& u) const { const int Lq = i * G + c; if (Lq >= ntile * NT) return false; const int it = Lq / NT, pnl = Lq % NT; u.pm = it; u.pn = tile_e[it] * NT + pnl; return true; }
    __device__ __forceinline__ void a_ready(const Unit&) const {}
    __device__ __forceinline__ void done(const Unit&) const {}
};

__device__ __forceinline__ void conv16(const bf16* QK, const float* convw, const float* convb, int b, int trow, int ch0, float (&o)[16]) {
    const f4* cb = (const f4*)(convb + ch0);
#pragma unroll
    for (int q = 0; q < 4; ++q) { const f4 v = cb[q]; o[4 * q] = v.x; o[4 * q + 1] = v.y; o[4 * q + 2] = v.z; o[4 * q + 3] = v.w; }
#pragma unroll
    for (int j = 0; j < 4; ++j) { const int r = trow - 3 + j;
        if (r >= 0) { const v4u* src = (const v4u*)(QK + ((size_t)(b * SEQ + r) * 1024 + ch0)); const v4u x0 = src[0], x1 = src[1];
            const f4* w4 = (const f4*)(convw + j * 1024 + ch0); const f4 w0 = w4[0], w1 = w4[1], w2 = w4[2], w3 = w4[3];
            o[0] += w0.x * bflo(x0.x); o[1] += w0.y * bfhi(x0.x); o[2] += w0.z * bflo(x0.y); o[3] += w0.w * bfhi(x0.y);
            o[4] += w1.x * bflo(x0.z); o[5] += w1.y * bfhi(x0.z); o[6] += w1.z * bflo(x0.w); o[7] += w1.w * bfhi(x0.w);
            o[8] += w2.x * bflo(x1.x); o[9] += w2.y * bfhi(x1.x); o[10] += w2.z * bflo(x1.y); o[11] += w2.w * bfhi(x1.y);
            o[12] += w3.x * bflo(x1.z); o[13] += w3.y * bfhi(x1.z); o[14] += w3.z * bflo(x1.w); o[15] += w3.w * bfhi(x1.w); } }
#pragma unroll
    for (int e = 0; e < 16; ++e) o[e] = siluf_(o[e]);
}

__device__ __forceinline__ void mlstm_local_item(const KArgs& a, LAS unsigned char* L, int item) {
    const int tid = otid(), lane = tid & 63, wave = tid >> 6;
    const int c = item & 127, bh = item >> 7, h = bh & 3, b = bh >> 2, tok0 = b * SEQ + c * 64;
    LAS bf16* kT = (LAS bf16*)L;
    LAS bf16* vT = (LAS bf16*)(L + 18432);
    LAS float* wsv = (LAS float*)(L + 36864);
    const float* GATES = (const float*)(a.ws + OFF_GATES);
    const bf16* QK = (const bf16*)(a.ws + OFF_QK); const bf16* V = (const bf16*)(a.ws + OFF_V);
    if (wave == 0) {
        const float fg = GATES[(size_t)(tok0 + lane) * 8 + 4 + h], ig = GATES[(size_t)(tok0 + lane) * 8 + h];
        float bb = logsigmoidf_(fg);
#pragma unroll
        for (int o = 1; o < 64; o <<= 1) { const float t = __shfl_up(bb, o); if (lane >= o) bb += t; }
        const float g = __shfl(bb, 63), wl = g - bb + ig, amax = wave_max(wl);
        wsv[lane] = expf(wl - amax);
        if (lane == 0) { ((float*)(a.ws + OFF_MLG))[item] = g; ((float*)(a.ws + OFF_MLA))[item] = amax; }
    }
    const int s = tid >> 3, col0 = (tid & 7) * 16;
    float kc[16];
    conv16(QK, a.in[I_CONVW], a.in[I_CONVB], b, c * 64 + s, 512 + h * 128 + col0, kc);
    const v4u* vsrc = (const v4u*)(V + ((size_t)(tok0 + s) * 512 + h * 128 + col0)); const v4u vx0 = vsrc[0], vx1 = vsrc[1];
#pragma unroll
    for (int e = 0; e < 16; ++e) kT[(col0 + e) * 72 + s] = (bf16)f2bf(kc[e] * 0.08838834764831845f);
    __syncthreads();
    {
        const float w = wsv[s];
        const unsigned vw[8] = {vx0.x, vx0.y, vx0.z, vx0.w, vx1.x, vx1.y, vx1.z, vx1.w};
#pragma unroll
        for (int q = 0; q < 8; ++q) { vT[(col0 + 2 * q) * 72 + s] = (bf16)f2bf(bflo(vw[q]) * w); vT[(col0 + 2 * q + 1) * 72 + s] = (bf16)f2bf(bfhi(vw[q]) * w); }
    }
    __syncthreads();
    {
        const int kdb = wave >> 1, vb0 = (wave & 1) * 2, r = lane & 31, hh = lane >> 5;
        f32x16 acc0, acc1;
#pragma unroll
        for (int i = 0; i < 16; ++i) { acc0[i] = 0.f; acc1[i] = 0.f; }
#pragma unroll
        for (int ks = 0; ks < 4; ++ks) {
            const bf16x8 A = *(const LAS bf16x8*)(kT + (kdb * 32 + r) * 72 + ks * 16 + 8 * hh);
            const bf16x8 B0 = *(const LAS bf16x8*)(vT + (vb0 * 32 + r) * 72 + ks * 16 + 8 * hh);
            const bf16x8 B1 = *(const LAS bf16x8*)(vT + ((vb0 + 1) * 32 + r) * 72 + ks * 16 + 8 * hh);
            acc0 = __builtin_amdgcn_mfma_f32_32x32x16_bf16(A, B0, acc0, 0, 0, 0);
            acc1 = __builtin_amdgcn_mfma_f32_32x32x16_bf16(A, B1, acc1, 0, 0, 0);
        }
        bf16* UP = (bf16*)((unsigned char*)a.out + OUT_UP) + (size_t)item * 16384;
#pragma unroll
        for (int q = 0; q < 4; ++q) { const int kd = kdb * 32 + 8 * q + 4 * hh;
            v2u w0; w0.x = pk2(acc0[4 * q], acc0[4 * q + 1]); w0.y = pk2(acc0[4 * q + 2], acc0[4 * q + 3]);
            v2u w1; w1.x = pk2(acc1[4 * q], acc1[4 * q + 1]); w1.y = pk2(acc1[4 * q + 2], acc1[4 * q + 3]);
            *(v2u*)(UP + (size_t)(vb0 * 32 + r) * 128 + kd) = w0; *(v2u*)(UP + (size_t)((vb0 + 1) * 32 + r) * 128 + kd) = w1; }
    }
    if (tid < 128) { float np = 0.f;
#pragma unroll 8
        for (int q = 0; q < 64; ++q) np += wsv[q] * bf2f(kT[tid * 72 + q]);
        ((float*)(a.ws + OFF_MLNP))[(size_t)item * 128 + tid] = np; }
    __syncthreads();
}

__device__ __forceinline__ void phase3(const KArgs& a, LAS unsigned char* L, int G) {
    const int tid = otid(), lane = tid & 63, wave = tid >> 6;
    LAS float* ga = (LAS float*)L; LAS float* aa = ga + 128; LAS float* dec = aa + 128; LAS float* scl = dec + 128;
    for (int w = blockIdx.x; w < 256; w += G) {
        const int bh = w >> 3, slice = w & 7;
        if (tid < 128) { ga[tid] = ((const float*)(a.ws + OFF_MLG))[bh * 128 + tid]; aa[tid] = ((const float*)(a.ws + OFF_MLA))[bh * 128 + tid]; }
        __syncthreads();
        if (tid == 0) { float m = 0.f; float* MLM = (float*)(a.ws + OFF_MLM);
            for (int c = 0; c < 128; ++c) { const float g = ga[c], am = aa[c], mn = fmaxf(g + m, am); dec[c] = expf(g + m - mn); scl[c] = expf(am - mn); if (slice == 0) MLM[bh * 128 + c] = m; m = mn; } }
        __syncthreads();
        {
            const size_t e0 = (size_t)bh * 128 * 16384 + slice * 2048 + tid * 4;
            const bf16* up = (const bf16*)((const unsigned char*)a.out + OUT_UP) + e0; bf16* cs = (bf16*)((unsigned char*)a.out + OUT_CST) + e0;
            float C0 = 0.f, C1 = 0.f, C2 = 0.f, C3 = 0.f;
            for (int c0 = 0; c0 < 128; c0 += 8) {
                v2u uv[8];
#pragma unroll
                for (int q = 0; q < 8; ++q) uv[q] = *(const v2u*)(up + (size_t)(c0 + q) * 16384);
#pragma unroll
                for (int q = 0; q < 8; ++q) { v2u o; o.x = pk2(C0, C1); o.y = pk2(C2, C3); *(v2u*)(cs + (size_t)(c0 + q) * 16384) = o;
                    const float d = dec[c0 + q], sc = scl[c0 + q];
                    C0 = d * C0 + sc * bflo(uv[q].x); C1 = d * C1 + sc * bfhi(uv[q].x); C2 = d * C2 + sc * bflo(uv[q].y); C3 = d * C3 + sc * bfhi(uv[q].y); }
            }
        }
        if (slice == 0 && tid < 128) { const float* np = (const float*)(a.ws + OFF_MLNP) + (size_t)bh * 128 * 128 + tid; float* ns = (float*)(a.ws + OFF_MLN) + (size_t)bh * 128 * 128 + tid; float n = 0.f;
            for (int c = 0; c < 128; ++c) { ns[c * 128] = n; n = dec[c] * n + scl[c] * np[c * 128]; } }
        __syncthreads();
    }
    if (wave == 7) for (int w = blockIdx.x; w < 256; w += G) {
        const int b = w >> 5, g = w & 31, p = lane;
        const float dt = expf(a.in[I_LDT][g]); float lr, li; lam_pow(a.in[I_LRE][g * 64 + p], a.in[I_LIM][g * 64 + p], dt, 64, lr, li);
        const float* E = (const float*)(a.ws + OFF_S5E) + ((size_t)(g * 1024 + b * 128) * 128 + 2 * p);
        bf16* UG = (bf16*)(a.ws + OFF_UG) + ((size_t)(g * 1024 + b * 128) * 1152 + 1024 + 2 * p);
        float xr = 0.f, xi = 0.f;
        for (int c0 = 0; c0 < 128; c0 += 8) {
            f2 ev[8];
#pragma unroll
            for (int q = 0; q < 8; ++q) ev[q] = *(const f2*)(E + (size_t)(c0 + q) * 128);
#pragma unroll
            for (int q = 0; q < 8; ++q) { *(unsigned*)(UG + (size_t)(c0 + q) * 1152) = pk2(xr, xi);
                const float nr = lr * xr - li * xi + ev[q].x, ni = lr * xi + li * xr + ev[q].y; xr = nr; xi = ni; }
        }
    }
}

__device__ __forceinline__ void mlstm_out_item(const KArgs& a, LAS unsigned char* L, int item) {
    const int tid = otid(), lane = tid & 63, wave = tid >> 6;
    const int c = item & 127, bh = item >> 7, h = bh & 3, b = bh >> 2, tok0 = b * SEQ + c * 64;
    LAS bf16* qc = (LAS bf16*)L;
    LAS bf16* kc = (LAS bf16*)(L + 17408);
    LAS bf16* vT = (LAS bf16*)(L + 34816);
    LAS bf16* Cs = (LAS bf16*)(L + 53248);
    LAS bf16* Pm = (LAS bf16*)(L + 88064);
    LAS float* fcs = (LAS float*)(L + 97280); LAS float* frr = fcs + 64; LAS float* fsc = frr + 64; LAS float* fen = fsc + 64; LAS float* fden = fen + 64; LAS float* fn = fden + 64;
    LAS float* hbuf = (LAS float*)L;
    const float* GATES = (const float*)(a.ws + OFF_GATES);
    const bf16* QK = (const bf16*)(a.ws + OFF_QK); const bf16* V = (const bf16*)(a.ws + OFF_V);
    if (wave == 0) {
        const float fg = GATES[(size_t)(tok0 + lane) * 8 + 4 + h], ig = GATES[(size_t)(tok0 + lane) * 8 + h];
        float bb = logsigmoidf_(fg);
#pragma unroll
        for (int o = 1; o < 64; o <<= 1) { const float t = __shfl_up(bb, o); if (lane >= o) bb += t; }
        const float cs = ig - bb; float pm = cs;
#pragma unroll
        for (int o = 1; o < 64; o <<= 1) { const float t = __shfl_up(pm, o); if (lane >= o) pm = fmaxf(pm, t); }
        const float mk = ((const float*)(a.ws + OFF_MLM))[item], r = fmaxf(pm, mk);
        fcs[lane] = cs; frr[lane] = r; fsc[lane] = expf(mk - r); fen[lane] = expf(-bb - r);
    }
    if (wave == 2 || wave == 3) fn[tid - 128] = ((const float*)(a.ws + OFF_MLN))[(size_t)item * 128 + tid - 128];
    const int s = tid >> 3, col0 = (tid & 7) * 16;
    {
        float t16[16];
        conv16(QK, a.in[I_CONVW], a.in[I_CONVB], b, c * 64 + s, h * 128 + col0, t16);
        v4u w0, w1; w0.x = pk2(t16[0], t16[1]); w0.y = pk2(t16[2], t16[3]); w0.z = pk2(t16[4], t16[5]); w0.w = pk2(t16[6], t16[7]);
        w1.x = pk2(t16[8], t16[9]); w1.y = pk2(t16[10], t16[11]); w1.z = pk2(t16[12], t16[13]); w1.w = pk2(t16[14], t16[15]);
        *(LAS v4u*)(qc + s * 136 + col0) = w0; *(LAS v4u*)(qc + s * 136 + col0 + 8) = w1;
        conv16(QK, a.in[I_CONVW], a.in[I_CONVB], b, c * 64 + s, 512 + h * 128 + col0, t16);
#pragma unroll
        for (int e = 0; e < 16; ++e) t16[e] *= 0.08838834764831845f;
        w0.x = pk2(t16[0], t16[1]); w0.y = pk2(t16[2], t16[3]); w0.z = pk2(t16[4], t16[5]); w0.w = pk2(t16[6], t16[7]);
        w1.x = pk2(t16[8], t16[9]); w1.y = pk2(t16[10], t16[11]); w1.z = pk2(t16[12], t16[13]); w1.w = pk2(t16[14], t16[15]);
        *(LAS v4u*)(kc + s * 136 + col0) = w0; *(LAS v4u*)(kc + s * 136 + col0 + 8) = w1;
        const v4u* vsrc = (const v4u*)(V + ((size_t)(tok0 + s) * 512 + h * 128 + col0)); const v4u vx0 = vsrc[0], vx1 = vsrc[1];
        const unsigned vw[8] = {vx0.x, vx0.y, vx0.z, vx0.w, vx1.x, vx1.y, vx1.z, vx1.w};
#pragma unroll
        for (int q = 0; q < 8; ++q) { vT[(col0 + 2 * q) * 72 + s] = (bf16)(vw[q] & 0xffffu); vT[(col0 + 2 * q + 1) * 72 + s] = (bf16)(vw[q] >> 16); }
        const bf16* CST = (const bf16*)((const unsigned char*)a.out + OUT_CST) + (size_t)item * 16384;
#pragma unroll
        for (int i = 0; i < 4; ++i) { const int ch = tid + 512 * i, v = ch >> 4, kd0 = (ch & 15) * 8; *(LAS v4u*)(Cs + v * 136 + kd0) = *(const v4u*)(CST + (size_t)ch * 8); }
    }
    __syncthreads();
    {
        const int tb = wave >> 1, sb0 = (wave & 1) * 2, fr = lane & 15, fq = lane >> 4;
#pragma unroll
        for (int jj = 0; jj < 2; ++jj) { const int sb = sb0 + jj;
            pg8::f32x4 acc = (pg8::f32x4){0.f, 0.f, 0.f, 0.f};
            if (sb <= tb) {
#pragma unroll
                for (int ks = 0; ks < 4; ++ks) {
                    const bf16x8 A = *(const LAS bf16x8*)(qc + (tb * 16 + fr) * 136 + ks * 32 + 8 * fq);
                    const bf16x8 B = *(const LAS bf16x8*)(kc + (sb * 16 + fr) * 136 + ks * 32 + 8 * fq);
                    acc = __builtin_amdgcn_mfma_f32_16x16x32_bf16(A, B, acc, 0, 0, 0);
                }
            }
            const int sc_ = sb * 16 + fr; const float csv = fcs[sc_];
#pragma unroll
            for (int q = 0; q < 4; ++q) { const int t = tb * 16 + fq * 4 + q; const float pv = (sc_ <= t) ? acc[q] * __expf(csv - frr[t]) : 0.f; Pm[t * 72 + sc_] = (bf16)f2bf(pv); }
        }
    }
    __syncthreads();
    {
        const int t = tid >> 3, part = tid & 7;
        const v4u pw = *(const LAS v4u*)(Pm + t * 72 + part * 8);
        float ps = (bflo(pw.x) + bfhi(pw.x)) + (bflo(pw.y) + bfhi(pw.y)) + (bflo(pw.z) + bfhi(pw.z)) + (bflo(pw.w) + bfhi(pw.w));
        const v4u q0 = *(const LAS v4u*)(qc + t * 136 + part * 16), q1 = *(const LAS v4u*)(qc + t * 136 + part * 16 + 8);
        const unsigned qw[8] = {q0.x, q0.y, q0.z, q0.w, q1.x, q1.y, q1.z, q1.w};
        float qn = 0.f;
#pragma unroll
        for (int q = 0; q < 8; ++q) qn += bflo(qw[q]) * fn[part * 16 + 2 * q] + bfhi(qw[q]) * fn[part * 16 + 2 * q + 1];
        float val = ps + fsc[t] * qn;
        val += __shfl_xor(val, 1); val += __shfl_xor(val, 2); val += __shfl_xor(val, 4);
        if (part == 0) fden[t] = val;
    }
    f32x16 accA, accB;
    const int tb2 = wave >> 2, vb = wave & 3, r32 = lane & 31, hh = lane >> 5;
    {
#pragma unroll
        for (int i = 0; i < 16; ++i) { accA[i] = 0.f; accB[i] = 0.f; }
#pragma unroll
        for (int ks = 0; ks < 4; ++ks) {
            const bf16x8 A = *(const LAS bf16x8*)(Pm + (tb2 * 32 + r32) * 72 + ks * 16 + 8 * hh);
            const bf16x8 B = *(const LAS bf16x8*)(vT + (vb * 32 + r32) * 72 + ks * 16 + 8 * hh);
            accA = __builtin_amdgcn_mfma_f32_32x32x16_bf16(A, B, accA, 0, 0, 0);
        }
#pragma unroll
        for (int ks = 0; ks < 8; ++ks) {
            const bf16x8 A = *(const LAS bf16x8*)(qc + (tb2 * 32 + r32) * 136 + ks * 16 + 8 * hh);
            const bf16x8 B = *(const LAS bf16x8*)(Cs + (vb * 32 + r32) * 136 + ks * 16 + 8 * hh);
            accB = __builtin_amdgcn_mfma_f32_32x32x16_bf16(A, B, accB, 0, 0, 0);
        }
    }
    __syncthreads();
    {
#pragma unroll
        for (int i = 0; i < 16; ++i) { const int t = tb2 * 32 + (i & 3) + 8 * (i >> 2) + 4 * hh;
            const float num = accA[i] + fsc[t] * accB[i]; hbuf[t * 132 + vb * 32 + r32] = num / fmaxf(fabsf(fden[t]), fen[t]); }
    }
    __syncthreads();
    {
        const int t = tid >> 3, part = tid & 7;
        f4 hv[4]; float ss = 0.f;
#pragma unroll
        for (int q = 0; q < 4; ++q) { hv[q] = *(const LAS f4*)(hbuf + t * 132 + part * 16 + 4 * q); ss += (hv[q].x * hv[q].x + hv[q].y * hv[q].y) + (hv[q].z * hv[q].z + hv[q].w * hv[q].w); }
        ss += __shfl_xor(ss, 1); ss += __shfl_xor(ss, 2); ss += __shfl_xor(ss, 4);
        const float rstd = rsqrtf(ss * (1.f / 128.f) + EPS);
        const bf16* O = (const bf16*)(a.ws + OFF_O) + ((size_t)(tok0 + t) * 512 + h * 128 + part * 16);
        const v4u o0 = ((const v4u*)O)[0], o1 = ((const v4u*)O)[1];
        const unsigned ow[8] = {o0.x, o0.y, o0.z, o0.w, o1.x, o1.y, o1.z, o1.w};
        const f4* hg = (const f4*)(a.in[I_HNG] + h * 128 + part * 16);
        float y[16];
#pragma unroll
        for (int q = 0; q < 4; ++q) { const f4 g4 = hg[q];
            y[4 * q + 0] = sigmoidf_(bflo(ow[2 * q])) * hv[q].x * rstd * g4.x; y[4 * q + 1] = sigmoidf_(bfhi(ow[2 * q])) * hv[q].y * rstd * g4.y;
            y[4 * q + 2] = sigmoidf_(bflo(ow[2 * q + 1])) * hv[q].z * rstd * g4.z; y[4 * q + 3] = sigmoidf_(bfhi(ow[2 * q + 1])) * hv[q].w * rstd * g4.w; }
        v4u w0, w1; w0.x = pk2(y[0], y[1]); w0.y = pk2(y[2], y[3]); w0.z = pk2(y[4], y[5]); w0.w = pk2(y[6], y[7]);
        w1.x = pk2(y[8], y[9]); w1.y = pk2(y[10], y[11]); w1.z = pk2(y[12], y[13]); w1.w = pk2(y[14], y[15]);
        bf16* MIX = (bf16*)(a.ws + OFF_H1) + ((size_t)(tok0 + t) * 1024 + h * 128 + part * 16);
        ((v4u*)MIX)[0] = w0; ((v4u*)MIX)[1] = w1;
    }
    __syncthreads();
}

template <int N, int MASK> __device__ __forceinline__ void rs_step(float* v, int lane) {
    const bool hi = (lane & MASK) != 0;
#pragma unroll
    for (int i = 0; i < N; ++i) { const float send = hi ? v[i] : v[i + N], keep = hi ? v[i + N] : v[i]; v[i] = keep + __shfl_xor(send, MASK); }
}
__device__ __forceinline__ void phase7(const KArgs& a, LAS unsigned char* L, int G) {
    const int tid = otid(), lane = tid & 63, wave = tid >> 6;
    LAS float* wrT = (LAS float*)L;
    LAS int* le = (LAS int*)(L + 131584);
    LAS int* lcnt = (LAS int*)(L + 131584 + 4096);
    const float* wr = a.in[I_WR];
    for (int idx = tid; idx < 32768; idx += 512) wrT[(idx & 31) * 1028 + (idx >> 5)] = wr[idx];
    const float* X1 = a.out; const float* g2 = a.in[I_N2G]; const float* br = a.in[I_BR];
    f4 gv[4];
#pragma unroll
    for (int j = 0; j < 4; ++j) gv[j] = ((const f4*)g2)[lane + 64 * j];
    const float bre = br[lane >> 1];
    float* RSTD = (float*)(a.ws + OFF_RSTD2); int* ENTE = (int*)(a.ws + OFF_ENTE); float* ENTG = (float*)(a.ws + OFF_ENTG); int* ENTR = (int*)(a.ws + OFF_ENTR); int* CNT = (int*)(a.ws + OFF_CNT);
    for (int chunk = blockIdx.x; chunk < 256; chunk += G) {
        if (tid < 32) lcnt[tid] = 0;
        __syncthreads();
        for (int it = 0; it < 16; ++it) {
            const int tl = wave * 32 + 2 * it, t0 = chunk * 256 + tl;
            f4 h0[4], h1[4]; float s0 = 0.f, s1 = 0.f;
            const f4* x0 = (const f4*)(X1 + (size_t)t0 * DM) + lane; const f4* x1 = x0 + 256;
#pragma unroll
            for (int j = 0; j < 4; ++j) { h0[j] = x0[64 * j]; h1[j] = x1[64 * j];
                s0 += (h0[j].x * h0[j].x + h0[j].y * h0[j].y) + (h0[j].z * h0[j].z + h0[j].w * h0[j].w); s1 += (h1[j].x * h1[j].x + h1[j].y * h1[j].y) + (h1[j].z * h1[j].z + h1[j].w * h1[j].w); }
            const float r0 = rsqrtf(wave_sum(s0) * (1.f / DM) + EPS), r1 = rsqrtf(wave_sum(s1) * (1.f / DM) + EPS);
            if (lane == 0) { RSTD[t0] = r0; RSTD[t0 + 1] = r1; }
#pragma unroll
            for (int j = 0; j < 4; ++j) { h0[j] = h0[j] * r0 * gv[j]; h1[j] = h1[j] * r1 * gv[j]; }
            float v0[32], v1[32];
#pragma unroll
            for (int e = 0; e < 32; ++e) { float p0 = 0.f, p1 = 0.f;
#pragma unroll
                for (int j = 0; j < 4; ++j) { const f4 w = *(const LAS f4*)(wrT + e * 1028 + 4 * lane + 256 * j);
                    p0 += (h0[j].x * w.x + h0[j].y * w.y) + (h0[j].z * w.z + h0[j].w * w.w); p1 += (h1[j].x * w.x + h1[j].y * w.y) + (h1[j].z * w.z + h1[j].w * w.w); }
                v0[e] = p0; v1[e] = p1; }
            rs_step<16, 32>(v0, lane); rs_step<8, 16>(v0, lane); rs_step<4, 8>(v0, lane); rs_step<2, 4>(v0, lane); rs_step<1, 2>(v0, lane);
            rs_step<16, 32>(v1, lane); rs_step<8, 16>(v1, lane); rs_step<4, 8>(v1, lane); rs_step<2, 4>(v1, lane); rs_step<1, 2>(v1, lane);
            float l0 = v0[0] + __shfl_xor(v0[0], 1) + bre, l1 = v1[0] + __shfl_xor(v1[0], 1) + bre;
            const int me = lane >> 1;
#pragma unroll
            for (int tk = 0; tk < 2; ++tk) {
                float lv = tk ? l1 : l0; float tv[4]; int te[4];
#pragma unroll
                for (int r = 0; r < 4; ++r) { float bv = lv; int be = me;
#pragma unroll
                    for (int o = 1; o < 64; o <<= 1) { const float ov = __shfl_xor(bv, o); const int oe = __shfl_xor(be, o); if (ov > bv || (ov == bv && oe < be)) { bv = ov; be = oe; } }
                    tv[r] = bv; te[r] = be; if (me == be) lv = -3.0e38f; }
                const float e1 = __expf(tv[1] - tv[0]), e2 = __expf(tv[2] - tv[0]), e3 = __expf(tv[3] - tv[0]), inv = 1.f / (1.f + e1 + e2 + e3);
                if (lane < 4) { const int r = lane; const int ee = r == 0 ? te[0] : r == 1 ? te[1] : r == 2 ? te[2] : te[3]; const float gg = (r == 0 ? 1.f : r == 1 ? e1 : r == 2 ? e2 : e3) * inv;
                    const int tt = t0 + tk; ENTE[tt * 4 + r] = ee; ENTG[tt * 4 + r] = gg; le[(tl + tk) * 4 + r] = ee; }
            }
        }
        __syncthreads();
#pragma unroll
        for (int q = 0; q < 2; ++q) { const int idx = tid + 512 * q; const int e = le[idx]; const int rk = __hip_atomic_fetch_add(&lcnt[e], 1, __ATOMIC_RELAXED, __HIP_MEMORY_SCOPE_WORKGROUP); ENTR[chunk * 1024 + idx] = rk; }
        __syncthreads();
        if (tid < 32) CNT[chunk * 32 + tid] = lcnt[tid];
        __syncthreads();
    }
}

__device__ __forceinline__ void place_preamble(const KArgs& a, LAS int* tot, LAS int* pst, bool write_tiles) {
    const int tid = otid();
    const int* CNT = (const int*)(a.ws + OFF_CNT); int* TILEE = (int*)(a.ws + OFF_TILEE); int* NTILE = (int*)(a.ws + OFF_NTILE);
    if (tid < 64) { const int hf = tid >> 5, e = tid & 31; int s = 0; for (int c = 0; c < 128; ++c) s += CNT[(hf * 128 + c) * 32 + e]; tot[tid] = s; }
    __syncthreads();
    if (tid < 2) { const int hf = tid; int run = 0;
        for (int e = 0; e < 32; ++e) { pst[hf * 32 + e] = run; const int nt = (tot[hf * 32 + e] + 255) >> 8;
            if (write_tiles) for (int i = 0; i < nt; ++i) TILEE[hf * 1024 + (run >> 8) + i] = e;
            run += nt << 8; }
        if (write_tiles) NTILE[hf] = run >> 8; }
    __syncthreads();
}
__device__ __forceinline__ void chunk_base(const KArgs& a, LAS int* pst, LAS int* base, int chunk) {
    const int tid = otid(), hf = chunk >> 7; const int* CNT = (const int*)(a.ws + OFF_CNT);
    if (tid < 32) { int s = pst[hf * 32 + tid]; for (int c = hf * 128; c < chunk; ++c) s += CNT[c * 32 + tid]; base[tid] = s; }
    __syncthreads();
}
__device__ __forceinline__ void gather_unit(const KArgs& a, LAS int* pst, LAS int* base, int hf, int u, bf16* XS) {
    const int tid = otid(), lane = tid & 63, wave = tid >> 6;
    const int chunk = hf * 128 + (u >> 1), sub = u & 1;
    chunk_base(a, pst, base, chunk);
    const float* X1 = a.out; const float* g2 = a.in[I_N2G]; const float* RSTD = (const float*)(a.ws + OFF_RSTD2);
    const int* ENTE = (const int*)(a.ws + OFF_ENTE); const int* ENTR = (const int*)(a.ws + OFF_ENTR);
    f4 gv[4];
#pragma unroll
    for (int j = 0; j < 4; ++j) gv[j] = ((const f4*)g2)[lane + 64 * j];
    for (int it = 0; it < 16; ++it) { const int t = chunk * 256 + sub * 128 + wave * 16 + it;
        const f4* xr = (const f4*)(X1 + (size_t)t * DM) + lane; const float rs = RSTD[t];
        unsigned long long w[4];
#pragma unroll
        for (int j = 0; j < 4; ++j) { const f4 v = xr[64 * j] * rs * gv[j]; w[j] = (unsigned long long)pk2(v.x, v.y) | ((unsigned long long)pk2(v.z, v.w) << 32); }
#pragma unroll
        for (int k = 0; k < 4; ++k) { const int d = base[ENTE[t * 4 + k]] + ENTR[t * 4 + k]; unsigned long long* o8 = (unsigned long long*)(XS + (size_t)d * DM) + lane;
#pragma unroll
            for (int j = 0; j < 4; ++j) o8[64 * j] = w[j]; }
    }
    __syncthreads();
}
__device__ __forceinline__ void phase8(const KArgs& a, LAS unsigned char* L, int G) {
    const int tid = otid();
    LAS int* tot = (LAS int*)L; LAS int* pst = tot + 64; LAS int* base = pst + 64;
    const int* ENTE = (const int*)(a.ws + OFF_ENTE); const int* ENTR = (const int*)(a.ws + OFF_ENTR); const float* ENTG = (const float*)(a.ws + OFF_ENTG);
    int* SDEST = (int*)(a.ws + OFF_SDEST); float* RGATE = (float*)(a.ws + OFF_RGATE);
    place_preamble(a, tot, pst, blockIdx.x == 0);
    for (int chunk = blockIdx.x; chunk < 256; chunk += G) {
        const int hf = chunk >> 7;
        chunk_base(a, pst, base, chunk);
#pragma unroll
        for (int q = 0; q < 2; ++q) { const int gi = chunk * 1024 + tid + 512 * q; const int e = ENTE[gi]; const int d = base[e] + ENTR[gi]; SDEST[gi] = d; RGATE[hf * RCAP + d] = ENTG[gi]; }
        __syncthreads();
    }
    for (int u = blockIdx.x; u < 256; u += G) gather_unit(a, pst, base, 0, u, (bf16*)(a.ws + OFF_R1));
}

__device__ __forceinline__ void combine_half(const KArgs& a, int hf, const bf16* YS, int G) {
    const int tid = otid(), lane = tid & 63, wave = tid >> 6;
    const int gw = blockIdx.x * 8 + wave, NGW = G * 8;
    const int* SDEST = (const int*)(a.ws + OFF_SDEST); const float* gf = a.in[I_NFG];
    f4 gv[4];
#pragma unroll
    for (int j = 0; j < 4; ++j) gv[j] = ((const f4*)gf)[lane + 64 * j];
    for (int t = hf * 32768 + gw; t < (hf + 1) * 32768; t += NGW) {
        f4* xr = (f4*)(a.out + (size_t)t * DM) + lane;
        f4 v[4];
#pragma unroll
        for (int j = 0; j < 4; ++j) v[j] = xr[64 * j];
#pragma unroll
        for (int k = 0; k < 4; ++k) { const int d = SDEST[t * 4 + k]; const v2u* y8 = (const v2u*)(YS + (size_t)d * DM) + lane;
#pragma unroll
            for (int j = 0; j < 4; ++j) { const v2u w = y8[64 * j]; v[j].x += bflo(w.x); v[j].y += bfhi(w.x); v[j].z += bflo(w.y); v[j].w += bfhi(w.y); } }
        float ss = 0.f;
#pragma unroll
        for (int j = 0; j < 4; ++j) ss += (v[j].x * v[j].x + v[j].y * v[j].y) + (v[j].z * v[j].z + v[j].w * v[j].w);
        const float rstd = rsqrtf(wave_sum(ss) * (1.f / DM) + EPS);
#pragma unroll
        for (int j = 0; j < 4; ++j) xr[64 * j] = v[j] * rstd * gv[j];
    }
}

#ifndef MK_SINGLE
#define MK_SINGLE 1
#endif
typedef const __attribute__((address_space(4))) KArgs* KArgsP;
__device__ __forceinline__ KArgs kargs() {
#if defined(__HIP_DEVICE_COMPILE__)
    KArgsP p = (KArgsP)__builtin_amdgcn_kernarg_segment_ptr(); asm volatile("" : "+s"(p)); KArgs r; __builtin_memcpy(&r, (const __attribute__((address_space(4))) void*)p, sizeof(KArgs)); return r;
#else
    return KArgs{};
#endif
}
__global__ void __launch_bounds__(512, 2) mk_fwd(KArgs a_in) {
    extern __shared__ __attribute__((aligned(16))) unsigned char lds_raw[];
    LAS unsigned char* L = (LAS unsigned char*)lds_raw;
    cg::grid_group grid = cg::this_grid();
    const int ph_lo = a_in.ph_lo, ph_hi = a_in.ph_hi;
#define IN(k) (ph_lo <= (k) && (k) < ph_hi)
#define SEAM(k) do { if (IN(k) && IN((k) + 1)) grid.sync(); } while (0)
#define GBX const int G = gridDim.x, bx = blockIdx.x; const KArgs a = kargs(); unsigned char* ws = a.ws; (void)G; (void)bx; (void)ws
    if (IN(0)) { GBX; phase0(a, L, G); }
    SEAM(0);
    if (IN(1)) { GBX;
        s5_expand(a, G);
        pg8::Gemm g{(const bf16*)(ws + OFF_H1), (const bf16*)(ws + OFF_WIN), 1024, 1024, 1024}; pg8::StaticOrder S; S.init(T, 2560, G, bx);
        EpiInProj E{(bf16*)(ws + OFF_QK), (bf16*)(ws + OFF_V), (bf16*)(ws + OFF_O), (bf16*)(ws + OFF_UG)};
        pg8::gemm_phase<EpiInProj, pg8::StaticOrder, true, true>(L, g, S, E);
    }
    SEAM(1);
    if (IN(2)) { GBX;
        for (int item = bx; item < 4096; item += G) mlstm_local_item(a, L, item);
        pg8::Gemm g{(const bf16*)(ws + OFF_UG), (const bf16*)(ws + OFF_S5P), 1152, 1024, 1024}; S5EOrder S{G, bx};
        EpiS5E E{(float*)(ws + OFF_S5E)};
        pg8::gemm_phase<EpiS5E, S5EOrder, true, true>(L, g, S, E);
    }
    SEAM(2);
    if (IN(3)) { GBX; phase3(a, L, G); }
    SEAM(3);
    if (IN(4)) { GBX;
        for (int item = bx; item < 4096; item += G) mlstm_out_item(a, L, item);
        pg8::Gemm g{(const bf16*)(ws + OFF_UG), (const bf16*)(ws + OFF_S5M), 1152, 1152, 1152}; S5YOrder S{G, bx};
        EpiS5Y E{(const bf16*)(ws + OFF_UG), a.in[I_DSKIP], (bf16*)(ws + OFF_YSG)};
        pg8::gemm_phase<EpiS5Y, S5YOrder, true, true>(L, g, S, E);
    }
    SEAM(4);
    if (IN(5)) { GBX;
        pg8::Gemm g{(const bf16*)(ws + OFF_YSG), (const bf16*)(ws + OFF_WGLU), 512, 512, 512}; pg8::StaticOrder S; S.init(T, 512, G, bx);
        EpiGlu E{(const bf16*)(ws + OFF_YSG), a.in[I_BGLU], (bf16*)(ws + OFF_H1)};
        pg8::gemm_phase<EpiGlu, pg8::StaticOrder, true, true>(L, g, S, E);
    }
    SEAM(5);
    if (IN(6)) { GBX;
        pg8::Gemm g{(const bf16*)(ws + OFF_H1), (const bf16*)(ws + OFF_WOUT), 1024, 1024, 1024}; pg8::StaticOrder S; S.init(T, 1024, G, bx);
        EpiOut E{a.in[I_X], a.out};
        pg8::gemm_phase<EpiOut, pg8::StaticOrder, true, true>(L, g, S, E);
    }
    SEAM(6);
    if (IN(7)) { GBX; phase7(a, L, G); }
    SEAM(7);
    if (IN(8)) { GBX; phase8(a, L, G); }
    SEAM(8);
#pragma unroll 1
    for (int hf = 0; hf < 2; ++hf) {
        const int pb = 9 + 3 * hf;
        if (IN(pb)) { GBX; const size_t rA = hf ? OFF_R2 : OFF_R1, rB = hf ? OFF_R1 : OFF_R2;
            const int ntile = ((const int*)(ws + OFF_NTILE))[hf];
            pg8::Gemm g{(const bf16*)(ws + rA), (const bf16*)(ws + OFF_WGU), 1024, 1024, 1024}; MoeOrder S{(const int*)(ws + OFF_TILEE) + hf * 1024, ntile, 8, G, bx};
            EpiMoeGU E{a.in[I_BGU], (bf16*)(ws + rB)};
            pg8::gemm_phase<EpiMoeGU, MoeOrder, true, true>(L, g, S, E);
        }
        SEAM(pb);
        if (IN(pb + 1)) { GBX; const size_t rA = hf ? OFF_R2 : OFF_R1, rB = hf ? OFF_R1 : OFF_R2;
            const int ntile = ((const int*)(ws + OFF_NTILE))[hf];
            pg8::Gemm g{(const bf16*)(ws + rB), (const bf16*)(ws + OFF_WDN), 1024, 1024, 1024}; MoeOrder S{(const int*)(ws + OFF_TILEE) + hf * 1024, ntile, 4, G, bx};
            EpiMoeDN E{a.in[I_BDN], (const float*)(ws + OFF_RGATE) + hf * RCAP, (bf16*)(ws + rA)};
            pg8::gemm_phase<EpiMoeDN, MoeOrder, true, true>(L, g, S, E);
        }
        SEAM(pb + 1);
        if (IN(pb + 2)) { GBX; const size_t rA = hf ? OFF_R2 : OFF_R1;
            combine_half(a, hf, (const bf16*)(ws + rA), G);
            if (hf == 0) { LAS int* tot = (LAS int*)L; LAS int* pst = tot + 64; LAS int* base = pst + 64; place_preamble(a, tot, pst, false);
                for (int u = bx; u < 256; u += G) gather_unit(a, pst, base, 1, u, (bf16*)(ws + OFF_R2)); }
        }
        if (hf == 0) SEAM(pb + 2);
    }
#undef IN
#undef SEAM
#undef GBX
}

extern "C" void kernel_launch(void* const* d_in, const int* in_sizes, int n_in, void* d_out, int out_size, void* d_ws, size_t ws_size, hipStream_t stream) {
    static int grid = 0;
    if (grid == 0) {
        if (n_in != 26 || out_size != T * DM || ws_size < WS_NEED) { fprintf(stderr, "kernel_launch: unexpected problem (n_in %d, out %d, ws %zu)\n", n_in, out_size, ws_size); grid = -1; return; }
        int dev = 0, cus = 0, per_cu = 0;
        (void)hipGetDevice(&dev); (void)hipDeviceGetAttribute(&cus, hipDeviceAttributeMultiprocessorCount, dev);
        if (hipFuncSetAttribute((const void*)mk_fwd, hipFuncAttributeMaxDynamicSharedMemorySize, LDS_BYTES) != hipSuccess) { fprintf(stderr, "kernel_launch: hipFuncSetAttribute failed\n"); grid = -1; return; }
        if (hipOccupancyMaxActiveBlocksPerMultiprocessor(&per_cu, (const void*)mk_fwd, 512, LDS_BYTES) != hipSuccess || per_cu < 1) { fprintf(stderr, "kernel_launch: occupancy query says %d\n", per_cu); per_cu = 1; }
        (void)hipGetLastError();
        grid = cus;
    }
    if (grid < 0) return;
    KArgs a{};
    for (int i = 0; i < 26; ++i) a.in[i] = (const float*)d_in[i];
    a.out = (float*)d_out; a.ws = (unsigned char*)d_ws;
#if MK_SINGLE
    a.ph_lo = 0; a.ph_hi = NPH;
    void* args[] = {&a};
    hipError_t e = hipLaunchCooperativeKernel((const void*)mk_fwd, dim3(grid), dim3(512), args, LDS_BYTES, stream);
    if (e != hipSuccess) fprintf(stderr, "cooperative launch failed: %s (grid %d)\n", hipGetErrorString(e), grid);
#else
    for (int p = 0; p < NPH; ++p) { a.ph_lo = p; a.ph_hi = p + 1; hipLaunchKernelGGL(mk_fwd, dim3(grid), dim3(512), LDS_BYTES, stream, a); }
#endif
}
```

```cpp
#include <hip/hip_runtime.h>
#include <hip/hip_cooperative_groups.h>
#include <cstdio>
#include <cstdint>
namespace cg = cooperative_groups;
__device__ __forceinline__ int otid() { int t = (int)threadIdx.x; asm volatile("" : "+v"(t)); return t; }

namespace pg8 {
#define PG8_LAS __attribute__((address_space(3)))
typedef unsigned short bf16_t;
typedef short bf16x8 __attribute__((ext_vector_type(8)));
typedef float f32x4 __attribute__((ext_vector_type(4)));
typedef unsigned u32x4 __attribute__((ext_vector_type(4)));
constexpr int BM = 256, BK = 64, HALF = 128, HTB = HALF * BK * 2  , STAGE_BYTES = 8 * HTB, NXCD = 8, WGM = 8;

__host__ __device__ __forceinline__ int lds_byte(int r, int c) { const int st = (r >> 4) * 2 + (c >> 5), rr = r & 15, cc = c & 31, ob = rr * 64 + cc * 2; return st * 1024 + (ob ^ (((ob >> 9) & 1) << 5)); }
__host__ __device__ __forceinline__ void stage_rc(int b, int& R, int& C) { const int st = b / 1024, sb = b % 1024, swz = sb ^ (((sb >> 9) & 1) << 5); R = (st >> 1) * 16 + swz / 64; C = (st & 1) * 32 + (swz % 64) / 2; }
__host__ __device__ __forceinline__ int perm32(int rho) { const int n = rho >> 4, i = rho & 15; return 8 * (i >> 2) + 4 * n + (i & 3); }

struct Unit { int pm, pn; };
struct Gemm { const bf16_t* A; const bf16_t* Bt; int lda, ldb, K; };

struct StaticOrder {
    int nM, nN, nwg, G, c;
    __host__ __device__ void init(int M, int N, int G_, int c_) { nM = M / BM; nN = N / BM; nwg = nM * nN; G = G_; c = c_; }
    __host__ __device__ bool next(int i, Unit& u) const {
        const long L = (long)i * G + c; if (L >= nwg) return false;
        int wgid = (int)L; { const int q = nwg / NXCD, r = nwg % NXCD, xcd = wgid % NXCD, off = wgid / NXCD; wgid = (xcd < r ? xcd * (q + 1) : r * (q + 1) + (xcd - r) * q) + off; }
        const int nig = WGM * nN, gid = wgid / nig, fm = gid * WGM, gsz = (nM - fm) < WGM ? (nM - fm) : WGM;
        u.pm = fm + ((wgid % nig) % gsz); u.pn = (wgid % nig) / gsz; return true;
    }
    __device__ __forceinline__ void a_ready(const Unit&) const {}
    __device__ __forceinline__ void done(const Unit&) const {}
};

__device__ __forceinline__ unsigned cvt_pk_bf16(float lo, float hi) { unsigned r; asm volatile("v_cvt_pk_bf16_f32 %0, %1, %2" : "=v"(r) : "v"(lo), "v"(hi)); return r; }

template <class Epi, class Sched, bool ALIGN_EPI = false, bool SP2 = false>
__device__ __forceinline__ void gemm_phase(PG8_LAS unsigned char* lds, const Gemm g, const Sched& S, const Epi& E) {
    const int tid = otid(), wid = __builtin_amdgcn_readfirstlane(tid >> 6), lane = tid & 63, wr = wid >> 2, wc = wid & 3, fr = lane & 15, fq = lane >> 4;
    const int K = g.K, nt = K / BK;
    unsigned voffA[2], voffB[2];
#pragma unroll
    for (int i = 0; i < 2; ++i) { int R, C; stage_rc(tid * 16 + i * 8192, R, C); const int Rb = Epi::PERM ? ((R & ~31) + perm32(R & 31)) : R;
        voffA[i] = (unsigned)(R * g.lda + C) * 2u; voffB[i] = (unsigned)(Rb * g.ldb + C) * 2u; }
    const size_t kstep = (size_t)(BK * 2);
    const size_t hstepA = (size_t)HALF * g.lda * 2, hstepB = (size_t)HALF * g.ldb * 2;
    const size_t tstepA = 2 * hstepA, tstepB = 2 * hstepB;
    const unsigned ldsw = (unsigned)wid * 1024u;
    const int aoff = lds_byte(wr * 64 + fr, fq * 8), boff = lds_byte(wc * 32 + fr, fq * 8);
#define PG8_SA(b, h) (((b) * 2 + (h)) * HTB)
#define PG8_SB(b, h) ((4 + (b) * 2 + (h)) * HTB)
#define PG8_STAGE(bufoff, gbase, voff) do { _Pragma("unroll") for (int _i = 0; _i < 2; ++_i) \
        __builtin_amdgcn_global_load_lds((const unsigned*)((const char*)(gbase) + (voff)[_i]), (PG8_LAS unsigned*)(lds + (bufoff) + ldsw + _i * 8192), 16, 0, 0); } while (0)
#define PG8_LDA(dst, b, h) do { _Pragma("unroll") for (int m = 0; m < 4; ++m) _Pragma("unroll") for (int k = 0; k < 2; ++k) dst[m][k] = *(const PG8_LAS bf16x8*)(lds + PG8_SA(b, h) + aoff + m * 2048 + k * 1024); } while (0)
#define PG8_LDB(dst, b, h) do { _Pragma("unroll") for (int n = 0; n < 2; ++n) _Pragma("unroll") for (int k = 0; k < 2; ++k) dst[n][k] = *(const PG8_LAS bf16x8*)(lds + PG8_SB(b, h) + boff + n * 2048 + k * 1024); } while (0)
#define PG8_MMA(ai, bj, At, Bt) do { __builtin_amdgcn_s_setprio(1); _Pragma("unroll") for (int m = 0; m < 4; ++m) _Pragma("unroll") for (int n = 0; n < 2; ++n) _Pragma("unroll") for (int k = 0; k < 2; ++k) \
        acc[ai][bj][m][n] = __builtin_amdgcn_mfma_f32_16x16x32_bf16(Bt[n][k], At[m][k], acc[ai][bj][m][n], 0, 0, 0); __builtin_amdgcn_s_setprio(0); } while (0)
#define PG8_WAIT_V(n) asm volatile("s_waitcnt vmcnt(" #n ")" ::: "memory")
#define PG8_WAIT_L(n) asm volatile("s_waitcnt lgkmcnt(" #n ")" ::: "memory")
#define PG8_BAR __builtin_amdgcn_s_barrier()
#define PG8_SCHED __builtin_amdgcn_sched_barrier(0)
    Unit cur, nxt; int ui = 0;
    if (!S.next(0, cur)) return;
    f32x4 acc[2][2][4][2];
#pragma unroll
    for (int a = 0; a < 2; ++a)
#pragma unroll
        for (int b = 0; b < 2; ++b)
#pragma unroll
            for (int m = 0; m < 4; ++m)
#pragma unroll
                for (int n = 0; n < 2; ++n) acc[a][b][m][n] = (f32x4){0.f, 0.f, 0.f, 0.f};
    bf16x8 At[4][2], B0[2][2], B1[2][2];
    const char* cA = (const char*)g.A + (size_t)cur.pm * tstepA; const char* cB = (const char*)g.Bt + (size_t)cur.pn * tstepB;
    S.a_ready(cur);
    if constexpr (SP2) {
        PG8_STAGE(PG8_SB(0, 0), cB, voffB); PG8_STAGE(PG8_SB(0, 1), cB + hstepB, voffB); PG8_STAGE(PG8_SA(0, 0), cA, voffA); PG8_STAGE(PG8_SA(0, 1), cA + hstepA, voffA);
        if (wr == 1) PG8_BAR;
        PG8_WAIT_V(2); PG8_BAR;
        PG8_STAGE(PG8_SB(1, 0), cB + kstep, voffB); PG8_STAGE(PG8_SA(1, 0), cA + kstep, voffA); PG8_STAGE(PG8_SB(1, 1), cB + hstepB + kstep, voffB);
        PG8_WAIT_V(6); PG8_BAR;
    } else {
        PG8_STAGE(PG8_SB(0, 0), cB, voffB); PG8_STAGE(PG8_SA(0, 0), cA, voffA); PG8_STAGE(PG8_SB(0, 1), cB + hstepB, voffB); PG8_STAGE(PG8_SA(0, 1), cA + hstepA, voffA);
        if (wr == 1) PG8_BAR;
        PG8_WAIT_V(4); PG8_BAR;
        PG8_STAGE(PG8_SB(1, 0), cB + kstep, voffB); PG8_STAGE(PG8_SA(1, 0), cA + kstep, voffA); PG8_STAGE(PG8_SB(1, 1), cB + hstepB + kstep, voffB);
        PG8_WAIT_V(6); PG8_BAR;
    }
    for (;;) {
        const bool has_next = S.next(ui + 1, nxt);
        const char* nA = has_next ? (const char*)g.A + (size_t)nxt.pm * tstepA : cA; const char* nB = has_next ? (const char*)g.Bt + (size_t)nxt.pn * tstepB : cB;
        for (int t = 0; t < nt; t += 2) {
            const bool last = (t == nt - 2);
            const char* a1 = cA + (size_t)(t + 1) * kstep;
            const char* a2 = last ? nA : cA + (size_t)(t + 2) * kstep; const char* b2 = last ? nB : cB + (size_t)(t + 2) * kstep;
            const char* a3 = a2 + kstep; const char* b3 = b2 + kstep;
            if (last && has_next) S.a_ready(nxt);
            if constexpr (SP2) {
            PG8_LDB(B0, 0, 0); PG8_LDB(B1, 0, 1); PG8_SCHED; PG8_LDA(At, 0, 0); PG8_STAGE(PG8_SA(1, 1), a1 + hstepA, voffA);
            PG8_WAIT_V(8); PG8_WAIT_L(0); PG8_BAR; PG8_MMA(0, 0, At, B0); PG8_MMA(0, 1, At, B1); PG8_BAR; PG8_SCHED;
            PG8_LDA(At, 0, 1); PG8_STAGE(PG8_SB(0, 0), b2, voffB); PG8_STAGE(PG8_SB(0, 1), b2 + hstepB, voffB); PG8_STAGE(PG8_SA(0, 0), a2, voffA);
            PG8_WAIT_V(8); PG8_WAIT_L(0); PG8_BAR; PG8_MMA(1, 0, At, B0); PG8_MMA(1, 1, At, B1); PG8_BAR; PG8_SCHED;
            PG8_LDB(B0, 1, 0); PG8_LDB(B1, 1, 1); PG8_SCHED; PG8_LDA(At, 1, 0); PG8_STAGE(PG8_SA(0, 1), a2 + hstepA, voffA);
            PG8_WAIT_V(8); PG8_WAIT_L(0); PG8_BAR; PG8_MMA(0, 0, At, B0); PG8_MMA(0, 1, At, B1); PG8_BAR; PG8_SCHED;
            PG8_LDA(At, 1, 1); PG8_STAGE(PG8_SB(1, 0), b3, voffB); PG8_STAGE(PG8_SB(1, 1), b3 + hstepB, voffB); PG8_STAGE(PG8_SA(1, 0), a3, voffA);
            PG8_WAIT_V(8); PG8_WAIT_L(0); PG8_BAR; PG8_MMA(1, 0, At, B0); PG8_MMA(1, 1, At, B1); PG8_BAR; PG8_SCHED;
            } else {
            PG8_LDB(B0, 0, 0); PG8_SCHED; PG8_LDA(At, 0, 0); PG8_STAGE(PG8_SA(1, 1), a1 + hstepA, voffA);
            PG8_WAIT_L(8); PG8_BAR; PG8_WAIT_L(0); PG8_MMA(0, 0, At, B0); PG8_BAR; PG8_SCHED;
            PG8_LDB(B1, 0, 1); PG8_STAGE(PG8_SB(0, 0), b2, voffB);
            PG8_BAR; PG8_WAIT_L(0); PG8_MMA(0, 1, At, B1); PG8_BAR;
            PG8_LDA(At, 0, 1); PG8_STAGE(PG8_SA(0, 0), a2, voffA);
            PG8_BAR; PG8_WAIT_L(0); PG8_MMA(1, 0, At, B0); PG8_BAR; PG8_SCHED;
            PG8_STAGE(PG8_SB(0, 1), b2 + hstepB, voffB);
            PG8_WAIT_V(6); PG8_BAR; PG8_MMA(1, 1, At, B1); PG8_BAR;
            PG8_LDB(B0, 1, 0); PG8_SCHED; PG8_LDA(At, 1, 0); PG8_STAGE(PG8_SA(0, 1), a2 + hstepA, voffA);
            PG8_WAIT_L(8); PG8_BAR; PG8_WAIT_L(0); PG8_MMA(0, 0, At, B0); PG8_BAR; PG8_SCHED;
            PG8_LDB(B1, 1, 1); PG8_STAGE(PG8_SB(1, 0), b3, voffB);
            PG8_BAR; PG8_WAIT_L(0); PG8_MMA(0, 1, At, B1); PG8_BAR;
            PG8_LDA(At, 1, 1); PG8_STAGE(PG8_SA(1, 0), a3, voffA);
            PG8_BAR; PG8_WAIT_L(0); PG8_MMA(1, 0, At, B0); PG8_BAR; PG8_SCHED;
            PG8_STAGE(PG8_SB(1, 1), b3 + hstepB, voffB);
            PG8_WAIT_V(6); PG8_BAR; PG8_MMA(1, 1, At, B1); PG8_BAR;
            }
        }
        if constexpr (ALIGN_EPI) { if (wr == 0) PG8_BAR; }
        E(acc, cur, wr, wc, fr, fq); S.done(cur);
        if (!has_next) break;
#pragma unroll
        for (int a = 0; a < 2; ++a)
#pragma unroll
            for (int b = 0; b < 2; ++b)
#pragma unroll
                for (int m = 0; m < 4; ++m)
#pragma unroll
                    for (int n = 0; n < 2; ++n) acc[a][b][m][n] = (f32x4){0.f, 0.f, 0.f, 0.f};
        cur = nxt; cA = nA; cB = nB; ++ui;
        if constexpr (ALIGN_EPI) { if (wr == 1) PG8_BAR; }
    }
    PG8_WAIT_V(0);
    if constexpr (!ALIGN_EPI) { if (wr == 0) PG8_BAR; }
    PG8_BAR;
#undef PG8_SA
#undef PG8_SB
#undef PG8_STAGE
#undef PG8_LDA
#undef PG8_LDB
#undef PG8_MMA
#undef PG8_WAIT_V
#undef PG8_WAIT_L
#undef PG8_BAR
#undef PG8_SCHED
}
}

#define LAS __attribute__((address_space(3)))
typedef unsigned short bf16;
typedef float f4 __attribute__((ext_vector_type(4)));
typedef float f2 __attribute__((ext_vector_type(2)));
typedef float f32x16 __attribute__((ext_vector_type(16)));
typedef short bf16x8 __attribute__((ext_vector_type(8)));
typedef unsigned v4u __attribute__((ext_vector_type(4)));
typedef unsigned v2u __attribute__((ext_vector_type(2)));

constexpr int T = 65536, DM = 1024, SEQ = 8192, NPROJ = 2568;
constexpr int NE = 32;
constexpr float EPS = 1e-6f;
constexpr int NPH = 15;
constexpr int RCAP = 139264;
constexpr int LDS_BYTES = 155648;

constexpr size_t MiB = (size_t)1 << 20;
constexpr size_t OFF_GATES = 1 * MiB, OFF_MLG = 3 * MiB, OFF_MLA = 3 * MiB + 16384, OFF_MLM = 3 * MiB + 32768;
constexpr size_t OFF_MLNP = 4 * MiB, OFF_MLN = 6 * MiB, OFF_KT = 8 * MiB, OFF_S5E = 10 * MiB, OFF_RSTD2 = 26 * MiB;
constexpr size_t OFF_ENTE = 27 * MiB, OFF_ENTG = 28 * MiB, OFF_ENTR = 29 * MiB, OFF_SDEST = 30 * MiB;
constexpr size_t OFF_CNT = 31 * MiB, OFF_TILEE = 31 * MiB + 65536, OFF_NTILE = 31 * MiB + 131072, OFF_RGATE = 32 * MiB;
constexpr size_t OFF_WIN = 64 * MiB, OFF_WGLU = 70 * MiB, OFF_WOUT = 71 * MiB, OFF_WGU = 74 * MiB, OFF_WDN = 202 * MiB;
constexpr size_t OFF_S5M = 266 * MiB, OFF_S5P = 338 * MiB, OFF_H1 = 354 * MiB, OFF_QK = 482 * MiB, OFF_V = 610 * MiB, OFF_O = 674 * MiB, OFF_UG = 738 * MiB, OFF_YSG = 810 * MiB;
constexpr size_t OFF_R1 = 266 * MiB, OFF_R2 = 538 * MiB, WS_NEED = 874 * MiB;
constexpr size_t OUT_UP = 0, OUT_CST = 134217728;

struct KArgs { const float* in[26]; float* out; unsigned char* ws; int ph_lo, ph_hi; };
enum { I_X = 0, I_N1G, I_WIN, I_BIF, I_CONVW, I_CONVB, I_HNG, I_LRE, I_LIM, I_LDT, I_BRE, I_BIM, I_CRE, I_CIM, I_DSKIP, I_WGLU, I_BGLU, I_WOUT, I_N2G, I_WR, I_BR, I_WGU, I_BGU, I_WDN, I_BDN, I_NFG };

__device__ __forceinline__ unsigned f2bf(float f) { unsigned u = __builtin_bit_cast(unsigned, f); return (u + 0x7fffu + ((u >> 16) & 1u)) >> 16; }
__device__ __forceinline__ unsigned pk2(float lo, float hi) { return f2bf(lo) | (f2bf(hi) << 16); }
__device__ __forceinline__ float bf2f(unsigned b) { return __builtin_bit_cast(float, b << 16); }
__device__ __forceinline__ float bflo(unsigned w) { return __builtin_bit_cast(float, w << 16); }
__device__ __forceinline__ float bfhi(unsigned w) { return __builtin_bit_cast(float, w & 0xffff0000u); }
__device__ __forceinline__ float wave_sum(float v) {
#pragma unroll
    for (int o = 1; o < 64; o <<= 1) v += __shfl_xor(v, o);
    return v;
}
__device__ __forceinline__ float wave_max(float v) {
#pragma unroll
    for (int o = 1; o < 64; o <<= 1) v = fmaxf(v, __shfl_xor(v, o));
    return v;
}
__device__ __forceinline__ float sigmoidf_(float x) { return 1.f / (1.f + __expf(-x)); }
__device__ __forceinline__ float siluf_(float x) { return x / (1.f + __expf(-x)); }
__device__ __forceinline__ float logsigmoidf_(float x) { return x >= 0.f ? -log1pf(expf(-x)) : x - log1pf(expf(x)); }
__device__ __forceinline__ float gelu_tanh(float x) { const float z = 0.7978845608028654f * (x + 0.044715f * x * x * x); const float e = __expf(2.f * z); return 0.5f * x * (2.f - 2.f / (e + 1.f)); }
#define LDS_WAIT() asm volatile("s_waitcnt lgkmcnt(0)" ::: "memory")

__device__ __forceinline__ void tr_item(const float* Wsrc, int ldw, bf16* WTdst, int ldt, int k0, LAS float* scr, int lane) {
#pragma unroll 8
    for (int i = 0; i < 32; ++i) { const int kk = 2 * i + (lane >> 5); scr[kk * 33 + (lane & 31)] = Wsrc[(size_t)(k0 + kk) * ldw + (lane & 31)]; }
    LDS_WAIT(); asm volatile("" ::: "memory");
    const int c = lane & 7;
#pragma unroll
    for (int j = 0; j < 4; ++j) { const int n = (lane >> 3) + 8 * j; const LAS float* s = scr + (8 * c) * 33 + n;
        v4u o; o.x = pk2(s[0 * 33], s[1 * 33]); o.y = pk2(s[2 * 33], s[3 * 33]); o.z = pk2(s[4 * 33], s[5 * 33]); o.w = pk2(s[6 * 33], s[7 * 33]);
        *(v4u*)(WTdst + (size_t)n * ldt + k0 + 8 * c) = o; }
    LDS_WAIT(); asm volatile("" ::: "memory");
}

__device__ __forceinline__ void lam_pow(float lre, float lim, float dt, int n, float& re, float& im) {
    const float mag = expf(lre * dt * (float)n);
    double th = (double)lim * (double)dt * (double)n;
    th -= 6.283185307179586476925 * rint(th * 0.15915494309189533577);
    float s, c; sincosf((float)th, &s, &c);
    re = mag * c; im = mag * s;
}

__device__ __forceinline__ void phase0(const KArgs& a, LAS unsigned char* L, int G) {
    const int tid = otid(), lane = tid & 63, wave = tid >> 6;
    const int gw = blockIdx.x * 8 + wave, NGW = G * 8;
    unsigned char* ws = a.ws;
    {
        LAS float* scr = (LAS float*)(L + wave * 8448);
        constexpr int N_IN = 16 * 80, N_GLU = 8 * 16, N_OUT = 16 * 32, N_GU = 32 * 16 * 64, N_DN = 32 * 16 * 32;
        constexpr int NITEMS = N_IN + N_GLU + N_OUT + N_GU + N_DN;
        for (int it = gw; it < NITEMS; it += NGW) {
            int r = it;
            if (r < N_IN) { const int kb = r / 80, nb = r % 80, n0 = 32 * nb, sc = n0 < 2048 ? n0 : n0 + 8;
                tr_item(a.in[I_WIN] + sc, NPROJ, (bf16*)(ws + OFF_WIN) + (size_t)n0 * 1024, 1024, 64 * kb, scr, lane); continue; } r -= N_IN;
            if (r < N_GLU) { const int kb = r / 16, nb = r % 16, n0 = 32 * nb;
                tr_item(a.in[I_WGLU] + n0, 512, (bf16*)(ws + OFF_WGLU) + (size_t)n0 * 512, 512, 64 * kb, scr, lane); continue; } r -= N_GLU;
            if (r < N_OUT) { const int kb = r / 32, nb = r % 32, n0 = 32 * nb;
                tr_item(a.in[I_WOUT] + n0, 1024, (bf16*)(ws + OFF_WOUT) + (size_t)n0 * 1024, 1024, 64 * kb, scr, lane); continue; } r -= N_OUT;
            if (r < N_GU) { const int e = r / 1024, q = r % 1024, kb = q / 64, nb = q % 64, n0 = 32 * nb, pn = n0 >> 8, wi = n0 & 255;
                const int sc = wi < 128 ? 128 * pn + wi : 1024 + 128 * pn + (wi - 128);
                tr_item(a.in[I_WGU] + (size_t)e * 1024 * 2048 + sc, 2048, (bf16*)(ws + OFF_WGU) + ((size_t)e * 2048 + n0) * 1024, 1024, 64 * kb, scr, lane); continue; } r -= N_GU;
            { const int e = r / 512, q = r % 512, kb = q / 32, nb = q % 32, n0 = 32 * nb;
                tr_item(a.in[I_WDN] + (size_t)e * 1024 * 1024 + n0, 1024, (bf16*)(ws + OFF_WDN) + ((size_t)e * 1024 + n0) * 1024, 1024, 64 * kb, scr, lane); }
        }
    }
    __syncthreads();
    {
        const float* lre = a.in[I_LRE]; const float* lim = a.in[I_LIM]; const float* ldt = a.in[I_LDT];
        const float* bre = a.in[I_BRE]; const float* bim = a.in[I_BIM]; const float* cre = a.in[I_CRE]; const float* cim = a.in[I_CIM];
        const int gt = blockIdx.x * 512 + tid, GT = G * 512;
        float* KT = (float*)(ws + OFF_KT);
        for (int task = gt; task < 32 * 64 * 16; task += GT) {
            const int g = task >> 10, tau = (task >> 4) & 63, i = task & 15;
            const float dt = expf(ldt[g]);
            float acc[16];
#pragma unroll
            for (int j = 0; j < 16; ++j) acc[j] = 0.f;
            for (int p = 0; p < 64; ++p) {
                const float lr = lre[g * 64 + p], li = lim[g * 64 + p];
                float pr, pi; lam_pow(lr, li, dt, tau, pr, pi);
                float l1r, l1i; lam_pow(lr, li, dt, 1, l1r, l1i);
                const float nr = l1r - 1.f, ni = l1i, den = lr * lr + li * li;
                const float fr = (nr * lr + ni * li) / den, fi = (ni * lr - nr * li) / den;
                const float cr = cre[(g * 16 + i) * 64 + p], ci = cim[(g * 16 + i) * 64 + p];
                const float zr = cr * pr - ci * pi, zi = cr * pi + ci * pr;
                const float yr = zr * fr - zi * fi, yi = zr * fi + zi * fr;
                const f4* br4 = (const f4*)(bre + (size_t)(g * 64 + p) * 16); const f4* bi4 = (const f4*)(bim + (size_t)(g * 64 + p) * 16);
#pragma unroll
                for (int q = 0; q < 4; ++q) { const f4 x = br4[q], y = bi4[q];
                    acc[4 * q + 0] += yr * x.x - yi * y.x; acc[4 * q + 1] += yr * x.y - yi * y.y; acc[4 * q + 2] += yr * x.z - yi * y.z; acc[4 * q + 3] += yr * x.w - yi * y.w; }
            }
            f4* o = (f4*)(KT + (size_t)task * 16);
#pragma unroll
            for (int q = 0; q < 4; ++q) o[q] = (f4){acc[4 * q], acc[4 * q + 1], acc[4 * q + 2], acc[4 * q + 3]};
        }
        bf16* S5P = (bf16*)(ws + OFF_S5P);
        for (int task = gt; task < 32 * 64 * 64; task += GT) {
            const int g = task >> 12, p = (task >> 6) & 63, s = task & 63;
            const float dt = expf(ldt[g]); const float lr = lre[g * 64 + p], li = lim[g * 64 + p];
            float pr, pi; lam_pow(lr, li, dt, 63 - s, pr, pi);
            float l1r, l1i; lam_pow(lr, li, dt, 1, l1r, l1i);
            const float nr = l1r - 1.f, ni = l1i, den = lr * lr + li * li;
            const float fr = (nr * lr + ni * li) / den, fi = (ni * lr - nr * li) / den;
            const float yr = pr * fr - pi * fi, yi = pr * fi + pi * fr;
            const float* br = bre + (size_t)(g * 64 + p) * 16; const float* bi = bim + (size_t)(g * 64 + p) * 16;
            unsigned ore[8], oim[8];
#pragma unroll
            for (int j = 0; j < 8; ++j) { const float x0 = br[2 * j], y0 = bi[2 * j], x1 = br[2 * j + 1], y1 = bi[2 * j + 1];
                ore[j] = pk2(yr * x0 - yi * y0, yr * x1 - yi * y1); oim[j] = pk2(yr * y0 + yi * x0, yr * y1 + yi * x1); }
            v4u* d0 = (v4u*)(S5P + ((size_t)(g * 256 + 2 * p) * 1024 + s * 16)); v4u* d1 = (v4u*)(S5P + ((size_t)(g * 256 + 2 * p + 1) * 1024 + s * 16));
            d0[0] = (v4u){ore[0], ore[1], ore[2], ore[3]}; d0[1] = (v4u){ore[4], ore[5], ore[6], ore[7]};
            d1[0] = (v4u){oim[0], oim[1], oim[2], oim[3]}; d1[1] = (v4u){oim[4], oim[5], oim[6], oim[7]};
        }
        for (int task = gt; task < 32 * 128 * 128; task += GT) {
            const int g = task >> 14, r = (task >> 7) & 127, c8 = task & 127;
            *(v4u*)(S5P + ((size_t)(g * 256 + 128 + r) * 1024 + c8 * 8)) = (v4u){0u, 0u, 0u, 0u};
        }
        bf16* S5M = (bf16*)(ws + OFF_S5M);
        for (int task = gt; task < 32 * 64 * 64; task += GT) {
            const int g = task >> 12, t = (task >> 6) & 63, p = task & 63;
            const float dt = expf(ldt[g]); const float lr = lre[g * 64 + p], li = lim[g * 64 + p];
            float pr, pi; lam_pow(lr, li, dt, t + 1, pr, pi);
#pragma unroll
            for (int i = 0; i < 16; ++i) { const float cr = cre[(g * 16 + i) * 64 + p], ci = cim[(g * 16 + i) * 64 + p];
                *(unsigned*)(S5M + ((size_t)(g * 1024 + t * 16 + i) * 1152 + 1024 + 2 * p)) = pk2(cr * pr - ci * pi, -(cr * pi + ci * pr)); }
        }
    }
    {
        LAS float* wif = (LAS float*)(L + 69632);
        const float* win = a.in[I_WIN];
        for (int idx = tid; idx < 8192; idx += 512) wif[idx] = win[(size_t)(idx >> 3) * NPROJ + 2048 + (idx & 7)];
        __syncthreads();
        const float* x = a.in[I_X]; const float* g1 = a.in[I_N1G]; const float* bif = a.in[I_BIF];
        bf16* H1 = (bf16*)(ws + OFF_H1); float* GATES = (float*)(ws + OFF_GATES);
        f4 gv[4];
#pragma unroll
        for (int j = 0; j < 4; ++j) gv[j] = ((const f4*)g1)[lane + 64 * j];
        for (int m = gw; m < T; m += NGW) {
            const f4* xr = (const f4*)(x + (size_t)m * DM) + lane;
            f4 v[4]; float ss = 0.f;
#pragma unroll
            for (int j = 0; j < 4; ++j) { v[j] = xr[64 * j]; ss += (v[j].x * v[j].x + v[j].y * v[j].y) + (v[j].z * v[j].z + v[j].w * v[j].w); }
            const float rstd = rsqrtf(wave_sum(ss) * (1.f / DM) + EPS);
            float ga[8];
#pragma unroll
            for (int c = 0; c < 8; ++c) ga[c] = 0.f;
            unsigned long long* o8 = (unsigned long long*)(H1 + (size_t)m * DM) + lane;
#pragma unroll
            for (int j = 0; j < 4; ++j) { v[j] = v[j] * rstd * gv[j];
                o8[64 * j] = (unsigned long long)pk2(v[j].x, v[j].y) | ((unsigned long long)pk2(v[j].z, v[j].w) << 32);
#pragma unroll
                for (int e = 0; e < 4; ++e) { const int k = 4 * lane + 256 * j + e; const f4 w0 = *(const LAS f4*)(wif + k * 8), w1 = *(const LAS f4*)(wif + k * 8 + 4); const float hv = v[j][e];
                    ga[0] += hv * w0.x; ga[1] += hv * w0.y; ga[2] += hv * w0.z; ga[3] += hv * w0.w; ga[4] += hv * w1.x; ga[5] += hv * w1.y; ga[6] += hv * w1.z; ga[7] += hv * w1.w; }
            }
            float r4[4], r2[2], r1;
            { const bool hi = lane & 32;
#pragma unroll
              for (int i = 0; i < 4; ++i) { const float send = hi ? ga[i] : ga[i + 4], keep = hi ? ga[i + 4] : ga[i]; r4[i] = keep + __shfl_xor(send, 32); } }
            { const bool hi = lane & 16;
#pragma unroll
              for (int i = 0; i < 2; ++i) { const float send = hi ? r4[i] : r4[i + 2], keep = hi ? r4[i + 2] : r4[i]; r2[i] = keep + __shfl_xor(send, 16); } }
            { const bool hi = lane & 8; const float send = hi ? r2[0] : r2[1], keep = hi ? r2[1] : r2[0]; r1 = keep + __shfl_xor(send, 8); }
            r1 += __shfl_xor(r1, 4); r1 += __shfl_xor(r1, 2); r1 += __shfl_xor(r1, 1);
            if ((lane & 7) == 0) { const int c = (lane >> 3) & 7; GATES[(size_t)m * 8 + c] = r1 + bif[c]; }
        }
    }
}

__device__ __forceinline__ void s5_expand(const KArgs& a, int G) {
    const float* KT = (const float*)(a.ws + OFF_KT); bf16* S5M = (bf16*)(a.ws + OFF_S5M);
    const int gt = blockIdx.x * 512 + otid(), GT = G * 512;
    for (int task = gt; task < 32 * 1024 * 64; task += GT) {
        const int s = task & 63, row = task >> 6, g = row >> 10, t = (row >> 4) & 63, i = row & 15;
        v4u o0 = (v4u){0u, 0u, 0u, 0u}, o1 = o0;
        if (s <= t) { const f4* k4 = (const f4*)(KT + ((size_t)((g * 64 + (t - s)) * 16 + i)) * 16); const f4 a0 = k4[0], a1 = k4[1], a2 = k4[2], a3 = k4[3];
            o0 = (v4u){pk2(a0.x, a0.y), pk2(a0.z, a0.w), pk2(a1.x, a1.y), pk2(a1.z, a1.w)}; o1 = (v4u){pk2(a2.x, a2.y), pk2(a2.z, a2.w), pk2(a3.x, a3.y), pk2(a3.z, a3.w)}; }
        v4u* d = (v4u*)(S5M + ((size_t)row * 1152 + s * 16)); d[0] = o0; d[1] = o1;
    }
}

using pg8::Unit; using pg8::cvt_pk_bf16;
struct EpiInProj {
    static constexpr bool PERM = true;
    bf16 *QK, *V, *O, *UG;
    __device__ __forceinline__ void operator()(const pg8::f32x4 (&acc)[2][2][4][2], const Unit& u, int wr, int wc, int fr, int fq) const {
        const int row0 = u.pm * 256 + wr * 64 + fr, c0 = wc * 32 + 8 * fq;
#pragma unroll
        for (int ai = 0; ai < 2; ++ai)
#pragma unroll
            for (int m = 0; m < 4; ++m) { const int row = row0 + ai * 128 + m * 16;
#pragma unroll
                for (int bj = 0; bj < 2; ++bj) { const pg8::f32x4 v0 = acc[ai][bj][m][0], v1 = acc[ai][bj][m][1];
                    v4u w; w.x = cvt_pk_bf16(v0[0], v0[1]); w.y = cvt_pk_bf16(v0[2], v0[3]); w.z = cvt_pk_bf16(v1[0], v1[1]); w.w = cvt_pk_bf16(v1[2], v1[3]);
                    const int col = c0 + bj * 128;
                    bf16* dst;
                    if (u.pn < 4) dst = QK + (size_t)row * 1024 + u.pn * 256 + col;
                    else if (u.pn < 6) dst = V + (size_t)row * 512 + (u.pn - 4) * 256 + col;
                    else if (u.pn < 8) dst = O + (size_t)row * 512 + (u.pn - 6) * 256 + col;
                    else { const int uc = (u.pn - 8) * 256 + col, g = uc >> 4, j = uc & 15; dst = UG + ((size_t)(g * 1024 + (row >> 6)) * 1152 + (row & 63) * 16 + j); }
                    *(v4u*)dst = w; } }
    }
};
struct EpiS5E {
    static constexpr bool PERM = false;
    float* E;
    __device__ __forceinline__ void operator()(const pg8::f32x4 (&acc)[2][2][4][2], const Unit& u, int wr, int wc, int fr, int fq) const {
        const int row0 = u.pm * 256 + wr * 64 + fr, col0 = wc * 32 + 4 * fq;
#pragma unroll
        for (int ai = 0; ai < 2; ++ai)
#pragma unroll
            for (int m = 0; m < 4; ++m) { float* rowp = E + (size_t)(row0 + ai * 128 + m * 16) * 128 + col0;
#pragma unroll
                for (int n = 0; n < 2; ++n) *(pg8::f32x4*)(rowp + n * 16) = acc[ai][0][m][n]; }
    }
};
struct EpiS5Y {
    static constexpr bool PERM = true;
    const bf16* UG; const float* dskip; bf16* YSG;
    __device__ __forceinline__ void operator()(const pg8::f32x4 (&acc)[2][2][4][2], const Unit& u, int wr, int wc, int fr, int fq) const {
        const int g = u.pm >> 2, row0 = u.pm * 256 + wr * 64 + fr, c0 = (u.pn & 3) * 256 + wc * 32 + 8 * fq;
#pragma unroll
        for (int ai = 0; ai < 2; ++ai)
#pragma unroll
            for (int m = 0; m < 4; ++m) { const int row = row0 + ai * 128 + m * 16, chunk = row & 1023;
#pragma unroll
                for (int bj = 0; bj < 2; ++bj) { const int n = c0 + bj * 128, t = n >> 4, i0 = n & 15;
                    const v4u uw = *(const v4u*)(UG + ((size_t)row * 1152 + n));
                    const f4 d0 = *(const f4*)(dskip + g * 16 + i0), d1 = *(const f4*)(dskip + g * 16 + i0 + 4);
                    const pg8::f32x4 v0 = acc[ai][bj][m][0], v1 = acc[ai][bj][m][1];
                    float y[8];
                    y[0] = v0[0] + d0.x * bflo(uw.x); y[1] = v0[1] + d0.y * bfhi(uw.x); y[2] = v0[2] + d0.z * bflo(uw.y); y[3] = v0[3] + d0.w * bfhi(uw.y);
                    y[4] = v1[0] + d1.x * bflo(uw.z); y[5] = v1[1] + d1.y * bfhi(uw.z); y[6] = v1[2] + d1.z * bflo(uw.w); y[7] = v1[3] + d1.w * bfhi(uw.w);
#pragma unroll
                    for (int e = 0; e < 8; ++e) y[e] = gelu_tanh(y[e]);
                    v4u w; w.x = cvt_pk_bf16(y[0], y[1]); w.y = cvt_pk_bf16(y[2], y[3]); w.z = cvt_pk_bf16(y[4], y[5]); w.w = cvt_pk_bf16(y[6], y[7]);
                    *(v4u*)(YSG + ((size_t)(chunk * 64 + t) * 512 + g * 16 + i0)) = w; } }
    }
};
struct EpiGlu {
    static constexpr bool PERM = true;
    const bf16* YSG; const float* bglu; bf16* MIX;
    __device__ __forceinline__ void operator()(const pg8::f32x4 (&acc)[2][2][4][2], const Unit& u, int wr, int wc, int fr, int fq) const {
        const int row0 = u.pm * 256 + wr * 64 + fr, c0 = u.pn * 256 + wc * 32 + 8 * fq;
#pragma unroll
        for (int ai = 0; ai < 2; ++ai)
#pragma unroll
            for (int m = 0; m < 4; ++m) { const int row = row0 + ai * 128 + m * 16;
#pragma unroll
                for (int bj = 0; bj < 2; ++bj) { const int col = c0 + bj * 128;
                    const v4u yw = *(const v4u*)(YSG + (size_t)row * 512 + col);
                    const f4 b0 = *(const f4*)(bglu + col), b1 = *(const f4*)(bglu + col + 4);
                    const pg8::f32x4 v0 = acc[ai][bj][m][0], v1 = acc[ai][bj][m][1];
                    float y[8];
                    y[0] = bflo(yw.x) * sigmoidf_(v0[0] + b0.x); y[1] = bfhi(yw.x) * sigmoidf_(v0[1] + b0.y); y[2] = bflo(yw.y) * sigmoidf_(v0[2] + b0.z); y[3] = bfhi(yw.y) * sigmoidf_(v0[3] + b0.w);
                    y[4] = bflo(yw.z) * sigmoidf_(v1[0] + b1.x); y[5] = bfhi(yw.z) * sigmoidf_(v1[1] + b1.y); y[6] = bflo(yw.w) * sigmoidf_(v1[2] + b1.z); y[7] = bfhi(yw.w) * sigmoidf_(v1[3] + b1.w);
                    v4u w; w.x = cvt_pk_bf16(y[0], y[1]); w.y = cvt_pk_bf16(y[2], y[3]); w.z = cvt_pk_bf16(y[4], y[5]); w.w = cvt_pk_bf16(y[6], y[7]);
                    *(v4u*)(MIX + (size_t)row * 1024 + 512 + col) = w; } }
    }
};
struct EpiOut {
    static constexpr bool PERM = false;
    const float* X; float* X1;
    __device__ __forceinline__ void operator()(const pg8::f32x4 (&acc)[2][2][4][2], const Unit& u, int wr, int wc, int fr, int fq) const {
        const int row0 = u.pm * 256 + wr * 64 + fr, col0 = u.pn * 256 + wc * 32 + 4 * fq;
#pragma unroll
        for (int ai = 0; ai < 2; ++ai)
#pragma unroll
            for (int m = 0; m < 4; ++m) { const size_t off = (size_t)(row0 + ai * 128 + m * 16) * 1024 + col0;
#pragma unroll
                for (int bj = 0; bj < 2; ++bj)
#pragma unroll
                    for (int n = 0; n < 2; ++n) { const pg8::f32x4 xv = *(const pg8::f32x4*)(X + off + bj * 128 + n * 16); *(pg8::f32x4*)(X1 + off + bj * 128 + n * 16) = xv + acc[ai][bj][m][n]; } }
    }
};
struct EpiMoeGU {
    static constexpr bool PERM = true;
    const float* bgu; bf16* ACT;
    __device__ __forceinline__ void operator()(const pg8::f32x4 (&acc)[2][2][4][2], const Unit& u, int wr, int wc, int fr, int fq) const {
        const int e = u.pn >> 3, pnl = u.pn & 7, row0 = u.pm * 256 + wr * 64 + fr, c0 = pnl * 128 + wc * 32 + 8 * fq;
        const float* bg = bgu + (size_t)e * 2048 + c0; const float* bu = bg + 1024;
        const f4 g0 = *(const f4*)bg, g1 = *(const f4*)(bg + 4), u0 = *(const f4*)bu, u1 = *(const f4*)(bu + 4);
        const float gb[8] = {g0.x, g0.y, g0.z, g0.w, g1.x, g1.y, g1.z, g1.w}, ub[8] = {u0.x, u0.y, u0.z, u0.w, u1.x, u1.y, u1.z, u1.w};
#pragma unroll
        for (int ai = 0; ai < 2; ++ai)
#pragma unroll
            for (int m = 0; m < 4; ++m) { const int row = row0 + ai * 128 + m * 16;
                float y[8];
#pragma unroll
                for (int n = 0; n < 2; ++n)
#pragma unroll
                    for (int q = 0; q < 4; ++q) { const int k = 4 * n + q;
                        const float gate = fminf(acc[ai][0][m][n][q] + gb[k], 7.0f); const float up = fminf(fmaxf(acc[ai][1][m][n][q] + ub[k], -7.0f), 7.0f);
                        y[k] = (up + 1.0f) * gate * sigmoidf_(1.702f * gate); }
                v4u w; w.x = cvt_pk_bf16(y[0], y[1]); w.y = cvt_pk_bf16(y[2], y[3]); w.z = cvt_pk_bf16(y[4], y[5]); w.w = cvt_pk_bf16(y[6], y[7]);
                *(v4u*)(ACT + (size_t)row * 1024 + c0) = w; }
    }
};
struct EpiMoeDN {
    static constexpr bool PERM = true;
    const float* bdn; const float* rgate; bf16* YS;
    __device__ __forceinline__ void operator()(const pg8::f32x4 (&acc)[2][2][4][2], const Unit& u, int wr, int wc, int fr, int fq) const {
        const int e = u.pn >> 2, pnl = u.pn & 3, row0 = u.pm * 256 + wr * 64 + fr, c0 = pnl * 256 + wc * 32 + 8 * fq;
#pragma unroll
        for (int bj = 0; bj < 2; ++bj) { const int col = c0 + bj * 128;
            const f4 b0 = *(const f4*)(bdn + (size_t)e * 1024 + col), b1 = *(const f4*)(bdn + (size_t)e * 1024 + col + 4);
#pragma unroll
            for (int ai = 0; ai < 2; ++ai)
#pragma unroll
                for (int m = 0; m < 4; ++m) { const int row = row0 + ai * 128 + m * 16; const float gt = rgate[row];
                    const pg8::f32x4 v0 = acc[ai][bj][m][0], v1 = acc[ai][bj][m][1];
                    v4u w; w.x = cvt_pk_bf16((v0[0] + b0.x) * gt, (v0[1] + b0.y) * gt); w.y = cvt_pk_bf16((v0[2] + b0.z) * gt, (v0[3] + b0.w) * gt);
                    w.z = cvt_pk_bf16((v1[0] + b1.x) * gt, (v1[1] + b1.y) * gt); w.w = cvt_pk_bf16((v1[2] + b1.z) * gt, (v1[3] + b1.w) * gt);
                    *(v4u*)(YS + (size_t)row * 1024 + col) = w; } }
    }
};

struct S5EOrder {
    int G, c;
    __device__ __forceinline__ bool next(int i, Unit& u) const { const int Lq = i * G + c; if (Lq >= 128) return false; u.pm = Lq; u.pn = Lq >> 2; return true; }
    __device__ __forceinline__ void a_ready(const Unit&) const {}
    __device__ __forceinline__ void done(const Unit&) const {}
};
struct S5YOrder {
    int G, c;
    __device__ __forceinline__ bool next(int i, Unit& u) const { const int Lq = i * G + c; if (Lq >= 512) return false; const int g = Lq >> 4, r = Lq & 15; u.pm = g * 4 + (r >> 2); u.pn = g * 4 + (r & 3); return true; }
    __device__ __forceinline__ void a_ready(const Unit&) const {}
    __device__ __forceinline__ void done(const Unit&) const {}
};
struct MoeOrder {
    const int* tile_e; int ntile, NT, G, c;
    __device__ __forceinline__ bool next(int i, Unit& u) const { const int Lq = i * G + c; if (Lq >= ntile * NT) return false; const int it = Lq / NT, pnl = Lq % NT; u.pm = it; u.pn = tile_e[it] * NT + pnl; return true; }
    __device__ __forceinline__ void a_ready(const Unit&) const {}
    __device__ __forceinline__ void done(const Unit&) const {}
};

__device__ __forceinline__ void conv16(const bf16* QK, const float* convw, const float* convb, int b, int trow, int ch0, float (&o)[16]) {
    const f4* cb = (const f4*)(convb + ch0);
#pragma unroll
    for (int q = 0; q < 4; ++q) { const f4 v = cb[q]; o[4 * q] = v.x; o[4 * q + 1] = v.y; o[4 * q + 2] = v.z; o[4 * q + 3] = v.w; }
#pragma unroll
    for (int j = 0; j < 4; ++j) { const int r = trow - 3 + j;
        if (r >= 0) { const v4u* src = (const v4u*)(QK + ((size_t)(b * SEQ + r) * 1024 + ch0)); const v4u x0 = src[0], x1 = src[1];
            const f4* w4 = (const f4*)(convw + j * 1024 + ch0); const f4 w0 = w4[0], w1 = w4[1], w2 = w4[2], w3 = w4[3];
            o[0] += w0.x * bflo(x0.x); o[1] += w0.y * bfhi(x0.x); o[2] += w0.z * bflo(x0.y); o[3] += w0.w * bfhi(x0.y);
            o[4] += w1.x * bflo(x0.z); o[5] += w1.y * bfhi(x0.z); o[6] += w1.z * bflo(x0.w); o[7] += w1.w * bfhi(x0.w);
            o[8] += w2.x * bflo(x1.x); o[9] += w2.y * bfhi(x1.x); o[10] += w2.z * bflo(x1.y); o[11] += w2.w * bfhi(x1.y);
            o[12] += w3.x * bflo(x1.z); o[13] += w3.y * bfhi(x1.z); o[14] += w3.z * bflo(x1.w); o[15] += w3.w * bfhi(x1.w); } }
#pragma unroll
    for (int e = 0; e < 16; ++e) o[e] = siluf_(o[e]);
}

__device__ __forceinline__ void mlstm_local_item(const KArgs& a, LAS unsigned char* L, int item) {
    const int tid = otid(), lane = tid & 63, wave = tid >> 6;
    const int c = item & 127, bh = item >> 7, h = bh & 3, b = bh >> 2, tok0 = b * SEQ + c * 64;
    LAS bf16* kT = (LAS bf16*)L;
    LAS bf16* vT = (LAS bf16*)(L + 18432);
    LAS float* wsv = (LAS float*)(L + 36864);
    const float* GATES = (const float*)(a.ws + OFF_GATES);
    const bf16* QK = (const bf16*)(a.ws + OFF_QK); const bf16* V = (const bf16*)(a.ws + OFF_V);
    if (wave == 0) {
        const float fg = GATES[(size_t)(tok0 + lane) * 8 + 4 + h], ig = GATES[(size_t)(tok0 + lane) * 8 + h];
        float bb = logsigmoidf_(fg);
#pragma unroll
        for (int o = 1; o < 64; o <<= 1) { const float t = __shfl_up(bb, o); if (lane >= o) bb += t; }
        const float g = __shfl(bb, 63), wl = g - bb + ig, amax = wave_max(wl);
        wsv[lane] = expf(wl - amax);
        if (lane == 0) { ((float*)(a.ws + OFF_MLG))[item] = g; ((float*)(a.ws + OFF_MLA))[item] = amax; }
    }
    const int s = tid >> 3, col0 = (tid & 7) * 16;
    float kc[16];
    conv16(QK, a.in[I_CONVW], a.in[I_CONVB], b, c * 64 + s, 512 + h * 128 + col0, kc);
    const v4u* vsrc = (const v4u*)(V + ((size_t)(tok0 + s) * 512 + h * 128 + col0)); const v4u vx0 = vsrc[0], vx1 = vsrc[1];
#pragma unroll
    for (int e = 0; e < 16; ++e) kT[(col0 + e) * 72 + s] = (bf16)f2bf(kc[e] * 0.08838834764831845f);
    __syncthreads();
    {
        const float w = wsv[s];
        const unsigned vw[8] = {vx0.x, vx0.y, vx0.z, vx0.w, vx1.x, vx1.y, vx1.z, vx1.w};
#pragma unroll
        for (int q = 0; q < 8; ++q) { vT[(col0 + 2 * q) * 72 + s] = (bf16)f2bf(bflo(vw[q]) * w); vT[(col0 + 2 * q + 1) * 72 + s] = (bf16)f2bf(bfhi(vw[q]) * w); }
    }
    __syncthreads();
    {
        const int kdb = wave >> 1, vb0 = (wave & 1) * 2, r = lane & 31, hh = lane >> 5;
        f32x16 acc0, acc1;
#pragma unroll
        for (int i = 0; i < 16; ++i) { acc0[i] = 0.f; acc1[i] = 0.f; }
#pragma unroll
        for (int ks = 0; ks < 4; ++ks) {
            const bf16x8 A = *(const LAS bf16x8*)(kT + (kdb * 32 + r) * 72 + ks * 16 + 8 * hh);
            const bf16x8 B0 = *(const LAS bf16x8*)(vT + (vb0 * 32 + r) * 72 + ks * 16 + 8 * hh);
            const bf16x8 B1 = *(const LAS bf16x8*)(vT + ((vb0 + 1) * 32 + r) * 72 + ks * 16 + 8 * hh);
            acc0 = __builtin_amdgcn_mfma_f32_32x32x16_bf16(A, B0, acc0, 0, 0, 0);
            acc1 = __builtin_amdgcn_mfma_f32_32x32x16_bf16(A, B1, acc1, 0, 0, 0);
        }
        bf16* UP = (bf16*)((unsigned char*)a.out + OUT_UP) + (size_t)item * 16384;
#pragma unroll
        for (int q = 0; q < 4; ++q) { const int kd = kdb * 32 + 8 * q + 4 * hh;
            v2u w0; w0.x = pk2(acc0[4 * q], acc0[4 * q + 1]); w0.y = pk2(acc0[4 * q + 2], acc0[4 * q + 3]);
            v2u w1; w1.x = pk2(acc1[4 * q], acc1[4 * q + 1]); w1.y = pk2(acc1[4 * q + 2], acc1[4 * q + 3]);
            *(v2u*)(UP + (size_t)(vb0 * 32 + r) * 128 + kd) = w0; *(v2u*)(UP + (size_t)((vb0 + 1) * 32 + r) * 128 + kd) = w1; }
    }
    if (tid < 128) { float np = 0.f;
#pragma unroll 8
        for (int q = 0; q < 64; ++q) np += wsv[q] * bf2f(kT[tid * 72 + q]);
        ((float*)(a.ws + OFF_MLNP))[(size_t)item * 128 + tid] = np; }
    __syncthreads();
}

__device__ __forceinline__ void phase3(const KArgs& a, LAS unsigned char* L, int G) {
    const int tid = otid(), lane = tid & 63, wave = tid >> 6;
    LAS float* ga = (LAS float*)L; LAS float* aa = ga + 128; LAS float* dec = aa + 128; LAS float* scl = dec + 128;
    for (int w = blockIdx.x; w < 256; w += G) {
        const int bh = w >> 3, slice = w & 7;
        if (tid < 128) { ga[tid] = ((const float*)(a.ws + OFF_MLG))[bh * 128 + tid]; aa[tid] = ((const float*)(a.ws + OFF_MLA))[bh * 128 + tid]; }
        __syncthreads();
        if (tid == 0) { float m = 0.f; float* MLM = (float*)(a.ws + OFF_MLM);
            for (int c = 0; c < 128; ++c) { const float g = ga[c], am = aa[c], mn = fmaxf(g + m, am); dec[c] = expf(g + m - mn); scl[c] = expf(am - mn); if (slice == 0) MLM[bh * 128 + c] = m; m = mn; } }
        __syncthreads();
        {
            const size_t e0 = (size_t)bh * 128 * 16384 + slice * 2048 + tid * 4;
            const bf16* up = (const bf16*)((const unsigned char*)a.out + OUT_UP) + e0; bf16* cs = (bf16*)((unsigned char*)a.out + OUT_CST) + e0;
            float C0 = 0.f, C1 = 0.f, C2 = 0.f, C3 = 0.f;
            for (int c0 = 0; c0 < 128; c0 += 8) {
                v2u uv[8];
#pragma unroll
                for (int q = 0; q < 8; ++q) uv[q] = *(const v2u*)(up + (size_t)(c0 + q) * 16384);
#pragma unroll
                for (int q = 0; q < 8; ++q) { v2u o; o.x = pk2(C0, C1); o.y = pk2(C2, C3); *(v2u*)(cs + (size_t)(c0 + q) * 16384) = o;
                    const float d = dec[c0 + q], sc = scl[c0 + q];
                    C0 = d * C0 + sc * bflo(uv[q].x); C1 = d * C1 + sc * bfhi(uv[q].x); C2 = d * C2 + sc * bflo(uv[q].y); C3 = d * C3 + sc * bfhi(uv[q].y); }
            }
        }
        if (slice == 0 && tid < 128) { const float* np = (const float*)(a.ws + OFF_MLNP) + (size_t)bh * 128 * 128 + tid; float* ns = (float*)(a.ws + OFF_MLN) + (size_t)bh * 128 * 128 + tid; float n = 0.f;
            for (int c = 0; c < 128; ++c) { ns[c * 128] = n; n = dec[c] * n + scl[c] * np[c * 128]; } }
        __syncthreads();
    }
    if (wave == 7) for (int w = blockIdx.x; w < 256; w += G) {
        const int b = w >> 5, g = w & 31, p = lane;
        const float dt = expf(a.in[I_LDT][g]); float lr, li; lam_pow(a.in[I_LRE][g * 64 + p], a.in[I_LIM][g * 64 + p], dt, 64, lr, li);
        const float* E = (const float*)(a.ws + OFF_S5E) + ((size_t)(g * 1024 + b * 128) * 128 + 2 * p);
        bf16* UG = (bf16*)(a.ws + OFF_UG) + ((size_t)(g * 1024 + b * 128) * 1152 + 1024 + 2 * p);
        float xr = 0.f, xi = 0.f;
        for (int c0 = 0; c0 < 128; c0 += 8) {
            f2 ev[8];
#pragma unroll
            for (int q = 0; q < 8; ++q) ev[q] = *(const f2*)(E + (size_t)(c0 + q) * 128);
#pragma unroll
            for (int q = 0; q < 8; ++q) { *(unsigned*)(UG + (size_t)(c0 + q) * 1152) = pk2(xr, xi);
                const float nr = lr * xr - li * xi + ev[q].x, ni = lr * xi + li * xr + ev[q].y; xr = nr; xi = ni; }
        }
    }
}

__device__ __forceinline__ void mlstm_out_item(const KArgs& a, LAS unsigned char* L, int item) {
    const int tid = otid(), lane = tid & 63, wave = tid >> 6;
    const int c = item & 127, bh = item >> 7, h = bh & 3, b = bh >> 2, tok0 = b * SEQ + c * 64;
    LAS bf16* qc = (LAS bf16*)L;
    LAS bf16* kc = (LAS bf16*)(L + 17408);
    LAS bf16* vT = (LAS bf16*)(L + 34816);
    LAS bf16* Cs = (LAS bf16*)(L + 53248);
    LAS bf16* Pm = (LAS bf16*)(L + 88064);
    LAS float* fcs = (LAS float*)(L + 97280); LAS float* frr = fcs + 64; LAS float* fsc = frr + 64; LAS float* fen = fsc + 64; LAS float* fden = fen + 64; LAS float* fn = fden + 64;
    LAS float* hbuf = (LAS float*)L;
    const float* GATES = (const float*)(a.ws + OFF_GATES);
    const bf16* QK = (const bf16*)(a.ws + OFF_QK); const bf16* V = (const bf16*)(a.ws + OFF_V);
    if (wave == 0) {
        const float fg = GATES[(size_t)(tok0 + lane) * 8 + 4 + h], ig = GATES[(size_t)(tok0 + lane) * 8 + h];
        float bb = logsigmoidf_(fg);
#pragma unroll
        for (int o = 1; o < 64; o <<= 1) { const float t = __shfl_up(bb, o); if (lane >= o) bb += t; }
        const float cs = ig - bb; float pm = cs;
#pragma unroll
        for (int o = 1; o < 64; o <<= 1) { const float t = __shfl_up(pm, o); if (lane >= o) pm = fmaxf(pm, t); }
        const float mk = ((const float*)(a.ws + OFF_MLM))[item], r = fmaxf(pm, mk);
        fcs[lane] = cs; frr[lane] = r; fsc[lane] = expf(mk - r); fen[lane] = expf(-bb - r);
    }
    if (wave == 2 || wave == 3) fn[tid - 128] = ((const float*)(a.ws + OFF_MLN))[(size_t)item * 128 + tid - 128];
    const int s = tid >> 3, col0 = (tid & 7) * 16;
    {
        float t16[16];
        conv16(QK, a.in[I_CONVW], a.in[I_CONVB], b, c * 64 + s, h * 128 + col0, t16);
        v4u w0, w1; w0.x = pk2(t16[0], t16[1]); w0.y = pk2(t16[2], t16[3]); w0.z = pk2(t16[4], t16[5]); w0.w = pk2(t16[6], t16[7]);
        w1.x = pk2(t16[8], t16[9]); w1.y = pk2(t16[10], t16[11]); w1.z = pk2(t16[12], t16[13]); w1.w = pk2(t16[14], t16[15]);
        *(LAS v4u*)(qc + s * 136 + col0) = w0; *(LAS v4u*)(qc + s * 136 + col0 + 8) = w1;
        conv16(QK, a.in[I_CONVW], a.in[I_CONVB], b, c * 64 + s, 512 + h * 128 + col0, t16);
#pragma unroll
        for (int e = 0; e < 16; ++e) t16[e] *= 0.08838834764831845f;
        w0.x = pk2(t16[0], t16[1]); w0.y = pk2(t16[2], t16[3]); w0.z = pk2(t16[4], t16[5]); w0.w = pk2(t16[6], t16[7]);
        w1.x = pk2(t16[8], t16[9]); w1.y = pk2(t16[10], t16[11]); w1.z = pk2(t16[12], t16[13]); w1.w = pk2(t16[14], t16[15]);
        *(LAS v4u*)(kc + s * 136 + col0) = w0; *(LAS v4u*)(kc + s * 136 + col0 + 8) = w1;
        const v4u* vsrc = (const v4u*)(V + ((size_t)(tok0 + s) * 512 + h * 128 + col0)); const v4u vx0 = vsrc[0], vx1 = vsrc[1];
        const unsigned vw[8] = {vx0.x, vx0.y, vx0.z, vx0.w, vx1.x, vx1.y, vx1.z, vx1.w};
#pragma unroll
        for (int q = 0; q < 8; ++q) { vT[(col0 + 2 * q) * 72 + s] = (bf16)(vw[q] & 0xffffu); vT[(col0 + 2 * q + 1) * 72 + s] = (bf16)(vw[q] >> 16); }
        const bf16* CST = (const bf16*)((const unsigned char*)a.out + OUT_CST) + (size_t)item * 16384;
#pragma unroll
        for (int i = 0; i < 4; ++i) { const int ch = tid + 512 * i, v = ch >> 4, kd0 = (ch & 15) * 8; *(LAS v4u*)(Cs + v * 136 + kd0) = *(const v4u*)(CST + (size_t)ch * 8); }
    }
    __syncthreads();
    {
        const int tb = wave >> 1, sb0 = (wave & 1) * 2, fr = lane & 15, fq = lane >> 4;
#pragma unroll
        for (int jj = 0; jj < 2; ++jj) { const int sb = sb0 + jj;
            pg8::f32x4 acc = (pg8::f32x4){0.f, 0.f, 0.f, 0.f};
            if (sb <= tb) {
#pragma unroll
                for (int ks = 0; ks < 4; ++ks) {
                    const bf16x8 A = *(const LAS bf16x8*)(qc + (tb * 16 + fr) * 136 + ks * 32 + 8 * fq);
                    const bf16x8 B = *(const LAS bf16x8*)(kc + (sb * 16 + fr) * 136 + ks * 32 + 8 * fq);
                    acc = __builtin_amdgcn_mfma_f32_16x16x32_bf16(A, B, acc, 0, 0, 0);
                }
            }
            const int sc_ = sb * 16 + fr; const float csv = fcs[sc_];
#pragma unroll
            for (int q = 0; q < 4; ++q) { const int t = tb * 16 + fq * 4 + q; const float pv = (sc_ <= t) ? acc[q] * __expf(csv - frr[t]) : 0.f; Pm[t * 72 + sc_] = (bf16)f2bf(pv); }
        }
    }
    __syncthreads();
    {
        const int t = tid >> 3, part = tid & 7;
        const v4u pw = *(const LAS v4u*)(Pm + t * 72 + part * 8);
        float ps = (bflo(pw.x) + bfhi(pw.x)) + (bflo(pw.y) + bfhi(pw.y)) + (bflo(pw.z) + bfhi(pw.z)) + (bflo(pw.w) + bfhi(pw.w));
        const v4u q0 = *(const LAS v4u*)(qc + t * 136 + part * 16), q1 = *(const LAS v4u*)(qc + t * 136 + part * 16 + 8);
        const unsigned qw[8] = {q0.x, q0.y, q0.z, q0.w, q1.x, q1.y, q1.z, q1.w};
        float qn = 0.f;
#pragma unroll
        for (int q = 0; q < 8; ++q) qn += bflo(qw[q]) * fn[part * 16 + 2 * q] + bfhi(qw[q]) * fn[part * 16 + 2 * q + 1];
        float val = ps + fsc[t] * qn;
        val += __shfl_xor(val, 1); val += __shfl_xor(val, 2); val += __shfl_xor(val, 4);
        if (part == 0) fden[t] = val;
    }
    f32x16 accA, accB;
    const int tb2 = wave >> 2, vb = wave & 3, r32 = lane & 31, hh = lane >> 5;
    {
#pragma unroll
        for (int i = 0; i < 16; ++i) { accA[i] = 0.f; accB[i] = 0.f; }
#pragma unroll
        for (int ks = 0; ks < 4; ++ks) {
            const bf16x8 A = *(const LAS bf16x8*)(Pm + (tb2 * 32 + r32) * 72 + ks * 16 + 8 * hh);
            const bf16x8 B = *(const LAS bf16x8*)(vT + (vb * 32 + r32) * 72 + ks * 16 + 8 * hh);
            accA = __builtin_amdgcn_mfma_f32_32x32x16_bf16(A, B, accA, 0, 0, 0);
        }
#pragma unroll
        for (int ks = 0; ks < 8; ++ks) {
            const bf16x8 A = *(const LAS bf16x8*)(qc + (tb2 * 32 + r32) * 136 + ks * 16 + 8 * hh);
            const bf16x8 B = *(const LAS bf16x8*)(Cs + (vb * 32 + r32) * 136 + ks * 16 + 8 * hh);
            accB = __builtin_amdgcn_mfma_f32_32x32x16_bf16(A, B, accB, 0, 0, 0);
        }
    }
    __syncthreads();
    {
#pragma unroll
        for (int i = 0; i < 16; ++i) { const int t = tb2 * 32 + (i & 3) + 8 * (i >> 2) + 4 * hh;
            const float num = accA[i] + fsc[t] * accB[i]; hbuf[t * 132 + vb * 32 + r32] = num / fmaxf(fabsf(fden[t]), fen[t]); }
    }
    __syncthreads();
    {
        const int t = tid >> 3, part = tid & 7;
        f4 hv[4]; float ss = 0.f;
#pragma unroll
        for (int q = 0; q < 4; ++q) { hv[q] = *(const LAS f4*)(hbuf + t * 132 + part * 16 + 4 * q); ss += (hv[q].x * hv[q].x + hv[q].y * hv[q].y) + (hv[q].z * hv[q].z + hv[q].w * hv[q].w); }
        ss += __shfl_xor(ss, 1); ss += __shfl_xor(ss, 2); ss += __shfl_xor(ss, 4);
        const float rstd = rsqrtf(ss * (1.f / 128.f) + EPS);
        const bf16* O = (const bf16*)(a.ws + OFF_O) + ((size_t)(tok0 + t) * 512 + h * 128 + part * 16);
        const v4u o0 = ((const v4u*)O)[0], o1 = ((const v4u*)O)[1];
        const unsigned ow[8] = {o0.x, o0.y, o0.z, o0.w, o1.x, o1.y, o1.z, o1.w};
        const f4* hg = (const f4*)(a.in[I_HNG] + h * 128 + part * 16);
        float y[16];
#pragma unroll
        for (int q = 0; q < 4; ++q) { const f4 g4 = hg[q];
            y[4 * q + 0] = sigmoidf_(bflo(ow[2 * q])) * hv[q].x * rstd * g4.x; y[4 * q + 1] = sigmoidf_(bfhi(ow[2 * q])) * hv[q].y * rstd * g4.y;
            y[4 * q + 2] = sigmoidf_(bflo(ow[2 * q + 1])) * hv[q].z * rstd * g4.z; y[4 * q + 3] = sigmoidf_(bfhi(ow[2 * q + 1])) * hv[q].w * rstd * g4.w; }
        v4u w0, w1; w0.x = pk2(y[0], y[1]); w0.y = pk2(y[2], y[3]); w0.z = pk2(y[4], y[5]); w0.w = pk2(y[6], y[7]);
        w1.x = pk2(y[8], y[9]); w1.y = pk2(y[10], y[11]); w1.z = pk2(y[12], y[13]); w1.w = pk2(y[14], y[15]);
        bf16* MIX = (bf16*)(a.ws + OFF_H1) + ((size_t)(tok0 + t) * 1024 + h * 128 + part * 16);
        ((v4u*)MIX)[0] = w0; ((v4u*)MIX)[1] = w1;
    }
    __syncthreads();
}

template <int N, int MASK> __device__ __forceinline__ void rs_step(float* v, int lane) {
    const bool hi = (lane & MASK) != 0;
#pragma unroll
    for (int i = 0; i < N; ++i) { const float send = hi ? v[i] : v[i + N], keep = hi ? v[i + N] : v[i]; v[i] = keep + __shfl_xor(send, MASK); }
}
__device__ __forceinline__ void phase7(const KArgs& a, LAS unsigned char* L, int G) {
    const int tid = otid(), lane = tid & 63, wave = tid >> 6;
    LAS float* wrT = (LAS float*)L;
    LAS int* le = (LAS int*)(L + 131584);
    LAS int* lcnt = (LAS int*)(L + 131584 + 4096);
    const float* wr = a.in[I_WR];
    for (int idx = tid; idx < 32768; idx += 512) wrT[(idx & 31) * 1028 + (idx >> 5)] = wr[idx];
    const float* X1 = a.out; const float* g2 = a.in[I_N2G]; const float* br = a.in[I_BR];
    f4 gv[4];
#pragma unroll
    for (int j = 0; j < 4; ++j) gv[j] = ((const f4*)g2)[lane + 64 * j];
    const float bre = br[lane >> 1];
    float* RSTD = (float*)(a.ws + OFF_RSTD2); int* ENTE = (int*)(a.ws + OFF_ENTE); float* ENTG = (float*)(a.ws + OFF_ENTG); int* ENTR = (int*)(a.ws + OFF_ENTR); int* CNT = (int*)(a.ws + OFF_CNT);
    for (int chunk = blockIdx.x; chunk < 256; chunk += G) {
        if (tid < 32) lcnt[tid] = 0;
        __syncthreads();
        for (int it = 0; it < 16; ++it) {
            const int tl = wave * 32 + 2 * it, t0 = chunk * 256 + tl;
            f4 h0[4], h1[4]; float s0 = 0.f, s1 = 0.f;
            const f4* x0 = (const f4*)(X1 + (size_t)t0 * DM) + lane; const f4* x1 = x0 + 256;
#pragma unroll
            for (int j = 0; j < 4; ++j) { h0[j] = x0[64 * j]; h1[j] = x1[64 * j];
                s0 += (h0[j].x * h0[j].x + h0[j].y * h0[j].y) + (h0[j].z * h0[j].z + h0[j].w * h0[j].w); s1 += (h1[j].x * h1[j].x + h1[j].y * h1[j].y) + (h1[j].z * h1[j].z + h1[j].w * h1[j].w); }
            const float r0 = rsqrtf(wave_sum(s0) * (1.f / DM) + EPS), r1 = rsqrtf(wave_sum(s1) * (1.f / DM) + EPS);
            if (lane == 0) { RSTD[t0] = r0; RSTD[t0 + 1] = r1; }
#pragma unroll
            for (int j = 0; j < 4; ++j) { h0[j] = h0[j] * r0 * gv[j]; h1[j] = h1[j] * r1 * gv[j]; }
            float v0[32], v1[32];
#pragma unroll
            for (int e = 0; e < 32; ++e) { float p0 = 0.f, p1 = 0.f;
#pragma unroll
                for (int j = 0; j < 4; ++j) { const f4 w = *(const LAS f4*)(wrT + e * 1028 + 4 * lane + 256 * j);
                    p0 += (h0[j].x * w.x + h0[j].y * w.y) + (h0[j].z * w.z + h0[j].w * w.w); p1 += (h1[j].x * w.x + h1[j].y * w.y) + (h1[j].z * w.z + h1[j].w * w.w); }
                v0[e] = p0; v1[e] = p1; }
            rs_step<16, 32>(v0, lane); rs_step<8, 16>(v0, lane); rs_step<4, 8>(v0, lane); rs_step<2, 4>(v0, lane); rs_step<1, 2>(v0, lane);
            rs_step<16, 32>(v1, lane); rs_step<8, 16>(v1, lane); rs_step<4, 8>(v1, lane); rs_step<2, 4>(v1, lane); rs_step<1, 2>(v1, lane);
            float l0 = v0[0] + __shfl_xor(v0[0], 1) + bre, l1 = v1[0] + __shfl_xor(v1[0], 1) + bre;
            const int me = lane >> 1;
#pragma unroll
            for (int tk = 0; tk < 2; ++tk) {
                float lv = tk ? l1 : l0; float tv[4]; int te[4];
#pragma unroll
                for (int r = 0; r < 4; ++r) { float bv = lv; int be = me;
#pragma unroll
                    for (int o = 1; o < 64; o <<= 1) { const float ov = __shfl_xor(bv, o); const int oe = __shfl_xor(be, o); if (ov > bv || (ov == bv && oe < be)) { bv = ov; be = oe; } }
                    tv[r] = bv; te[r] = be; if (me == be) lv = -3.0e38f; }
                const float e1 = __expf(tv[1] - tv[0]), e2 = __expf(tv[2] - tv[0]), e3 = __expf(tv[3] - tv[0]), inv = 1.f / (1.f + e1 + e2 + e3);
                if (lane < 4) { const int r = lane; const int ee = r == 0 ? te[0] : r == 1 ? te[1] : r == 2 ? te[2] : te[3]; const float gg = (r == 0 ? 1.f : r == 1 ? e1 : r == 2 ? e2 : e3) * inv;
                    const int tt = t0 + tk; ENTE[tt * 4 + r] = ee; ENTG[tt * 4 + r] = gg; le[(tl + tk) * 4 + r] = ee; }
            }
        }
        __syncthreads();
#pragma unroll
        for (int q = 0; q < 2; ++q) { const int idx = tid + 512 * q; const int e = le[idx]; const int rk = __hip_atomic_fetch_add(&lcnt[e], 1, __ATOMIC_RELAXED, __HIP_MEMORY_SCOPE_WORKGROUP); ENTR[chunk * 1024 + idx] = rk; }
        __syncthreads();
        if (tid < 32) CNT[chunk * 32 + tid] = lcnt[tid];
        __syncthreads();
    }
}

__device__ __forceinline__ void place_preamble(const KArgs& a, LAS int* tot, LAS int* pst, bool write_tiles) {
    const int tid = otid();
    const int* CNT = (const int*)(a.ws + OFF_CNT); int* TILEE = (int*)(a.ws + OFF_TILEE); int* NTILE = (int*)(a.ws + OFF_NTILE);
    if (tid < 64) { const int hf = tid >> 5, e = tid & 31; int s = 0; for (int c = 0; c < 128; ++c) s += CNT[(hf * 128 + c) * 32 + e]; tot[tid] = s; }
    __syncthreads();
    if (tid < 2) { const int hf = tid; int run = 0;
        for (int e = 0; e < 32; ++e) { pst[hf * 32 + e] = run; const int nt = (tot[hf * 32 + e] + 255) >> 8;
            if (write_tiles) for (int i = 0; i < nt; ++i) TILEE[hf * 1024 + (run >> 8) + i] = e;
            run += nt << 8; }
        if (write_tiles) NTILE[hf] = run >> 8; }
    __syncthreads();
}
__device__ __forceinline__ void chunk_base(const KArgs& a, LAS int* pst, LAS int* base, int chunk) {
    const int tid = otid(), hf = chunk >> 7; const int* CNT = (const int*)(a.ws + OFF_CNT);
    if (tid < 32) { int s = pst[hf * 32 + tid]; for (int c = hf * 128; c < chunk; ++c) s += CNT[c * 32 + tid]; base[tid] = s; }
    __syncthreads();
}
__device__ __forceinline__ void gather_unit(const KArgs& a, LAS int* pst, LAS int* base, int hf, int u, bf16* XS) {
    const int tid = otid(), lane = tid & 63, wave = tid >> 6;
    const int chunk = hf * 128 + (u >> 1), sub = u & 1;
    chunk_base(a, pst, base, chunk);
    const float* X1 = a.out; const float* g2 = a.in[I_N2G]; const float* RSTD = (const float*)(a.ws + OFF_RSTD2);
    const int* ENTE = (const int*)(a.ws + OFF_ENTE); const int* ENTR = (const int*)(a.ws + OFF_ENTR);
    f4 gv[4];
#pragma unroll
    for (int j = 0; j < 4; ++j) gv[j] = ((const f4*)g2)[lane + 64 * j];
    for (int it = 0; it < 16; ++it) { const int t = chunk * 256 + sub * 128 + wave * 16 + it;
        const f4* xr = (const f4*)(X1 + (size_t)t * DM) + lane; const float rs = RSTD[t];
        unsigned long long w[4];
#pragma unroll
        for (int j = 0; j < 4; ++j) { const f4 v = xr[64 * j] * rs * gv[j]; w[j] = (unsigned long long)pk2(v.x, v.y) | ((unsigned long long)pk2(v.z, v.w) << 32); }
#pragma unroll
        for (int k = 0; k < 4; ++k) { const int d = base[ENTE[t * 4 + k]] + ENTR[t * 4 + k]; unsigned long long* o8 = (unsigned long long*)(XS + (size_t)d * DM) + lane;
#pragma unroll
            for (int j = 0; j < 4; ++j) o8[64 * j] = w[j]; }
    }
    __syncthreads();
}
__device__ __forceinline__ void phase8(const KArgs& a, LAS unsigned char* L, int G) {
    const int tid = otid();
    LAS int* tot = (LAS int*)L; LAS int* pst = tot + 64; LAS int* base = pst + 64;
    const int* ENTE = (const int*)(a.ws + OFF_ENTE); const int* ENTR = (const int*)(a.ws + OFF_ENTR); const float* ENTG = (const float*)(a.ws + OFF_ENTG);
    int* SDEST = (int*)(a.ws + OFF_SDEST); float* RGATE = (float*)(a.ws + OFF_RGATE);
    place_preamble(a, tot, pst, blockIdx.x == 0);
    for (int chunk = blockIdx.x; chunk < 256; chunk += G) {
        const int hf = chunk >> 7;
        chunk_base(a, pst, base, chunk);
#pragma unroll
        for (int q = 0; q < 2; ++q) { const int gi = chunk * 1024 + tid + 512 * q; const int e = ENTE[gi]; const int d = base[e] + ENTR[gi]; SDEST[gi] = d; RGATE[hf * RCAP + d] = ENTG[gi]; }
        __syncthreads();
    }
    for (int u = blockIdx.x; u < 256; u += G) gather_unit(a, pst, base, 0, u, (bf16*)(a.ws + OFF_R1));
}

__device__ __forceinline__ void combine_half(const KArgs& a, int hf, const bf16* YS, int G) {
    const int tid = otid(), lane = tid & 63, wave = tid >> 6;
    const int gw = blockIdx.x * 8 + wave, NGW = G * 8;
    const int* SDEST = (const int*)(a.ws + OFF_SDEST); const float* gf = a.in[I_NFG];
    f4 gv[4];
#pragma unroll
    for (int j = 0; j < 4; ++j) gv[j] = ((const f4*)gf)[lane + 64 * j];
    for (int t = hf * 32768 + gw; t < (hf + 1) * 32768; t += NGW) {
        f4* xr = (f4*)(a.out + (size_t)t * DM) + lane;
        f4 v[4];
#pragma unroll
        for (int j = 0; j < 4; ++j) v[j] = xr[64 * j];
#pragma unroll
        for (int k = 0; k < 4; ++k) { const int d = SDEST[t * 4 + k]; const v2u* y8 = (const v2u*)(YS + (size_t)d * DM) + lane;
#pragma unroll
            for (int j = 0; j < 4; ++j) { const v2u w = y8[64 * j]; v[j].x += bflo(w.x); v[j].y += bfhi(w.x); v[j].z += bflo(w.y); v[j].w += bfhi(w.y); } }
        float ss = 0.f;
#pragma unroll
        for (int j = 0; j < 4; ++j) ss += (v[j].x * v[j].x + v[j].y * v[j].y) + (v[j].z * v[j].z + v[j].w * v[j].w);
        const float rstd = rsqrtf(wave_sum(ss) * (1.f / DM) + EPS);
#pragma unroll
        for (int j = 0; j < 4; ++j) xr[64 * j] = v[j] * rstd * gv[j];
    }
}

#define XB_TMO      128
#define XB_XCNT(j)  (256  + 64 * (j))
#define XB_XSUB(j)  (1280 + 64 * (j))
#define XB_XGEN(j)  (2304 + 64 * (j))
#define XB_TOP      3328
#define XB_TOPGEN   3392
#define XCD_BAR_WORDS 3456
#define XB_SPIN_CAP (1u << 18)

__device__ __forceinline__ unsigned xb_ld(unsigned* p)              { return __hip_atomic_load(p, __ATOMIC_RELAXED, __HIP_MEMORY_SCOPE_AGENT); }
__device__ __forceinline__ unsigned xb_add(unsigned* p, unsigned v) { return __hip_atomic_fetch_add(p, v, __ATOMIC_RELAXED, __HIP_MEMORY_SCOPE_AGENT); }
__device__ __forceinline__ unsigned xb_xcc_id() { return (unsigned)__builtin_amdgcn_s_getreg((3 << 11) | 20) & 0xFu; }
#define XB_SPIN(cond, bar) do { unsigned _sp = 0; while (cond) { __builtin_amdgcn_s_sleep(1); \
    if ((++_sp & 255u) == 0u) { if (xb_ld(&(bar)[XB_TMO])) break; if (_sp > XB_SPIN_CAP) { atomicAdd(&(bar)[XB_TMO], 1u); break; } } } } while (0)

struct XcdBarrier {
    unsigned* bar; unsigned x;
    volatile LAS unsigned* st;
};

__device__ __forceinline__ XcdBarrier xcd_barrier_post(unsigned* bar, volatile LAS unsigned* st) {
    XcdBarrier b; b.bar = bar; b.x = xb_xcc_id(); b.st = st;
    if (threadIdx.x == 0) (void)xb_add(&bar[XB_XCNT(b.x)], 1u);
    return b;
}
__device__ __forceinline__ void xcd_barrier_complete(unsigned* bar, unsigned x, unsigned& nloc, unsigned& nx) {
    const unsigned G = gridDim.x * gridDim.y * gridDim.z;
    unsigned sum, cnt, mine, sp = 0u;
    for (;;) {
        sum = 0u; cnt = 0u; mine = 0u;
#pragma unroll
        for (unsigned j = 0; j < 16; ++j) { const unsigned c = xb_ld(&bar[XB_XCNT(j)]); sum += c; cnt += (c > 0u) ? 1u : 0u; mine = (j == x) ? c : mine; }
        if (sum == G) break;
        __builtin_amdgcn_s_sleep(1);
        if ((++sp & 255u) == 0u) { if (xb_ld(&bar[XB_TMO])) break; if (sp > XB_SPIN_CAP) { atomicAdd(&bar[XB_TMO], 1u); break; } }
    }
    nloc = mine > 0u ? mine : 1u; nx = cnt > 0u ? cnt : 1u;
}

__device__ __forceinline__ void xcd_barrier(const XcdBarrier& b) {
    asm volatile("s_waitcnt vmcnt(0)" ::: "memory");
    __syncthreads();
    if (threadIdx.x == 0) {
        unsigned* bar = b.bar;
        __builtin_amdgcn_s_waitcnt(0);
        unsigned nloc = b.st[0], nx = b.st[1];
        if (nloc == 0u) { xcd_barrier_complete(bar, b.x, nloc, nx); b.st[0] = nloc; b.st[1] = nx; }
        const unsigned old = xb_add(&bar[XB_XSUB(b.x)], 1u);
        const unsigned gen = old / nloc;
        if (old + 1u == (gen + 1u) * nloc) {
            __builtin_amdgcn_fence(__ATOMIC_RELEASE, "agent");
            asm volatile("s_waitcnt vmcnt(0)" ::: "memory");
            const unsigned og = xb_add(&bar[XB_TOP], 1u);
            const unsigned tg = og / nx;
            if (og + 1u == (tg + 1u) * nx) xb_add(&bar[XB_TOPGEN], 1u);
            else XB_SPIN(xb_ld(&bar[XB_TOPGEN]) == tg, bar);
            __builtin_amdgcn_fence(__ATOMIC_ACQUIRE, "agent");
            xb_add(&bar[XB_XGEN(b.x)], 1u);
            asm volatile("s_waitcnt vmcnt(0)" ::: "memory");
        } else {
            XB_SPIN(xb_ld(&bar[XB_XGEN(b.x)]) == gen, bar);
            __builtin_amdgcn_fence(__ATOMIC_ACQUIRE, "agent");
            asm volatile("s_waitcnt vmcnt(0)" ::: "memory");
        }
    }
    __syncthreads();
}

#ifndef MK_SINGLE
#define MK_SINGLE 1
#endif
typedef const __attribute__((address_space(4))) KArgs* KArgsP;
__device__ __forceinline__ KArgs kargs() {
#if defined(__HIP_DEVICE_COMPILE__)
    KArgsP p = (KArgsP)__builtin_amdgcn_kernarg_segment_ptr(); asm volatile("" : "+s"(p)); KArgs r; __builtin_memcpy(&r, (const __attribute__((address_space(4))) void*)p, sizeof(KArgs)); return r;
#else
    return KArgs{};
#endif
}
__global__ void __launch_bounds__(512, 2) mk_fwd(KArgs a_in) {
    extern __shared__ __attribute__((aligned(16))) unsigned char lds_raw[];
    LAS unsigned char* L = (LAS unsigned char*)lds_raw;
    cg::grid_group grid = cg::this_grid();
    const int ph_lo = a_in.ph_lo, ph_hi = a_in.ph_hi;
    volatile LAS unsigned* MISC = (volatile LAS unsigned*)(L + LDS_BYTES - 64);
    if (otid() < 16) MISC[otid()] = 0u;
    __syncthreads();
    XcdBarrier xbar = xcd_barrier_post((unsigned*)a_in.ws, MISC);
#define IN(k) (ph_lo <= (k) && (k) < ph_hi)
#define SEAM(k) do { if (IN(k) && IN((k) + 1)) { if ((k) == 0) grid.sync(); else xcd_barrier(xbar); } } while (0)
#define GBX const int G = gridDim.x, bx = blockIdx.x; const KArgs a = kargs(); unsigned char* ws = a.ws; (void)G; (void)bx; (void)ws
    if (IN(0)) { GBX; phase0(a, L, G); }
    SEAM(0);
    if (IN(1)) { GBX;
        s5_expand(a, G);
        pg8::Gemm g{(const bf16*)(ws + OFF_H1), (const bf16*)(ws + OFF_WIN), 1024, 1024, 1024}; pg8::StaticOrder S; S.init(T, 2560, G, bx);
        EpiInProj E{(bf16*)(ws + OFF_QK), (bf16*)(ws + OFF_V), (bf16*)(ws + OFF_O), (bf16*)(ws + OFF_UG)};
        pg8::gemm_phase<EpiInProj, pg8::StaticOrder, true, true>(L, g, S, E);
    }
    SEAM(1);
    if (IN(2)) { GBX;
        for (int item = bx; item < 4096; item += G) mlstm_local_item(a, L, item);
        pg8::Gemm g{(const bf16*)(ws + OFF_UG), (const bf16*)(ws + OFF_S5P), 1152, 1024, 1024}; S5EOrder S{G, bx};
        EpiS5E E{(float*)(ws + OFF_S5E)};
        pg8::gemm_phase<EpiS5E, S5EOrder, true, true>(L, g, S, E);
    }
    SEAM(2);
    if (IN(3)) { GBX; phase3(a, L, G); }
    SEAM(3);
    if (IN(4)) { GBX;
        for (int item = bx; item < 4096; item += G) mlstm_out_item(a, L, item);
        pg8::Gemm g{(const bf16*)(ws + OFF_UG), (const bf16*)(ws + OFF_S5M), 1152, 1152, 1152}; S5YOrder S{G, bx};
        EpiS5Y E{(const bf16*)(ws + OFF_UG), a.in[I_DSKIP], (bf16*)(ws + OFF_YSG)};
        pg8::gemm_phase<EpiS5Y, S5YOrder, true, true>(L, g, S, E);
    }
    SEAM(4);
    if (IN(5)) { GBX;
        pg8::Gemm g{(const bf16*)(ws + OFF_YSG), (const bf16*)(ws + OFF_WGLU), 512, 512, 512}; pg8::StaticOrder S; S.init(T, 512, G, bx);
        EpiGlu E{(const bf16*)(ws + OFF_YSG), a.in[I_BGLU], (bf16*)(ws + OFF_H1)};
        pg8::gemm_phase<EpiGlu, pg8::StaticOrder, true, true>(L, g, S, E);
    }
    SEAM(5);
    if (IN(6)) { GBX;
        pg8::Gemm g{(const bf16*)(ws + OFF_H1), (const bf16*)(ws + OFF_WOUT), 1024, 1024, 1024}; pg8::StaticOrder S; S.init(T, 1024, G, bx);
        EpiOut E{a.in[I_X], a.out};
        pg8::gemm_phase<EpiOut, pg8::StaticOrder, true, true>(L, g, S, E);
    }
    SEAM(6);
    if (IN(7)) { GBX; phase7(a, L, G); }
    SEAM(7);
    if (IN(8)) { GBX; phase8(a, L, G); }
    SEAM(8);
#pragma unroll 1
    for (int hf = 0; hf < 2; ++hf) {
        const int pb = 9 + 3 * hf;
        if (IN(pb)) { GBX; const size_t rA = hf ? OFF_R2 : OFF_R1, rB = hf ? OFF_R1 : OFF_R2;
            const int ntile = ((const int*)(ws + OFF_NTILE))[hf];
            pg8::Gemm g{(const bf16*)(ws + rA), (const bf16*)(ws + OFF_WGU), 1024, 1024, 1024}; MoeOrder S{(const int*)(ws + OFF_TILEE) + hf * 1024, ntile, 8, G, bx};
            EpiMoeGU E{a.in[I_BGU], (bf16*)(ws + rB)};
            pg8::gemm_phase<EpiMoeGU, MoeOrder, true, true>(L, g, S, E);
        }
        SEAM(pb);
        if (IN(pb + 1)) { GBX; const size_t rA = hf ? OFF_R2 : OFF_R1, rB = hf ? OFF_R1 : OFF_R2;
            const int ntile = ((const int*)(ws + OFF_NTILE))[hf];
            pg8::Gemm g{(const bf16*)(ws + rB), (const bf16*)(ws + OFF_WDN), 1024, 1024, 1024}; MoeOrder S{(const int*)(ws + OFF_TILEE) + hf * 1024, ntile, 4, G, bx};
            EpiMoeDN E{a.in[I_BDN], (const float*)(ws + OFF_RGATE) + hf * RCAP, (bf16*)(ws + rA)};
            pg8::gemm_phase<EpiMoeDN, MoeOrder, true, true>(L, g, S, E);
        }
        SEAM(pb + 1);
        if (IN(pb + 2)) { GBX; const size_t rA = hf ? OFF_R2 : OFF_R1;
            combine_half(a, hf, (const bf16*)(ws + rA), G);
            if (hf == 0) { LAS int* tot = (LAS int*)L; LAS int* pst = tot + 64; LAS int* base = pst + 64; place_preamble(a, tot, pst, false);
                for (int u = bx; u < 256; u += G) gather_unit(a, pst, base, 1, u, (bf16*)(ws + OFF_R2)); }
        }
        if (hf == 0) SEAM(pb + 2);
    }
#undef IN
#undef SEAM
#undef GBX
}

extern "C" void kernel_launch(void* const* d_in, const int* in_sizes, int n_in, void* d_out, int out_size, void* d_ws, size_t ws_size, hipStream_t stream) {
    static int grid = 0;
    if (grid == 0) {
        if (n_in != 26 || out_size != T * DM || ws_size < WS_NEED) { fprintf(stderr, "kernel_launch: unexpected problem (n_in %d, out %d, ws %zu)\n", n_in, out_size, ws_size); grid = -1; return; }
        int dev = 0, cus = 0, per_cu = 0;
        (void)hipGetDevice(&dev); (void)hipDeviceGetAttribute(&cus, hipDeviceAttributeMultiprocessorCount, dev);
        if (hipFuncSetAttribute((const void*)mk_fwd, hipFuncAttributeMaxDynamicSharedMemorySize, LDS_BYTES) != hipSuccess) { fprintf(stderr, "kernel_launch: hipFuncSetAttribute failed\n"); grid = -1; return; }
        if (hipOccupancyMaxActiveBlocksPerMultiprocessor(&per_cu, (const void*)mk_fwd, 512, LDS_BYTES) != hipSuccess || per_cu < 1) { fprintf(stderr, "kernel_launch: occupancy query says %d\n", per_cu); per_cu = 1; }
        (void)hipGetLastError();
        grid = cus;
    }
    if (grid < 0) return;
    if (hipMemsetAsync(d_ws, 0, 16384, stream) != hipSuccess) { fprintf(stderr, "kernel_launch: memset failed\n"); return; }
    KArgs a{};
    for (int i = 0; i < 26; ++i) a.in[i] = (const float*)d_in[i];
    a.out = (float*)d_out; a.ws = (unsigned char*)d_ws;
#if MK_SINGLE
    a.ph_lo = 0; a.ph_hi = NPH;
    void* args[] = {&a};
    hipError_t e = hipLaunchCooperativeKernel((const void*)mk_fwd, dim3(grid), dim3(512), args, LDS_BYTES, stream);
    if (e != hipSuccess) fprintf(stderr, "cooperative launch failed: %s (grid %d)\n", hipGetErrorString(e), grid);
#else
    for (int p = 0; p < NPH; ++p) { a.ph_lo = p; a.ph_hi = p + 1; hipLaunchKernelGGL(mk_fwd, dim3(grid), dim3(512), LDS_BYTES, stream, a); }
#endif
}
```

```cpp
#include <hip/hip_runtime.h>
#include <hip/hip_cooperative_groups.h>
#include <cstdio>
#include <cstdint>
namespace cg = cooperative_groups;
__device__ __forceinline__ int otid() { int t = (int)threadIdx.x; asm volatile("" : "+v"(t)); return t; }

#ifndef PROBE_SECT
#define PROBE_SECT 0
#endif
#ifndef PROBE_SCALE
#define PROBE_SCALE 16
#endif
#define PROBE_LDS_WORD ((volatile __attribute__((address_space(3))) unsigned*)(155648 - 32))
#define TIC(id) unsigned long long tic_##id = 0; if (PROBE_SECT == (id)) { __builtin_amdgcn_sched_barrier(0); tic_##id = __builtin_amdgcn_s_memrealtime(); __builtin_amdgcn_sched_barrier(0); }
#define TOC(id) if (PROBE_SECT == (id)) { __builtin_amdgcn_sched_barrier(0); asm volatile("s_waitcnt vmcnt(0) lgkmcnt(0)" ::: "memory"); const unsigned d_ = (unsigned)(__builtin_amdgcn_s_memrealtime() - tic_##id); if (blockIdx.x == 0 && threadIdx.x == 0) *PROBE_LDS_WORD += d_; __builtin_amdgcn_sched_barrier(0); }
namespace pg8 {
#define PG8_LAS __attribute__((address_space(3)))
typedef unsigned short bf16_t;
typedef short bf16x8 __attribute__((ext_vector_type(8)));
typedef float f32x4 __attribute__((ext_vector_type(4)));
typedef unsigned u32x4 __attribute__((ext_vector_type(4)));
typedef long lx2 __attribute__((ext_vector_type(2)));
constexpr int BM = 256, BK = 64, HALF = 128, HTB = HALF * BK * 2  , STAGE_BYTES = 8 * HTB, NXCD = 8, WGM = 8;

__host__ __device__ __forceinline__ int lds_byte(int r, int c) { const int st = (r >> 4) * 2 + (c >> 5), rr = r & 15, cc = c & 31, ob = rr * 64 + cc * 2; return st * 1024 + (ob ^ (((ob >> 9) & 1) << 5)); }
__host__ __device__ __forceinline__ void stage_rc(int b, int& R, int& C) { const int st = b / 1024, sb = b % 1024, swz = sb ^ (((sb >> 9) & 1) << 5); R = (st >> 1) * 16 + swz / 64; C = (st & 1) * 32 + (swz % 64) / 2; }
__host__ __device__ __forceinline__ int perm32(int rho) { const int n = rho >> 4, i = rho & 15; return 8 * (i >> 2) + 4 * n + (i & 3); }

struct Unit { int pm, pn, rd, nt; };
struct Gemm { const bf16_t* A; const bf16_t* Bt; int lda, ldb, K; const int* rowmap; int blkA, blkB; };

struct StaticOrder {
    int nM, nN, nwg, G, c;
    __host__ __device__ void init(int M, int N, int G_, int c_) { nM = M / BM; nN = N / BM; nwg = nM * nN; G = G_; c = c_; }
    __host__ __device__ bool next(int i, Unit& u) const {
        const long L = (long)i * G + c; if (L >= nwg) return false;
        int wgid = (int)L; { const int q = nwg / NXCD, r = nwg % NXCD, xcd = wgid % NXCD, off = wgid / NXCD; wgid = (xcd < r ? xcd * (q + 1) : r * (q + 1) + (xcd - r) * q) + off; }
        const int nig = WGM * nN, gid = wgid / nig, fm = gid * WGM, gsz = (nM - fm) < WGM ? (nM - fm) : WGM;
        u.pm = fm + ((wgid % nig) % gsz); u.pn = (wgid % nig) / gsz; u.rd = 0; u.nt = 0; return true;
    }
    __device__ __forceinline__ void a_ready(const Unit&) const {}
    __device__ __forceinline__ void done(const Unit&) const {}
};

__device__ __forceinline__ unsigned cvt_pk_bf16(float lo, float hi) { unsigned r; asm volatile("v_cvt_pk_bf16_f32 %0, %1, %2" : "=v"(r) : "v"(lo), "v"(hi)); return r; }

template <class Epi, class Sched, bool ALIGN_EPI = false, bool SP2 = false, bool GATHER = false, bool FP8 = false, bool BLKA = false, bool BLKB = false>
__device__ __forceinline__ void gemm_phase(PG8_LAS unsigned char* lds, const Gemm g, const Sched& S, const Epi& E) {
    const int tid = otid(), wid = __builtin_amdgcn_readfirstlane(tid >> 6), lane = tid & 63, wr = wid >> 2, wc = wid & 3, fr = lane & 15, fq = lane >> 4;
    const int K = g.K, nt = FP8 ? K / 128 : K / BK;
    const unsigned ldaB = BLKA ? 128u : (FP8 ? (unsigned)g.lda : 2u * (unsigned)g.lda), ldbB = BLKB ? 128u : (FP8 ? (unsigned)g.ldb : 2u * (unsigned)g.ldb);
    unsigned voffA[2], voffB[2];
#pragma unroll
    for (int i = 0; i < 2; ++i) { int R, C; stage_rc(tid * 16 + i * 8192, R, C); const int Rb = Epi::PERM ? ((R & ~31) + perm32(R & 31)) : R;
        voffA[i] = (unsigned)R * ldaB + 2u * (unsigned)C; voffB[i] = (unsigned)Rb * ldbB + 2u * (unsigned)C; }
    int gR0, gC0; stage_rc(tid * 16, gR0, gC0);
    const unsigned gRowBytes = ldaB, gColBytes = (unsigned)gC0 * 2u;
    unsigned offC[2][2], offN[2][2];
#define PG8_GOFF(dst, pm) do { if constexpr (GATHER) { _Pragma("unroll") for (int _h = 0; _h < 2; ++_h) _Pragma("unroll") for (int _i = 0; _i < 2; ++_i) \
        dst[_h][_i] = (unsigned)g.rowmap[(pm) * BM + _h * HALF + _i * 64 + gR0] * gRowBytes + gColBytes; } } while (0)
    constexpr size_t kstepA = BLKA ? (size_t)32768 : (size_t)128, kstepB = BLKB ? (size_t)32768 : (size_t)128;
    const size_t hstepA = (size_t)HALF * ldaB, hstepB = (size_t)HALF * ldbB;
    const size_t tstepA = BLKA ? (size_t)nt * 32768 : 2 * hstepA, tstepB = BLKB ? (size_t)nt * 32768 : 2 * hstepB;
    const unsigned ldsw = (unsigned)wid * 1024u;
    const int aoff = lds_byte(wr * 64 + fr, fq * 8), boff = lds_byte(wc * 32 + fr, fq * 8);
#define PG8_SA(b, h) (((b) * 2 + (h)) * HTB)
#define PG8_SB(b, h) ((4 + (b) * 2 + (h)) * HTB)
#ifndef PG8_AUX
#define PG8_AUX 0
#endif
#define PG8_STAGE(bufoff, gbase, voff) do { _Pragma("unroll") for (int _i = 0; _i < 2; ++_i) \
        __builtin_amdgcn_global_load_lds((const unsigned*)((const char*)(gbase) + (voff)[_i]), (PG8_LAS unsigned*)(lds + (bufoff) + ldsw + _i * 8192), 16, 0, FP8 ? PG8_AUX : 0); } while (0)
#define PG8_LDA(dst, b, h) do { _Pragma("unroll") for (int m = 0; m < 4; ++m) _Pragma("unroll") for (int k = 0; k < 2; ++k) dst[m][k] = *(const PG8_LAS bf16x8*)(lds + PG8_SA(b, h) + aoff + m * 2048 + k * 1024); } while (0)
#define PG8_LDB(dst, b, h) do { _Pragma("unroll") for (int n = 0; n < 2; ++n) _Pragma("unroll") for (int k = 0; k < 2; ++k) dst[n][k] = *(const PG8_LAS bf16x8*)(lds + PG8_SB(b, h) + boff + n * 2048 + k * 1024); } while (0)
#define PG8_MMA(ai, bj, At, Bt) do { __builtin_amdgcn_s_setprio(1); _Pragma("unroll") for (int m = 0; m < 4; ++m) _Pragma("unroll") for (int n = 0; n < 2; ++n) _Pragma("unroll") for (int k = 0; k < 2; ++k) { \
        if constexpr (FP8) { const lx2 a_ = __builtin_bit_cast(lx2, At[m][k]), b_ = __builtin_bit_cast(lx2, Bt[n][k]);        \
            acc[ai][bj][m][n] = __builtin_amdgcn_mfma_f32_16x16x32_fp8_fp8(b_.x, a_.x, acc[ai][bj][m][n], 0, 0, 0); acc[ai][bj][m][n] = __builtin_amdgcn_mfma_f32_16x16x32_fp8_fp8(b_.y, a_.y, acc[ai][bj][m][n], 0, 0, 0); } \
        else acc[ai][bj][m][n] = __builtin_amdgcn_mfma_f32_16x16x32_bf16(Bt[n][k], At[m][k], acc[ai][bj][m][n], 0, 0, 0); } __builtin_amdgcn_s_setprio(0); } while (0)
#define PG8_WAIT_V(n) asm volatile("s_waitcnt vmcnt(" #n ")" ::: "memory")
#define PG8_WAIT_L(n) asm volatile("s_waitcnt lgkmcnt(" #n ")" ::: "memory")
#define PG8_BAR __builtin_amdgcn_s_barrier()
#define PG8_SCHED __builtin_amdgcn_sched_barrier(0)
    Unit cur, nxt; int ui = 0;
    if (!S.next(0, cur)) return;
    f32x4 acc[2][2][4][2];
#pragma unroll
    for (int a = 0; a < 2; ++a)
#pragma unroll
        for (int b = 0; b < 2; ++b)
#pragma unroll
            for (int m = 0; m < 4; ++m)
#pragma unroll
                for (int n = 0; n < 2; ++n) acc[a][b][m][n] = (f32x4){0.f, 0.f, 0.f, 0.f};
    bf16x8 At[4][2], B0[2][2], B1[2][2];
    const char* cA = (const char*)g.A + (size_t)cur.pm * tstepA; const char* cB = (const char*)g.Bt + (size_t)cur.pn * tstepB;
    S.a_ready(cur);
    const char* gA = (const char*)g.A;
    PG8_GOFF(offC, cur.pm);
#define PG8_STAGE_A(bufoff, h, ptr_plain, kt, offs) do { if constexpr (GATHER) PG8_STAGE(bufoff, gA + (size_t)(kt) * kstepA, (offs)[h]); else PG8_STAGE(bufoff, ptr_plain, voffA); } while (0)
    if constexpr (SP2) {
        PG8_STAGE(PG8_SB(0, 0), cB, voffB); PG8_STAGE(PG8_SB(0, 1), cB + hstepB, voffB); PG8_STAGE_A(PG8_SA(0, 0), 0, cA, 0, offC); PG8_STAGE_A(PG8_SA(0, 1), 1, cA + hstepA, 0, offC);
        if (wr == 1) PG8_BAR;
        PG8_WAIT_V(2); PG8_BAR;
        PG8_STAGE(PG8_SB(1, 0), cB + kstepB, voffB); PG8_STAGE_A(PG8_SA(1, 0), 0, cA + kstepA, 1, offC); PG8_STAGE(PG8_SB(1, 1), cB + hstepB + kstepB, voffB);
        PG8_WAIT_V(6); PG8_BAR;
    } else {
        PG8_STAGE(PG8_SB(0, 0), cB, voffB); PG8_STAGE(PG8_SA(0, 0), cA, voffA); PG8_STAGE(PG8_SB(0, 1), cB + hstepB, voffB); PG8_STAGE(PG8_SA(0, 1), cA + hstepA, voffA);
        if (wr == 1) PG8_BAR;
        PG8_WAIT_V(4); PG8_BAR;
        PG8_STAGE(PG8_SB(1, 0), cB + kstepB, voffB); PG8_STAGE(PG8_SA(1, 0), cA + kstepA, voffA); PG8_STAGE(PG8_SB(1, 1), cB + hstepB + kstepB, voffB);
        PG8_WAIT_V(6); PG8_BAR;
    }
    for (;;) {
        const bool has_next = S.next(ui + 1, nxt);
        if constexpr (GATHER) { if (has_next) PG8_GOFF(offN, nxt.pm); else { _Pragma("unroll") for (int _h = 0; _h < 2; ++_h) _Pragma("unroll") for (int _i = 0; _i < 2; ++_i) offN[_h][_i] = offC[_h][_i]; } }
        const char* nA = has_next ? (const char*)g.A + (size_t)nxt.pm * tstepA : cA; const char* nB = has_next ? (const char*)g.Bt + (size_t)nxt.pn * tstepB : cB;
#ifndef PROBE_KREP_G
#define PROBE_KREP_G 1
#endif
#ifndef PROBE_KREP_N
#define PROBE_KREP_N 1
#endif
#ifndef PROBE_KREP_D
#define PROBE_KREP_D 1
#endif
        constexpr int KREP = GATHER ? PROBE_KREP_G : (FP8 ? PROBE_KREP_D : PROBE_KREP_N);
        TIC(21)
        for (int pass = 0; pass < KREP; ++pass) {
        const bool fpass = (pass == KREP - 1);
        if (KREP > 1 && pass > 0) {
#pragma unroll
            for (int a = 0; a < 2; ++a)
#pragma unroll
                for (int b = 0; b < 2; ++b)
#pragma unroll
                    for (int m = 0; m < 4; ++m)
#pragma unroll
                        for (int n = 0; n < 2; ++n) acc[a][b][m][n] = (f32x4){0.f, 0.f, 0.f, 0.f}; }
        const int ntc = cur.nt > 0 ? cur.nt : nt;
        for (int t = 0; t < ntc; t += 2) {
            const bool lastk = (t == ntc - 2), last = lastk && fpass;
            const char* a1 = cA + (size_t)(t + 1) * kstepA;
            const char* a2 = lastk ? (fpass ? nA : cA) : cA + (size_t)(t + 2) * kstepA; const char* b2 = lastk ? (fpass ? nB : cB) : cB + (size_t)(t + 2) * kstepB;
            const char* a3 = a2 + kstepA; const char* b3 = b2 + kstepB;
            if (last && has_next) S.a_ready(nxt);
            if constexpr (SP2) {
            const int k2 = lastk ? 0 : t + 2;
            unsigned offS[2][2];
            if constexpr (GATHER) { _Pragma("unroll") for (int _h = 0; _h < 2; ++_h) _Pragma("unroll") for (int _i = 0; _i < 2; ++_i) offS[_h][_i] = last ? offN[_h][_i] : offC[_h][_i]; }
            PG8_LDB(B0, 0, 0); PG8_LDB(B1, 0, 1); PG8_SCHED; PG8_LDA(At, 0, 0); PG8_STAGE_A(PG8_SA(1, 1), 1, a1 + hstepA, t + 1, offC);
            PG8_WAIT_V(8); PG8_WAIT_L(0); PG8_BAR; PG8_MMA(0, 0, At, B0); PG8_MMA(0, 1, At, B1); PG8_BAR; PG8_SCHED;
            PG8_LDA(At, 0, 1); PG8_STAGE(PG8_SB(0, 0), b2, voffB); PG8_STAGE(PG8_SB(0, 1), b2 + hstepB, voffB); PG8_STAGE_A(PG8_SA(0, 0), 0, a2, k2, offS);
            PG8_WAIT_V(8); PG8_WAIT_L(0); PG8_BAR; PG8_MMA(1, 0, At, B0); PG8_MMA(1, 1, At, B1); PG8_BAR; PG8_SCHED;
            PG8_LDB(B0, 1, 0); PG8_LDB(B1, 1, 1); PG8_SCHED; PG8_LDA(At, 1, 0); PG8_STAGE_A(PG8_SA(0, 1), 1, a2 + hstepA, k2, offS);
            PG8_WAIT_V(8); PG8_WAIT_L(0); PG8_BAR; PG8_MMA(0, 0, At, B0); PG8_MMA(0, 1, At, B1); PG8_BAR; PG8_SCHED;
            PG8_LDA(At, 1, 1); PG8_STAGE(PG8_SB(1, 0), b3, voffB); PG8_STAGE(PG8_SB(1, 1), b3 + hstepB, voffB); PG8_STAGE_A(PG8_SA(1, 0), 0, a3, k2 + 1, offS);
            PG8_WAIT_V(8); PG8_WAIT_L(0); PG8_BAR; PG8_MMA(1, 0, At, B0); PG8_MMA(1, 1, At, B1); PG8_BAR; PG8_SCHED;
            } else {
            PG8_LDB(B0, 0, 0); PG8_SCHED; PG8_LDA(At, 0, 0); PG8_STAGE(PG8_SA(1, 1), a1 + hstepA, voffA);
            PG8_WAIT_L(8); PG8_BAR; PG8_WAIT_L(0); PG8_MMA(0, 0, At, B0); PG8_BAR; PG8_SCHED;
            PG8_LDB(B1, 0, 1); PG8_STAGE(PG8_SB(0, 0), b2, voffB);
            PG8_BAR; PG8_WAIT_L(0); PG8_MMA(0, 1, At, B1); PG8_BAR;
            PG8_LDA(At, 0, 1); PG8_STAGE(PG8_SA(0, 0), a2, voffA);
            PG8_BAR; PG8_WAIT_L(0); PG8_MMA(1, 0, At, B0); PG8_BAR; PG8_SCHED;
            PG8_STAGE(PG8_SB(0, 1), b2 + hstepB, voffB);
            PG8_WAIT_V(6); PG8_BAR; PG8_MMA(1, 1, At, B1); PG8_BAR;
            PG8_LDB(B0, 1, 0); PG8_SCHED; PG8_LDA(At, 1, 0); PG8_STAGE(PG8_SA(0, 1), a2 + hstepA, voffA);
            PG8_WAIT_L(8); PG8_BAR; PG8_WAIT_L(0); PG8_MMA(0, 0, At, B0); PG8_BAR; PG8_SCHED;
            PG8_LDB(B1, 1, 1); PG8_STAGE(PG8_SB(1, 0), b3, voffB);
            PG8_BAR; PG8_WAIT_L(0); PG8_MMA(0, 1, At, B1); PG8_BAR;
            PG8_LDA(At, 1, 1); PG8_STAGE(PG8_SA(1, 0), a3, voffA);
            PG8_BAR; PG8_WAIT_L(0); PG8_MMA(1, 0, At, B0); PG8_BAR; PG8_SCHED;
            PG8_STAGE(PG8_SB(1, 1), b3 + hstepB, voffB);
            PG8_WAIT_V(6); PG8_BAR; PG8_MMA(1, 1, At, B1); PG8_BAR;
            }
        }
        }
        if (FP8) { TOC(21) }
        if constexpr (ALIGN_EPI) { if (wr == 0) PG8_BAR; }
        TIC(22)
        E(acc, cur, wr, wc, fr, fq); S.done(cur);
        if (FP8) { TOC(22) }
        if (!has_next) break;
#pragma unroll
        for (int a = 0; a < 2; ++a)
#pragma unroll
            for (int b = 0; b < 2; ++b)
#pragma unroll
                for (int m = 0; m < 4; ++m)
#pragma unroll
                    for (int n = 0; n < 2; ++n) acc[a][b][m][n] = (f32x4){0.f, 0.f, 0.f, 0.f};
        cur = nxt; cA = nA; cB = nB; ++ui;
        if constexpr (GATHER) { _Pragma("unroll") for (int _h = 0; _h < 2; ++_h) _Pragma("unroll") for (int _i = 0; _i < 2; ++_i) offC[_h][_i] = offN[_h][_i]; }
        if constexpr (ALIGN_EPI) { if (wr == 1) PG8_BAR; }
    }
    PG8_WAIT_V(0);
    if constexpr (!ALIGN_EPI) { if (wr == 0) PG8_BAR; }
    PG8_BAR;
#undef PG8_SA
#undef PG8_SB
#undef PG8_STAGE
#undef PG8_STAGE_A
#undef PG8_GOFF
#undef PG8_LDA
#undef PG8_LDB
#undef PG8_MMA
#undef PG8_WAIT_V
#undef PG8_WAIT_L
#undef PG8_BAR
#undef PG8_SCHED
}
}

#define LAS __attribute__((address_space(3)))
typedef unsigned short bf16;
typedef float f4 __attribute__((ext_vector_type(4)));
typedef float f2 __attribute__((ext_vector_type(2)));
typedef float f32x16 __attribute__((ext_vector_type(16)));
typedef short bf16x8 __attribute__((ext_vector_type(8)));
typedef unsigned v4u __attribute__((ext_vector_type(4)));
typedef unsigned v2u __attribute__((ext_vector_type(2)));

constexpr int T = 65536, DM = 1024, SEQ = 8192, NPROJ = 2568;
constexpr int NE = 32;
constexpr float EPS = 1e-6f;
constexpr int NPH = 14;
constexpr int RCAP = 229376;
constexpr int LDS_BYTES = 155648;

constexpr size_t MiB = (size_t)1 << 20;
constexpr size_t OFF_GATES = 1 * MiB, OFF_MLG = 3 * MiB, OFF_MLA = 3 * MiB + 16384, OFF_MLM = 3 * MiB + 32768;
constexpr size_t OFF_MLNP = 4 * MiB, OFF_MLN = 6 * MiB, OFF_KT = 8 * MiB, OFF_S5E = 10 * MiB, OFF_RSTD2 = 26 * MiB;
constexpr size_t OFF_ENTE = 27 * MiB, OFF_ENTG = 28 * MiB, OFF_ENTR = 29 * MiB, OFF_SDEST = 30 * MiB;
constexpr size_t OFF_CNT = 31 * MiB, OFF_TILEE = 31 * MiB + 65536, OFF_NTILE = 31 * MiB + 131072, OFF_RGATE = 32 * MiB;
constexpr size_t OFF_WIN = 64 * MiB, OFF_WGLU = 70 * MiB, OFF_WOUT = 71 * MiB, OFF_WGU = 74 * MiB, OFF_WDN = 202 * MiB;
constexpr size_t OFF_S5M = 266 * MiB, OFF_S5P = 338 * MiB, OFF_H1 = 354 * MiB, OFF_QK = 482 * MiB, OFF_V = 610 * MiB, OFF_O = 674 * MiB, OFF_UG = 738 * MiB, OFF_YSG = 810 * MiB;
constexpr size_t OFF_H2 = 266 * MiB, OFF_R1 = 394 * MiB, OFF_R2 = 620 * MiB, WS_NEED = 1002 * MiB;
constexpr size_t OFF_MO = 874 * MiB;
constexpr size_t OFF_ROWMAP = 34 * MiB, OFF_RSTDS = 36 * MiB;
constexpr size_t OFF_QC = 874 * MiB, OFF_VT = 938 * MiB, OFF_KCTW = 810 * MiB;
constexpr size_t OUT_UP = 0, OUT_CST = 134217728;

struct KArgs { const float* in[26]; float* out; unsigned char* ws; int ph_lo, ph_hi; };
enum { I_X = 0, I_N1G, I_WIN, I_BIF, I_CONVW, I_CONVB, I_HNG, I_LRE, I_LIM, I_LDT, I_BRE, I_BIM, I_CRE, I_CIM, I_DSKIP, I_WGLU, I_BGLU, I_WOUT, I_N2G, I_WR, I_BR, I_WGU, I_BGU, I_WDN, I_BDN, I_NFG };

typedef float f32x2_t_ __attribute__((ext_vector_type(2))); typedef __bf16 bf16x2_t_ __attribute__((ext_vector_type(2)));
__device__ __forceinline__ unsigned f2bf(float f) { const f32x2_t_ v = {f, 0.f}; const bf16x2_t_ b = __builtin_convertvector(v, bf16x2_t_); return __builtin_bit_cast(unsigned, b) & 0xffffu; }
typedef float f32x2_t __attribute__((ext_vector_type(2))); typedef __bf16 bf16x2_t __attribute__((ext_vector_type(2)));
__device__ __forceinline__ unsigned pk2(float lo, float hi) { const f32x2_t v = {lo, hi}; const bf16x2_t b = __builtin_convertvector(v, bf16x2_t); return __builtin_bit_cast(unsigned, b); }
__device__ __forceinline__ unsigned pk4_fp8(float a, float b, float c, float d) { int r = 0; r = __builtin_amdgcn_cvt_pk_fp8_f32(a, b, r, false); r = __builtin_amdgcn_cvt_pk_fp8_f32(c, d, r, true); return (unsigned)r; }
constexpr float FP8_WSCALE = 64.f, FP8_ASCALE = 4.f, FP8_YSCALE = 16.f;
__device__ __forceinline__ float bf2f(unsigned b) { return __builtin_bit_cast(float, b << 16); }
__device__ __forceinline__ float bflo(unsigned w) { return __builtin_bit_cast(float, w << 16); }
__device__ __forceinline__ float bfhi(unsigned w) { return __builtin_bit_cast(float, w & 0xffff0000u); }
__device__ __forceinline__ float wave_sum(float v) {
#pragma unroll
    for (int o = 1; o < 64; o <<= 1) v += __shfl_xor(v, o);
    return v;
}
__device__ __forceinline__ float wave_max(float v) {
#pragma unroll
    for (int o = 1; o < 64; o <<= 1) v = fmaxf(v, __shfl_xor(v, o));
    return v;
}
__device__ __forceinline__ float sigmoidf_(float x) { return __builtin_amdgcn_rcpf(1.f + __expf(-x)); }
__device__ __forceinline__ float siluf_(float x) { return x * __builtin_amdgcn_rcpf(1.f + __expf(-x)); }
__device__ __forceinline__ float logsigmoidf_(float x) { return x >= 0.f ? -log1pf(expf(-x)) : x - log1pf(expf(x)); }
__device__ __forceinline__ float gelu_tanh(float x) { const float z = 0.7978845608028654f * (x + 0.044715f * x * x * x); const float e = __expf(2.f * z); return 0.5f * x * (2.f - 2.f * __builtin_amdgcn_rcpf(e + 1.f)); }
#define LDS_WAIT() asm volatile("s_waitcnt lgkmcnt(0)" ::: "memory")

struct TrLoc { const float* src; bf16* dst; int ldw, ldt; int fp8; int blk_n; };
__device__ __forceinline__ void tr_load(const TrLoc& t, int lane, float (&v)[32]) {
    unsigned off = (unsigned)((lane >> 5) * t.ldw + (lane & 31)) * 4u; const unsigned st = 8u * (unsigned)t.ldw;
#pragma unroll
    for (int i = 0; i < 32; ++i) { v[i] = *(const float*)((const char*)t.src + off); off += st; }
}
__device__ __forceinline__ void tr_finish(const TrLoc& t, LAS float* scr, int lane, const float (&v)[32]) {
#pragma unroll
    for (int i = 0; i < 32; ++i) scr[(2 * i + (lane >> 5)) * 33 + (lane & 31)] = v[i];
    LDS_WAIT(); asm volatile("" ::: "memory");
    const int c = lane & 7;
    if (t.fp8) {
#pragma unroll
        for (int j = 0; j < 4; ++j) { const int n = (lane >> 3) + 8 * j; const LAS float* s = scr + (8 * c) * 33 + n;
            v2u o; o.x = pk4_fp8(s[0 * 33] * FP8_WSCALE, s[1 * 33] * FP8_WSCALE, s[2 * 33] * FP8_WSCALE, s[3 * 33] * FP8_WSCALE); o.y = pk4_fp8(s[4 * 33] * FP8_WSCALE, s[5 * 33] * FP8_WSCALE, s[6 * 33] * FP8_WSCALE, s[7 * 33] * FP8_WSCALE);
            *(v2u*)((unsigned char*)t.dst + (size_t)n * t.ldt + 8 * c) = o; }
    } else {
#pragma unroll
        for (int j = 0; j < 4; ++j) { const int n = (lane >> 3) + 8 * j; const LAS float* s = scr + (8 * c) * 33 + n;
            v4u o; o.x = pk2(s[0 * 33], s[1 * 33]); o.y = pk2(s[2 * 33], s[3 * 33]); o.z = pk2(s[4 * 33], s[5 * 33]); o.w = pk2(s[6 * 33], s[7 * 33]);
            *(v4u*)(t.dst + (size_t)n * t.ldt + 8 * c) = o; }
    }
    LDS_WAIT(); asm volatile("" ::: "memory");
}

__device__ __forceinline__ void lam_pow(float lre, float lim, float dt, int n, float& re, float& im) {
    const float mag = expf(lre * dt * (float)n);
    double th = (double)lim * (double)dt * (double)n;
    th -= 6.283185307179586476925 * rint(th * 0.15915494309189533577);
    const float s = __sinf((float)th), c = __cosf((float)th);
    re = mag * c; im = mag * s;
}

__device__ __forceinline__ void phase0(const KArgs& a, LAS unsigned char* L, int G) {
    const int tid = otid(), lane = tid & 63, wave = __builtin_amdgcn_readfirstlane(tid >> 6);
    const int gw = blockIdx.x * 8 + wave, NGW = G * 8;
    unsigned char* ws = a.ws;
    TIC(11)
    {
        LAS float* scr = (LAS float*)(L + wave * 8448);
        constexpr int N_IN = 16 * 80, N_GLU = 8 * 16, N_OUT = 16 * 32, N_GU = 32 * 16 * 64, N_DN = 32 * 16 * 32;
        constexpr int NITEMS = N_IN + N_GLU + N_OUT + N_GU + N_DN;
        auto locate = [&](int it) -> TrLoc {
            int r = it;
            if (r < N_IN) { const int kb = r / 80, nb = r % 80, n0 = 32 * nb, sc = n0 < 2048 ? n0 : n0 + 8;
                return TrLoc{a.in[I_WIN] + (size_t)(64 * kb) * NPROJ + sc, (bf16*)(ws + OFF_WIN) + (((size_t)(n0 >> 8) * 16 + kb) * 256 + (n0 & 255)) * 64, NPROJ, 64, 0, n0 & 255}; } r -= N_IN;
            if (r < N_GLU) { const int kb = r / 16, nb = r % 16, n0 = 32 * nb;
                return TrLoc{a.in[I_WGLU] + (size_t)(64 * kb) * 512 + n0, (bf16*)(ws + OFF_WGLU) + (size_t)n0 * 512 + 64 * kb, 512, 512, 0, -1}; } r -= N_GLU;
            if (r < N_OUT) { const int kb = r / 32, nb = r % 32, n0 = 32 * nb;
                return TrLoc{a.in[I_WOUT] + (size_t)(64 * kb) * 1024 + n0, (bf16*)(ws + OFF_WOUT) + (size_t)n0 * 1024 + 64 * kb, 1024, 1024, 0, -1}; } r -= N_OUT;
            if (r < N_GU) { const int e = r / 1024, q = r % 1024, kb = q / 64, nb = q % 64, n0 = 32 * nb, pn = n0 >> 8, wi = n0 & 255;
                const int sc = wi < 128 ? 128 * pn + wi : 1024 + 128 * pn + (wi - 128);
                return TrLoc{a.in[I_WGU] + (size_t)e * 1024 * 2048 + (size_t)(64 * kb) * 2048 + sc, (bf16*)(ws + OFF_WGU + ((((size_t)e * 8 + (n0 >> 8)) * 8 + (kb >> 1)) * 256 + (n0 & 255)) * 128 + (kb & 1) * 64), 2048, 128, 1, n0 & 255}; } r -= N_GU;
            { const int e = r / 512, q = r % 512, kb = q / 32, nb = q % 32, n0 = 32 * nb;
                return TrLoc{a.in[I_WDN] + (size_t)e * 1024 * 1024 + (size_t)(64 * kb) * 1024 + n0, (bf16*)(ws + OFF_WDN + ((((size_t)e * 4 + (n0 >> 8)) * 8 + (kb >> 1)) * 256 + (n0 & 255)) * 128 + (kb & 1) * 64), 1024, 128, 1, n0 & 255}; }
        };
        if (gw < NITEMS) {
            TrLoc cur = locate(gw); float vc[32]; tr_load(cur, lane, vc);
            for (int it = gw; it < NITEMS; it += NGW) {
                const int itn = (it + NGW < NITEMS) ? it + NGW : it;
                const TrLoc nxt = locate(itn); float vn[32]; tr_load(nxt, lane, vn);
                tr_finish(cur, scr, lane, vc);
                cur = nxt;
#pragma unroll
                for (int i = 0; i < 32; ++i) vc[i] = vn[i];
            }
        }
    }
    TOC(11)
    __syncthreads();
    TIC(12)
    {
        const float* lre = a.in[I_LRE]; const float* lim = a.in[I_LIM]; const float* ldt = a.in[I_LDT];
        const float* bre = a.in[I_BRE]; const float* bim = a.in[I_BIM]; const float* cre = a.in[I_CRE]; const float* cim = a.in[I_CIM];
        const int gt = blockIdx.x * 512 + tid, GT = G * 512;
        float* KT = (float*)(ws + OFF_KT);
        for (int task4 = gt; task4 < 32 * 64 * 16 * 4; task4 += GT) {
            const int task = task4 >> 2, pq = task4 & 3;
            const int g = task >> 10, tau = (task >> 4) & 63, i = task & 15;
            const float dt = expf(ldt[g]);
            float acc[16];
#pragma unroll
            for (int j = 0; j < 16; ++j) acc[j] = 0.f;
#pragma unroll 2
            for (int p = pq * 16; p < pq * 16 + 16; ++p) {
                const float lr = lre[g * 64 + p], li = lim[g * 64 + p];
                float pr, pi; lam_pow(lr, li, dt, tau, pr, pi);
                float l1r, l1i; lam_pow(lr, li, dt, 1, l1r, l1i);
                const float nr = l1r - 1.f, ni = l1i, den = lr * lr + li * li;
                const float fr = (nr * lr + ni * li) / den, fi = (ni * lr - nr * li) / den;
                const float cr = cre[(g * 16 + i) * 64 + p], ci = cim[(g * 16 + i) * 64 + p];
                const float zr = cr * pr - ci * pi, zi = cr * pi + ci * pr;
                const float yr = zr * fr - zi * fi, yi = zr * fi + zi * fr;
                const f4* br4 = (const f4*)(bre + (size_t)(g * 64 + p) * 16); const f4* bi4 = (const f4*)(bim + (size_t)(g * 64 + p) * 16);
#pragma unroll
                for (int q = 0; q < 4; ++q) { const f4 x = br4[q], y = bi4[q];
                    acc[4 * q + 0] += yr * x.x - yi * y.x; acc[4 * q + 1] += yr * x.y - yi * y.y; acc[4 * q + 2] += yr * x.z - yi * y.z; acc[4 * q + 3] += yr * x.w - yi * y.w; }
            }
#pragma unroll
            for (int j = 0; j < 16; ++j) { acc[j] += __shfl_xor(acc[j], 1); acc[j] += __shfl_xor(acc[j], 2); }
            if (pq == 0) { f4* o = (f4*)(KT + (size_t)task * 16);
#pragma unroll
                for (int q = 0; q < 4; ++q) o[q] = (f4){acc[4 * q], acc[4 * q + 1], acc[4 * q + 2], acc[4 * q + 3]}; }
        }
        bf16* S5P = (bf16*)(ws + OFF_S5P);
        for (int task = gt; task < 32 * 64 * 64; task += GT) {
            const int g = task >> 12, p = (task >> 6) & 63, s = task & 63;
            const float dt = expf(ldt[g]); const float lr = lre[g * 64 + p], li = lim[g * 64 + p];
            float pr, pi; lam_pow(lr, li, dt, 63 - s, pr, pi);
            float l1r, l1i; lam_pow(lr, li, dt, 1, l1r, l1i);
            const float nr = l1r - 1.f, ni = l1i, den = lr * lr + li * li;
            const float fr = (nr * lr + ni * li) / den, fi = (ni * lr - nr * li) / den;
            const float yr = pr * fr - pi * fi, yi = pr * fi + pi * fr;
            const float* br = bre + (size_t)(g * 64 + p) * 16; const float* bi = bim + (size_t)(g * 64 + p) * 16;
            unsigned ore[8], oim[8];
#pragma unroll
            for (int j = 0; j < 8; ++j) { const float x0 = br[2 * j], y0 = bi[2 * j], x1 = br[2 * j + 1], y1 = bi[2 * j + 1];
                ore[j] = pk2(yr * x0 - yi * y0, yr * x1 - yi * y1); oim[j] = pk2(yr * y0 + yi * x0, yr * y1 + yi * x1); }
            v4u* d0 = (v4u*)(S5P + ((size_t)(g * 256 + 2 * p) * 1024 + s * 16)); v4u* d1 = (v4u*)(S5P + ((size_t)(g * 256 + 2 * p + 1) * 1024 + s * 16));
            d0[0] = (v4u){ore[0], ore[1], ore[2], ore[3]}; d0[1] = (v4u){ore[4], ore[5], ore[6], ore[7]};
            d1[0] = (v4u){oim[0], oim[1], oim[2], oim[3]}; d1[1] = (v4u){oim[4], oim[5], oim[6], oim[7]};
        }
        for (int task = gt; task < 32 * 128 * 128; task += GT) {
            const int g = task >> 14, r = (task >> 7) & 127, c8 = task & 127;
            *(v4u*)(S5P + ((size_t)(g * 256 + 128 + r) * 1024 + c8 * 8)) = (v4u){0u, 0u, 0u, 0u};
        }
        bf16* S5M = (bf16*)(ws + OFF_S5M);
        for (int task = gt; task < 32 * 64 * 64; task += GT) {
            const int g = task >> 12, t = (task >> 6) & 63, p = task & 63;
            const float dt = expf(ldt[g]); const float lr = lre[g * 64 + p], li = lim[g * 64 + p];
            float pr, pi; lam_pow(lr, li, dt, t + 1, pr, pi);
#pragma unroll
            for (int i = 0; i < 16; ++i) { const float cr = cre[(g * 16 + i) * 64 + p], ci = cim[(g * 16 + i) * 64 + p];
                *(unsigned*)(S5M + ((size_t)(g * 1024 + t * 16 + i) * 1152 + 2 * p)) = pk2(cr * pr - ci * pi, -(cr * pi + ci * pr)); }
        }
    }
    TOC(12) TIC(13)
    {
        LAS float* wif = (LAS float*)(L + 69632);
        const float* win = a.in[I_WIN];
        for (int idx = tid; idx < 8192; idx += 512) wif[idx] = win[(size_t)(idx >> 3) * NPROJ + 2048 + (idx & 7)];
        __syncthreads();
        const float* x = a.in[I_X]; const float* g1 = a.in[I_N1G]; const float* bif = a.in[I_BIF];
        bf16* H1 = (bf16*)(ws + OFF_H1); float* GATES = (float*)(ws + OFF_GATES);
        f4 gv[4];
#pragma unroll
        for (int j = 0; j < 4; ++j) gv[j] = ((const f4*)g1)[lane + 64 * j];
        for (int m0 = 2 * gw; m0 < T; m0 += 2 * NGW) {
            f4 v2[2][4];
#pragma unroll
            for (int rr = 0; rr < 2; ++rr) { const f4* xr = (const f4*)(x + (size_t)(m0 + rr) * DM) + lane;
#pragma unroll
                for (int j = 0; j < 4; ++j) v2[rr][j] = xr[64 * j]; }
#pragma unroll
            for (int rr = 0; rr < 2; ++rr) { const int m = m0 + rr;
            f4 v[4]; float ss = 0.f;
#pragma unroll
            for (int j = 0; j < 4; ++j) { v[j] = v2[rr][j]; ss += (v[j].x * v[j].x + v[j].y * v[j].y) + (v[j].z * v[j].z + v[j].w * v[j].w); }
            const float rstd = rsqrtf(wave_sum(ss) * (1.f / DM) + EPS);
            float ga[8];
#pragma unroll
            for (int c = 0; c < 8; ++c) ga[c] = 0.f;
            bf16* o8 = H1 + (((size_t)(m >> 8) * 16 + (lane >> 4)) * 256 + (m & 255)) * 64 + 4 * (lane & 15);
#pragma unroll
            for (int j = 0; j < 4; ++j) { v[j] = v[j] * rstd * gv[j];
                *(unsigned long long*)(o8 + (size_t)j * 4 * 256 * 64) = (unsigned long long)pk2(v[j].x, v[j].y) | ((unsigned long long)pk2(v[j].z, v[j].w) << 32);
#pragma unroll
                for (int e = 0; e < 4; ++e) { const int k = 4 * lane + 256 * j + e; const f4 w0 = *(const LAS f4*)(wif + k * 8), w1 = *(const LAS f4*)(wif + k * 8 + 4); const float hv = v[j][e];
                    ga[0] += hv * w0.x; ga[1] += hv * w0.y; ga[2] += hv * w0.z; ga[3] += hv * w0.w; ga[4] += hv * w1.x; ga[5] += hv * w1.y; ga[6] += hv * w1.z; ga[7] += hv * w1.w; }
            }
            float r4[4], r2[2], r1;
            { const bool hi = lane & 32;
#pragma unroll
              for (int i = 0; i < 4; ++i) { const float send = hi ? ga[i] : ga[i + 4], keep = hi ? ga[i + 4] : ga[i]; r4[i] = keep + __shfl_xor(send, 32); } }
            { const bool hi = lane & 16;
#pragma unroll
              for (int i = 0; i < 2; ++i) { const float send = hi ? r4[i] : r4[i + 2], keep = hi ? r4[i + 2] : r4[i]; r2[i] = keep + __shfl_xor(send, 16); } }
            { const bool hi = lane & 8; const float send = hi ? r2[0] : r2[1], keep = hi ? r2[1] : r2[0]; r1 = keep + __shfl_xor(send, 8); }
            r1 += __shfl_xor(r1, 4); r1 += __shfl_xor(r1, 2); r1 += __shfl_xor(r1, 1);
            if ((lane & 7) == 0) { const int c = (lane >> 3) & 7; GATES[(size_t)m * 8 + c] = r1 + bif[c]; }
            }
        }
    }
    TOC(13)
}

__device__ __forceinline__ void s5_expand(const KArgs& a, int G) {
    const float* KT = (const float*)(a.ws + OFF_KT); bf16* S5M = (bf16*)(a.ws + OFF_S5M);
    const int gt = blockIdx.x * 512 + otid(), GT = G * 512;
    for (int task = gt; task < 32 * 1024 * 64; task += GT) {
        const int s = task & 63, row = task >> 6, g = row >> 10, t = (row >> 4) & 63, i = row & 15;
        if (s >= ((t >> 4) + 1) * 16) continue;
        v4u o0 = (v4u){0u, 0u, 0u, 0u}, o1 = o0;
        if (s <= t) { const f4* k4 = (const f4*)(KT + ((size_t)((g * 64 + (t - s)) * 16 + i)) * 16); const f4 a0 = k4[0], a1 = k4[1], a2 = k4[2], a3 = k4[3];
            o0 = (v4u){pk2(a0.x, a0.y), pk2(a0.z, a0.w), pk2(a1.x, a1.y), pk2(a1.z, a1.w)}; o1 = (v4u){pk2(a2.x, a2.y), pk2(a2.z, a2.w), pk2(a3.x, a3.y), pk2(a3.z, a3.w)}; }
        v4u* d = (v4u*)(S5M + ((size_t)row * 1152 + 128 + s * 16)); d[0] = o0; d[1] = o1;
    }
}

using pg8::Unit; using pg8::cvt_pk_bf16;
struct EpiInProj {
    static constexpr bool PERM = true;
    bf16 *QK, *V, *O, *UG;
    __device__ __forceinline__ void operator()(const pg8::f32x4 (&acc)[2][2][4][2], const Unit& u, int wr, int wc, int fr, int fq) const {
        const int row0 = u.pm * 256 + wr * 64 + fr, c0 = wc * 32 + 8 * fq;
#pragma unroll
        for (int ai = 0; ai < 2; ++ai)
#pragma unroll
            for (int m = 0; m < 4; ++m) { const int row = row0 + ai * 128 + m * 16;
#pragma unroll
                for (int bj = 0; bj < 2; ++bj) { const pg8::f32x4 v0 = acc[ai][bj][m][0], v1 = acc[ai][bj][m][1];
                    v4u w; w.x = cvt_pk_bf16(v0[0], v0[1]); w.y = cvt_pk_bf16(v0[2], v0[3]); w.z = cvt_pk_bf16(v1[0], v1[1]); w.w = cvt_pk_bf16(v1[2], v1[3]);
                    const int col = c0 + bj * 128;
                    bf16* dst;
                    if (u.pn < 4) dst = QK + (size_t)row * 1024 + u.pn * 256 + col;
                    else if (u.pn < 6) dst = V + (size_t)row * 512 + (u.pn - 4) * 256 + col;
                    else if (u.pn < 8) dst = O + (size_t)row * 512 + (u.pn - 6) * 256 + col;
                    else { const int uc = (u.pn - 8) * 256 + col, g = uc >> 4, j = uc & 15; dst = UG + ((size_t)(g * 1024 + (row >> 6)) * 1152 + 128 + (row & 63) * 16 + j); }
                    *(v4u*)dst = w; } }
    }
};
struct EpiS5E {
    static constexpr bool PERM = false;
    float* E;
    __device__ __forceinline__ void operator()(const pg8::f32x4 (&acc)[2][2][4][2], const Unit& u, int wr, int wc, int fr, int fq) const {
        const int row0 = u.pm * 256 + wr * 64 + fr, col0 = wc * 32 + 4 * fq;
#pragma unroll
        for (int ai = 0; ai < 2; ++ai)
#pragma unroll
            for (int m = 0; m < 4; ++m) { float* rowp = E + (size_t)(row0 + ai * 128 + m * 16) * 128 + col0;
#pragma unroll
                for (int n = 0; n < 2; ++n) *(pg8::f32x4*)(rowp + n * 16) = acc[ai][0][m][n]; }
    }
};
struct EpiS5Y {
    static constexpr bool PERM = true;
    const bf16* UG; const float* dskip; bf16* YSG;
    __device__ __forceinline__ void operator()(const pg8::f32x4 (&acc)[2][2][4][2], const Unit& u, int wr, int wc, int fr, int fq) const {
        const int g = u.pm >> 2, row0 = u.pm * 256 + wr * 64 + fr, c0 = (u.pn & 3) * 256 + wc * 32 + 8 * fq;
#pragma unroll
        for (int ai = 0; ai < 2; ++ai)
#pragma unroll
            for (int m = 0; m < 4; ++m) { const int row = row0 + ai * 128 + m * 16, chunk = row & 1023;
#pragma unroll
                for (int bj = 0; bj < 2; ++bj) { const int n = c0 + bj * 128, t = n >> 4, i0 = n & 15;
                    const v4u uw = *(const v4u*)(UG + ((size_t)row * 1152 + 128 + n));
                    const f4 d0 = *(const f4*)(dskip + g * 16 + i0), d1 = *(const f4*)(dskip + g * 16 + i0 + 4);
                    const pg8::f32x4 v0 = acc[ai][bj][m][0], v1 = acc[ai][bj][m][1];
                    float y[8];
                    y[0] = v0[0] + d0.x * bflo(uw.x); y[1] = v0[1] + d0.y * bfhi(uw.x); y[2] = v0[2] + d0.z * bflo(uw.y); y[3] = v0[3] + d0.w * bfhi(uw.y);
                    y[4] = v1[0] + d1.x * bflo(uw.z); y[5] = v1[1] + d1.y * bfhi(uw.z); y[6] = v1[2] + d1.z * bflo(uw.w); y[7] = v1[3] + d1.w * bfhi(uw.w);
#pragma unroll
                    for (int e = 0; e < 8; ++e) y[e] = gelu_tanh(y[e]);
                    v4u w; w.x = cvt_pk_bf16(y[0], y[1]); w.y = cvt_pk_bf16(y[2], y[3]); w.z = cvt_pk_bf16(y[4], y[5]); w.w = cvt_pk_bf16(y[6], y[7]);
                    *(v4u*)(YSG + ((size_t)(chunk * 64 + t) * 512 + g * 16 + i0)) = w; } }
    }
};
struct EpiGlu {
    static constexpr bool PERM = true;
    const bf16* YSG; const float* bglu; bf16* MIX;
    __device__ __forceinline__ void operator()(const pg8::f32x4 (&acc)[2][2][4][2], const Unit& u, int wr, int wc, int fr, int fq) const {
        const int row0 = u.pm * 256 + wr * 64 + fr, c0 = u.pn * 256 + wc * 32 + 8 * fq;
#pragma unroll
        for (int ai = 0; ai < 2; ++ai)
#pragma unroll
            for (int m = 0; m < 4; ++m) { const int row = row0 + ai * 128 + m * 16;
#pragma unroll
                for (int bj = 0; bj < 2; ++bj) { const int col = c0 + bj * 128;
                    const v4u yw = *(const v4u*)(YSG + (size_t)row * 512 + col);
                    const f4 b0 = *(const f4*)(bglu + col), b1 = *(const f4*)(bglu + col + 4);
                    const pg8::f32x4 v0 = acc[ai][bj][m][0], v1 = acc[ai][bj][m][1];
                    float y[8];
                    y[0] = bflo(yw.x) * sigmoidf_(v0[0] + b0.x); y[1] = bfhi(yw.x) * sigmoidf_(v0[1] + b0.y); y[2] = bflo(yw.y) * sigmoidf_(v0[2] + b0.z); y[3] = bfhi(yw.y) * sigmoidf_(v0[3] + b0.w);
                    y[4] = bflo(yw.z) * sigmoidf_(v1[0] + b1.x); y[5] = bfhi(yw.z) * sigmoidf_(v1[1] + b1.y); y[6] = bflo(yw.w) * sigmoidf_(v1[2] + b1.z); y[7] = bfhi(yw.w) * sigmoidf_(v1[3] + b1.w);
                    v4u w; w.x = cvt_pk_bf16(y[0], y[1]); w.y = cvt_pk_bf16(y[2], y[3]); w.z = cvt_pk_bf16(y[4], y[5]); w.w = cvt_pk_bf16(y[6], y[7]);
                    *(v4u*)(MIX + (size_t)row * 1024 + 512 + col) = w; } }
    }
};
struct EpiOut {
    static constexpr bool PERM = true;
    bf16* MO;
    __device__ __forceinline__ void operator()(const pg8::f32x4 (&acc)[2][2][4][2], const Unit& u, int wr, int wc, int fr, int fq) const {
        const int row0 = u.pm * 256 + wr * 64 + fr, c0 = u.pn * 256 + wc * 32 + 8 * fq;
#pragma unroll
        for (int ai = 0; ai < 2; ++ai)
#pragma unroll
            for (int m = 0; m < 4; ++m) { bf16* rowp = MO + (size_t)(row0 + ai * 128 + m * 16) * 1024 + c0;
#pragma unroll
                for (int bj = 0; bj < 2; ++bj) { const pg8::f32x4 v0 = acc[ai][bj][m][0], v1 = acc[ai][bj][m][1];
                    v4u w; w.x = cvt_pk_bf16(v0[0], v0[1]); w.y = cvt_pk_bf16(v0[2], v0[3]); w.z = cvt_pk_bf16(v1[0], v1[1]); w.w = cvt_pk_bf16(v1[2], v1[3]);
                    *(v4u*)(rowp + bj * 128) = w; } }
    }
};
struct EpiMoeGU {
    static constexpr bool PERM = true;
    const float* bgu; unsigned char* ACT; const float* rstds;
    __device__ __forceinline__ void operator()(const pg8::f32x4 (&acc)[2][2][4][2], const Unit& u, int wr, int wc, int fr, int fq) const {
        const int e = u.pn >> 3, pnl = u.pn & 7, row0 = u.pm * 256 + wr * 64 + fr, c0 = pnl * 128 + wc * 32 + 8 * fq;
        const float* bg = bgu + (size_t)e * 2048 + c0; const float* bu = bg + 1024;
        const f4 g0 = *(const f4*)bg, g1 = *(const f4*)(bg + 4), u0 = *(const f4*)bu, u1 = *(const f4*)(bu + 4);
        const float gb[8] = {g0.x, g0.y, g0.z, g0.w, g1.x, g1.y, g1.z, g1.w}, ub[8] = {u0.x, u0.y, u0.z, u0.w, u1.x, u1.y, u1.z, u1.w};
        constexpr float inv = 1.f / (FP8_WSCALE * FP8_ASCALE);
#pragma unroll
        for (int ai = 0; ai < 2; ++ai)
#pragma unroll
            for (int m = 0; m < 4; ++m) { const int row = row0 + ai * 128 + m * 16; const float ri = rstds[row] * inv;
                float y[8];
#pragma unroll
                for (int n = 0; n < 2; ++n)
#pragma unroll
                    for (int q = 0; q < 4; ++q) { const int k = 4 * n + q;
                        const float gate = fminf(acc[ai][0][m][n][q] * ri + gb[k], 7.0f); const float up = fminf(fmaxf(acc[ai][1][m][n][q] * ri + ub[k], -7.0f), 7.0f);
                        y[k] = (up + 1.0f) * gate * sigmoidf_(1.702f * gate) * FP8_ASCALE; }
                v2u w; w.x = pk4_fp8(y[0], y[1], y[2], y[3]); w.y = pk4_fp8(y[4], y[5], y[6], y[7]);
                *(v2u*)(ACT + ((size_t)(u.pm * 8 + pnl) * 256 + (row & 255)) * 128 + (wc * 32 + 8 * fq)) = w; }
    }
};
struct EpiMoeDN {
    static constexpr bool PERM = true;
    const float* bdn; const float* rgate; unsigned char* YS;
    __device__ __forceinline__ void operator()(const pg8::f32x4 (&acc)[2][2][4][2], const Unit& u, int wr, int wc, int fr, int fq) const {
        const int e = u.pn >> 2, pnl = u.pn & 3, row0 = u.pm * 256 + wr * 64 + fr, c0 = pnl * 256 + wc * 32 + 8 * fq;
#pragma unroll
        for (int bj = 0; bj < 2; ++bj) { const int col = c0 + bj * 128;
            const f4 b0 = *(const f4*)(bdn + (size_t)e * 1024 + col), b1 = *(const f4*)(bdn + (size_t)e * 1024 + col + 4);
#pragma unroll
            for (int ai = 0; ai < 2; ++ai)
#pragma unroll
                for (int m = 0; m < 4; ++m) { const int row = row0 + ai * 128 + m * 16; const float gt = rgate[row];
                    const pg8::f32x4 v0 = acc[ai][bj][m][0] * (1.f / (FP8_WSCALE * FP8_ASCALE)), v1 = acc[ai][bj][m][1] * (1.f / (FP8_WSCALE * FP8_ASCALE));
                    const float gs = gt * FP8_YSCALE;
                    v2u w; w.x = pk4_fp8((v0[0] + b0.x) * gs, (v0[1] + b0.y) * gs, (v0[2] + b0.z) * gs, (v0[3] + b0.w) * gs);
                    w.y = pk4_fp8((v1[0] + b1.x) * gs, (v1[1] + b1.y) * gs, (v1[2] + b1.z) * gs, (v1[3] + b1.w) * gs);
                    *(v2u*)(YS + (size_t)row * 1024 + col) = w; } }
    }
};

struct S5EOrder {
    int G, c;
    __device__ __forceinline__ bool next(int i, Unit& u) const { const int x = c & 7, j = c >> 3; if (i > 0 || j >= 16) return false; const int g = x + 8 * (j >> 2); u.pm = g * 4 + (j & 3); u.pn = g; u.rd = 0; u.nt = 0; return true; }
    __device__ __forceinline__ void a_ready(const Unit&) const {}
    __device__ __forceinline__ void done(const Unit&) const {}
};
struct S5YOrder {
    int G, c;
    __device__ __forceinline__ bool next(int i, Unit& u) const { if (i >= 2) return false; const int x = c & 7, j = c >> 3, g = x + 8 * (2 * i + (j >> 4)), r = j & 15, b = i ? 3 - (r & 3) : (r & 3);
        u.pm = g * 4 + (r >> 2); u.pn = g * 4 + b; u.rd = i; u.nt = 6 + 4 * b; return true; }
    __device__ __forceinline__ void a_ready(const Unit&) const {}
    __device__ __forceinline__ void done(const Unit&) const {}
};
struct MoeOrder {
    const int* tile_e; int ntile, NT, G, c;
    unsigned* sync;
    __device__ __forceinline__ bool next(int i, Unit& u) const {
#ifdef HALF_CHIP
        const int x = c & 7, RT = 32 / NT; if ((c >> 3) >= 16) return false; const int j = (c >> 3) + 16 * (i & 1); i >>= 1;
#else
        const int x = c & 7, j = c >> 3, RT = 32 / NT;
#endif
        const int it = (i * 8 + x) * RT + j / NT, pnl = j % NT;
        if (it >= ntile) return false;
#ifdef DN_REVERSE
        if (NT == 4) { const int itr = ntile - 1 - it; u.pm = itr; u.pn = tile_e[itr] * NT + pnl; u.rd = i; u.nt = 0; return true; }
#endif
        u.pm = it; u.pn = tile_e[it] * NT + pnl; u.rd = i; u.nt = 0; return true; }
    __device__ __forceinline__ void a_ready(const Unit&) const {}
    __device__ __forceinline__ void done(const Unit&) const {}
};

typedef short v4i16_t __attribute__((ext_vector_type(4)));
__device__ __forceinline__ bf16x8 tr_frag(const LAS unsigned char* img, int RS, int ks, int n0, int lane) {
    const int h = lane >> 5, blk = (lane >> 4) & 1, q = (lane & 15) >> 2, p = lane & 3;
    const LAS unsigned char* a0 = img + (16 * ks + 8 * h + q) * RS + (n0 + 16 * blk + 4 * p) * 2;
    const v4i16_t lo = __builtin_amdgcn_ds_read_tr16_b64_v4i16((LAS v4i16_t*)a0), hi = __builtin_amdgcn_ds_read_tr16_b64_v4i16((LAS v4i16_t*)(a0 + 4 * RS));
    return (bf16x8){lo[0], lo[1], lo[2], lo[3], hi[0], hi[1], hi[2], hi[3]};
}
__device__ __forceinline__ int tr_base(int RS, int lane) { const int h = lane >> 5, blk = (lane >> 4) & 1, q = (lane & 15) >> 2, p = lane & 3; return (8 * h + q) * RS + (16 * blk + 4 * p) * 2; }
__device__ __forceinline__ bf16x8 tr_frag_b(const LAS unsigned char* lanebase, int RS, int off) {
    const v4i16_t lo = __builtin_amdgcn_ds_read_tr16_b64_v4i16((LAS v4i16_t*)(lanebase + off)), hi = __builtin_amdgcn_ds_read_tr16_b64_v4i16((LAS v4i16_t*)(lanebase + off + 4 * RS));
    return (bf16x8){lo[0], lo[1], lo[2], lo[3], hi[0], hi[1], hi[2], hi[3]};
}
__device__ __forceinline__ v4u pack8(const float (&v)[8]) { v4u w; w.x = pk2(v[0], v[1]); w.y = pk2(v[2], v[3]); w.z = pk2(v[4], v[5]); w.w = pk2(v[6], v[7]); return w; }
constexpr int ML_KT = 0, ML_VT = 34816, ML_TILE = 17408;
constexpr int ML_CW = 69632;
constexpr int ML_GA = 74752;
constexpr int ML_PW = 79616;
struct KvRaw { v4u k[4][2]; v4u v[2]; unsigned m[4]; };
__device__ __forceinline__ void kv_load(KvRaw& R, const bf16* QKb  , const bf16* Vb  , int srow  , int col0) {
#pragma unroll
    for (int i = 0; i < 4; ++i) { const int r = srow - 3 + i; const v4u* p = (const v4u*)(QKb + (size_t)(r < 0 ? 0 : r) * 1024 + col0); R.k[i][0] = p[0]; R.k[i][1] = p[1]; R.m[i] = r < 0 ? 0u : 0xffffffffu; }
    const v4u* pv = (const v4u*)(Vb + (size_t)srow * 512 + col0); R.v[0] = pv[0]; R.v[1] = pv[1];
}
__device__ __forceinline__ void kv_conv(const KvRaw& R, const LAS float* cw, int col0, float mul, float (&o)[16]) {
#pragma unroll
    for (int q = 0; q < 4; ++q) { const f4 bv = *(const LAS f4*)(cw + 4 * 128 + col0 + 4 * q); o[4 * q] = bv.x; o[4 * q + 1] = bv.y; o[4 * q + 2] = bv.z; o[4 * q + 3] = bv.w; }
#pragma unroll
    for (int i = 0; i < 4; ++i) { const unsigned m = R.m[i];
        const unsigned xw[8] = {R.k[i][0].x & m, R.k[i][0].y & m, R.k[i][0].z & m, R.k[i][0].w & m, R.k[i][1].x & m, R.k[i][1].y & m, R.k[i][1].z & m, R.k[i][1].w & m};
#pragma unroll
        for (int q = 0; q < 4; ++q) { const f4 w = *(const LAS f4*)(cw + i * 128 + col0 + 4 * q);
            o[4 * q] += w.x * bflo(xw[2 * q]); o[4 * q + 1] += w.y * bfhi(xw[2 * q]); o[4 * q + 2] += w.z * bflo(xw[2 * q + 1]); o[4 * q + 3] += w.w * bfhi(xw[2 * q + 1]); } }
#pragma unroll
    for (int e = 0; e < 16; ++e) o[e] = siluf_(o[e]) * mul;
}
__device__ __forceinline__ void gate_part1(const float* GATES, int tok0, int h, int tid, float& bbw, float& ig, LAS float* scr, int nw) {
    const int lane = tid & 63, wave = tid >> 6;
    if (wave < nw) { const float fg = GATES[(size_t)(tok0 + tid) * 8 + 4 + h]; ig = GATES[(size_t)(tok0 + tid) * 8 + h];
        bbw = logsigmoidf_(fg);
#pragma unroll
        for (int o = 1; o < 64; o <<= 1) { const float t = __shfl_up(bbw, o); if (lane >= o) bbw += t; }
        if (lane == 63) scr[wave] = bbw; }
}
__device__ __forceinline__ void mlstm_state_item(const KArgs& a, LAS unsigned char* L, int item) {
    const int tid = otid(), lane = tid & 63, wave = tid >> 6;
    const int c = item & 63, bh = item >> 6, h = bh & 3, b = bh >> 2, tok0 = b * SEQ + c * 128;
    LAS float* cwk = (LAS float*)(L + ML_CW) + 640; LAS float* wsv = (LAS float*)(L + ML_GA); LAS float* scr = wsv + 1024;
    const bf16* QKb = (const bf16*)(a.ws + OFF_QK) + (size_t)(b * SEQ) * 1024 + 512 + h * 128; const bf16* Vb = (const bf16*)(a.ws + OFF_V) + (size_t)(b * SEQ) * 512 + h * 128;
    const int s = tid >> 3, col0 = (tid & 7) * 16;
    KvRaw R; kv_load(R, QKb, Vb, c * 128 + s, col0);
    if (tid < 160) { const int r = tid >> 5, q4 = (tid & 31) * 4; *(LAS f4*)(cwk + r * 128 + q4) = r < 4 ? *(const f4*)(a.in[I_CONVW] + r * 1024 + 512 + h * 128 + q4) : *(const f4*)(a.in[I_CONVB] + 512 + h * 128 + q4); }
    float bbw = 0.f, ig = 0.f; gate_part1((const float*)(a.ws + OFF_GATES), tok0, h, tid, bbw, ig, scr, 2);
    __syncthreads();
    float wl = -3.0e38f;
    if (wave < 2) { float off = 0.f;
#pragma unroll
        for (int w = 0; w < 2; ++w) if (w < wave) off += scr[w];
        const float g = scr[0] + scr[1]; wl = g - (bbw + off) + ig;
        const float wm = wave_max(wl); if (lane == 0) scr[8 + wave] = wm;
        if (tid == 0) ((float*)(a.ws + OFF_MLG))[item] = g; }
    __syncthreads();
    if (wave < 2) { const float amax = fmaxf(scr[8], scr[9]); wsv[tid] = expf(wl - amax); if (tid == 0) ((float*)(a.ws + OFF_MLA))[item] = amax; }
    __syncthreads();
    const int kdb = wave >> 1, vb0 = (wave & 1) * 2, r32 = lane & 31, hh = lane >> 5;
    f32x16 acc0, acc1;
#pragma unroll
    for (int i = 0; i < 16; ++i) { acc0[i] = 0.f; acc1[i] = 0.f; }
    float np = 0.f;
#pragma unroll 1
    for (int j = 0; j < 2; ++j) {
        LAS unsigned char* kt = L + ML_KT + (j & 1) * ML_TILE; LAS unsigned char* vt = L + ML_VT + (j & 1) * ML_TILE;
        { float o[16]; kv_conv(R, cwk, col0, 0.08838834764831845f * wsv[64 * j + s], o);
          const float o0[8] = {o[0], o[1], o[2], o[3], o[4], o[5], o[6], o[7]}, o1[8] = {o[8], o[9], o[10], o[11], o[12], o[13], o[14], o[15]};
          *(LAS v4u*)(kt + s * 272 + col0 * 2) = pack8(o0); *(LAS v4u*)(kt + s * 272 + col0 * 2 + 16) = pack8(o1);
          *(LAS v4u*)(vt + s * 272 + col0 * 2) = R.v[0]; *(LAS v4u*)(vt + s * 272 + col0 * 2 + 16) = R.v[1]; }
        kv_load(R, QKb, Vb, c * 128 + 64 + s, col0);
        __syncthreads();
#pragma unroll
        for (int ks = 0; ks < 4; ++ks) { const bf16x8 A = tr_frag(kt, 272, ks, kdb * 32, lane), B0 = tr_frag(vt, 272, ks, vb0 * 32, lane), B1 = tr_frag(vt, 272, ks, vb0 * 32 + 32, lane);
            acc0 = __builtin_amdgcn_mfma_f32_32x32x16_bf16(A, B0, acc0, 0, 0, 0); acc1 = __builtin_amdgcn_mfma_f32_32x32x16_bf16(A, B1, acc1, 0, 0, 0); }
        if (tid < 128) {
#pragma unroll 8
            for (int q = 0; q < 64; ++q) np += bf2f(*(const LAS bf16*)(kt + q * 272 + tid * 2)); }
    }
    {
        bf16* UP = (bf16*)((unsigned char*)a.out + OUT_UP) + (size_t)item * 16384;
#pragma unroll
        for (int q = 0; q < 4; ++q) { const int kd = kdb * 32 + 8 * q + 4 * hh;
            v2u w0; w0.x = pk2(acc0[4 * q], acc0[4 * q + 1]); w0.y = pk2(acc0[4 * q + 2], acc0[4 * q + 3]);
            v2u w1; w1.x = pk2(acc1[4 * q], acc1[4 * q + 1]); w1.y = pk2(acc1[4 * q + 2], acc1[4 * q + 3]);
            *(v2u*)(UP + (size_t)(vb0 * 32 + r32) * 128 + kd) = w0; *(v2u*)(UP + (size_t)((vb0 + 1) * 32 + r32) * 128 + kd) = w1; }
        if (tid < 128) ((float*)(a.ws + OFF_MLNP))[(size_t)item * 128 + tid] = np;
    }
    __syncthreads();
}

__device__ __forceinline__ void phase3(const KArgs& a, LAS unsigned char* L, int G) {
    const int tid = otid(), lane = tid & 63, wave = tid >> 6;
    LAS float* ga = (LAS float*)L; LAS float* aa = ga + 64; LAS float* dec = aa + 64; LAS float* scl = dec + 64;
    for (int w = blockIdx.x; w < 256; w += G) {
        const int bh = w >> 3, slice = w & 7;
        if (tid < 64) { ga[tid] = ((const float*)(a.ws + OFF_MLG))[bh * 64 + tid]; aa[tid] = ((const float*)(a.ws + OFF_MLA))[bh * 64 + tid]; }
        __syncthreads();
        if (tid == 0) { float m = 0.f; float* MLM = (float*)(a.ws + OFF_MLM);
            for (int c = 0; c < 64; ++c) { const float g = ga[c], am = aa[c], mn = fmaxf(g + m, am); dec[c] = expf(g + m - mn); scl[c] = expf(am - mn); if (slice == 0) MLM[bh * 64 + c] = m; m = mn; } }
        __syncthreads();
        {
            const size_t e0 = (size_t)bh * 64 * 16384 + slice * 2048 + tid * 4;
            const bf16* up = (const bf16*)((const unsigned char*)a.out + OUT_UP) + e0; bf16* cs = (bf16*)((unsigned char*)a.out + OUT_CST) + e0;
            float C0 = 0.f, C1 = 0.f, C2 = 0.f, C3 = 0.f;
            for (int c0 = 0; c0 < 64; c0 += 16) {
                v2u uv[16];
#pragma unroll
                for (int q = 0; q < 16; ++q) uv[q] = *(const v2u*)(up + (size_t)(c0 + q) * 16384);
#pragma unroll
                for (int q = 0; q < 16; ++q) { v2u o; o.x = pk2(C0, C1); o.y = pk2(C2, C3); *(v2u*)(cs + (size_t)(c0 + q) * 16384) = o;
                    const float d = dec[c0 + q], sc = scl[c0 + q];
                    C0 = d * C0 + sc * bflo(uv[q].x); C1 = d * C1 + sc * bfhi(uv[q].x); C2 = d * C2 + sc * bflo(uv[q].y); C3 = d * C3 + sc * bfhi(uv[q].y); }
            }
        }
        if (slice == 0 && tid < 128) { const float* np = (const float*)(a.ws + OFF_MLNP) + (size_t)bh * 64 * 128 + tid; float* ns = (float*)(a.ws + OFF_MLN) + (size_t)bh * 64 * 128 + tid; float n = 0.f;
            for (int c = 0; c < 64; ++c) { ns[c * 128] = n; n = dec[c] * n + scl[c] * np[c * 128]; } }
        __syncthreads();
    }
    if (wave == 7) for (int w = blockIdx.x; w < 256; w += G) {
        const int b = w >> 5, g = w & 31, p = lane;
        const float dt = expf(a.in[I_LDT][g]); float lr, li; lam_pow(a.in[I_LRE][g * 64 + p], a.in[I_LIM][g * 64 + p], dt, 64, lr, li);
        const float* E = (const float*)(a.ws + OFF_S5E) + ((size_t)(g * 1024 + b * 128) * 128 + 2 * p);
        bf16* UG = (bf16*)(a.ws + OFF_UG) + ((size_t)(g * 1024 + b * 128) * 1152 + 2 * p);
        float xr = 0.f, xi = 0.f;
        for (int c0 = 0; c0 < 128; c0 += 8) {
            f2 ev[8];
#pragma unroll
            for (int q = 0; q < 8; ++q) ev[q] = *(const f2*)(E + (size_t)(c0 + q) * 128);
#pragma unroll
            for (int q = 0; q < 8; ++q) { *(unsigned*)(UG + (size_t)(c0 + q) * 1152) = pk2(xr, xi);
                const float nr = lr * xr - li * xi + ev[q].x, ni = lr * xi + li * xr + ev[q].y; xr = nr; xi = ni; }
        }
    }
}

__device__ __forceinline__ void kq_load(KvRaw& R, const bf16* QKq, int srow, int col0) {
#pragma unroll
    for (int i = 0; i < 4; ++i) { const int r = srow - 3 + i; const v4u* p = (const v4u*)(QKq + (size_t)(r < 0 ? 0 : r) * 1024 + col0); R.k[i][0] = p[0]; R.k[i][1] = p[1]; R.m[i] = r < 0 ? 0u : 0xffffffffu; }
}
__device__ __forceinline__ bf16x8 tr16_frag(const LAS unsigned char* lanebase, int off) {
    const v4i16_t lo = __builtin_amdgcn_ds_read_tr16_b64_v4i16((LAS v4i16_t*)(lanebase + off)), hi = __builtin_amdgcn_ds_read_tr16_b64_v4i16((LAS v4i16_t*)(lanebase + off + 4 * 272));
    return (bf16x8){lo[0], lo[1], lo[2], lo[3], hi[0], hi[1], hi[2], hi[3]};
}
__device__ __forceinline__ void mlstm_out_item(const KArgs& a, LAS unsigned char* L, int item, int next_item, KvRaw& Ra, KvRaw& Rb, int& h_loaded) {
    const int tid = otid(), lane = tid & 63, wave = __builtin_amdgcn_readfirstlane(tid >> 6);
    const int c = item & 63, bh = item >> 6, h = bh & 3, b = bh >> 2, tok0 = b * SEQ + c * 128;
    const int fr = lane & 15, fq = lane >> 4;
    LAS float* cwq = (LAS float*)(L + ML_CW); LAS float* cwk = cwq + 640;
    LAS float* gcs = (LAS float*)(L + ML_GA); LAS float* grr = gcs + 256; LAS float* gsc = grr + 256; LAS float* gen = gsc + 256; LAS float* scr = gen + 256;
    LAS bf16* Pw = (LAS bf16*)(L + ML_PW + wave * 2304);
    const bf16* QKq = (const bf16*)(a.ws + OFF_QK) + (size_t)(b * SEQ) * 1024 + h * 128;
    const bf16* QKb = QKq + 512; const bf16* Vb = (const bf16*)(a.ws + OFF_V) + (size_t)(b * SEQ) * 512 + h * 128;
    const int s = tid >> 3, col0 = (tid & 7) * 16;
    TIC(31) TIC(36)
    if (h != h_loaded) {
    if (tid < 320) { const int t2 = tid < 160 ? tid : tid - 160, r = t2 >> 5, q4 = (t2 & 31) * 4, ch = (tid < 160 ? 0 : 512) + h * 128 + q4;
        *(LAS f4*)((tid < 160 ? cwq : cwk) + r * 128 + q4) = r < 4 ? *(const f4*)(a.in[I_CONVW] + r * 1024 + ch) : *(const f4*)(a.in[I_CONVB] + ch); }
    else if (tid < 352) *(LAS f4*)(scr + 64 + 4 * (tid - 320)) = *(const f4*)(a.in[I_HNG] + h * 128 + 4 * (tid - 320));
    h_loaded = h; }
    float bbw = 0.f, ig = 0.f; gate_part1((const float*)(a.ws + OFF_GATES), tok0, h, tid, bbw, ig, scr, 2);
    __syncthreads();
    float cs = 0.f, pmw = -3.0e38f, bb = 0.f;
    if (wave < 2) { const float off = wave ? scr[0] : 0.f;
        bb = bbw + off; cs = ig - bb; pmw = cs;
#pragma unroll
        for (int o = 1; o < 64; o <<= 1) { const float t = __shfl_up(pmw, o); if (lane >= o) pmw = fmaxf(pmw, t); }
        if (lane == 63) scr[8 + wave] = pmw; }
    {
        float o[16]; kv_conv(Ra, cwq, col0, 1.f, o);
        { const float o0[8] = {o[0], o[1], o[2], o[3], o[4], o[5], o[6], o[7]}, o1[8] = {o[8], o[9], o[10], o[11], o[12], o[13], o[14], o[15]};
          *(LAS v4u*)(L + s * 272 + col0 * 2) = pack8(o0); *(LAS v4u*)(L + s * 272 + col0 * 2 + 16) = pack8(o1); }
        kv_conv(Rb, cwq, col0, 1.f, o);
        { const float o0[8] = {o[0], o[1], o[2], o[3], o[4], o[5], o[6], o[7]}, o1[8] = {o[8], o[9], o[10], o[11], o[12], o[13], o[14], o[15]};
          *(LAS v4u*)(L + (64 + s) * 272 + col0 * 2) = pack8(o0); *(LAS v4u*)(L + (64 + s) * 272 + col0 * 2 + 16) = pack8(o1); }
    }
    KvRaw R; kv_load(R, QKb, Vb, c * 128 + s, col0);
    __syncthreads();
    TOC(31) TIC(32)
    bf16x8 Aq[4];
#pragma unroll
    for (int ks = 0; ks < 4; ++ks) Aq[ks] = *(const LAS bf16x8*)(L + (16 * wave + fr) * 272 + (32 * ks + 8 * fq) * 2);
    if (wave < 2) { const float pm = wave ? fmaxf(pmw, scr[8]) : pmw;
        const float mk = ((const float*)(a.ws + OFF_MLM))[item], rr = fmaxf(pm, mk);
        gcs[tid] = cs; grr[tid] = rr; gsc[tid] = expf(mk - rr); gen[tid] = expf(-bb - rr); }
    __syncthreads();
    TOC(32) TIC(33)
    pg8::f32x4 num[8]; float rs[4] = {0.f, 0.f, 0.f, 0.f};
#pragma unroll
    for (int cb = 0; cb < 8; ++cb) num[cb] = (pg8::f32x4){0.f, 0.f, 0.f, 0.f};
    const int jmax = wave >> 2;
#pragma unroll 1
    for (int j = 0; j < 2; ++j) {
        LAS unsigned char* kt = L + ML_KT + (j & 1) * ML_TILE; LAS unsigned char* vt = L + ML_VT + (j & 1) * ML_TILE;
        { float o[16]; kv_conv(R, cwk, col0, 0.08838834764831845f, o);
          const float o0[8] = {o[0], o[1], o[2], o[3], o[4], o[5], o[6], o[7]}, o1[8] = {o[8], o[9], o[10], o[11], o[12], o[13], o[14], o[15]};
          *(LAS v4u*)(kt + s * 272 + col0 * 2) = pack8(o0); *(LAS v4u*)(kt + s * 272 + col0 * 2 + 16) = pack8(o1);
          *(LAS v4u*)(vt + s * 272 + col0 * 2) = R.v[0]; *(LAS v4u*)(vt + s * 272 + col0 * 2 + 16) = R.v[1]; }
        kv_load(R, QKb, Vb, c * 128 + 64 + s, col0);
        __syncthreads();
        if (j <= jmax) {
            const LAS unsigned char* ktb = kt + fr * 272 + 16 * fq; const LAS unsigned char* vtb = vt + (8 * fq + (fr >> 2)) * 272 + 8 * (fr & 3);
            LAS bf16* pwb = Pw + (4 * fq) * 72 + fr; const LAS bf16* pab = Pw + fr * 72 + 8 * fq; const LAS float* grb = grr + 16 * wave + 4 * fq; const int tg0 = 16 * wave + 4 * fq;
            asm volatile("" : "+v"(ktb), "+v"(vtb), "+v"(pwb), "+v"(pab), "+v"(grb));
#pragma unroll
            for (int st = 0; st < 4; ++st) {
                pg8::f32x4 sacc = (pg8::f32x4){0.f, 0.f, 0.f, 0.f};
#pragma unroll
                for (int ks = 0; ks < 4; ++ks) { const bf16x8 Bk = *(const LAS bf16x8*)(ktb + st * 16 * 272 + 64 * ks); sacc = __builtin_amdgcn_mfma_f32_16x16x32_bf16(Aq[ks], Bk, sacc, 0, 0, 0); }
                const int sg = 64 * j + 16 * st + fr; const float csv = gcs[sg];
#pragma unroll
                for (int q = 0; q < 4; ++q) { const float ev = __expf(fminf(csv - grb[q], 0.f)); const float pv = (sg <= tg0 + q) ? sacc[q] * ev : 0.f; rs[q] += pv; pwb[q * 72 + 16 * st] = (bf16)f2bf(pv); }
            }
#pragma unroll
            for (int ks = 0; ks < 2; ++ks) { const bf16x8 Ap = *(const LAS bf16x8*)(pab + 32 * ks);
#pragma unroll
                for (int cb = 0; cb < 8; ++cb) num[cb] = __builtin_amdgcn_mfma_f32_16x16x32_bf16(Ap, tr16_frag(vtb, 32 * ks * 272 + 32 * cb), num[cb], 0, 0, 0); }
        }
    }
    TOC(33) TIC(34)
    v4u ow4[4];
    { const bf16* Op = (const bf16*)(a.ws + OFF_O) + (size_t)(tok0 + 16 * wave + (lane >> 2)) * 512 + h * 128 + (lane & 3) * 8;
#pragma unroll
      for (int i = 0; i < 4; ++i) ow4[i] = *(const v4u*)(Op + 32 * i); }
#pragma unroll
    for (int q = 0; q < 4; ++q) { rs[q] += __shfl_xor(rs[q], 1); rs[q] += __shfl_xor(rs[q], 2); rs[q] += __shfl_xor(rs[q], 4); rs[q] += __shfl_xor(rs[q], 8); }
    float sc_t[4], inv[4]; float ss[4] = {0.f, 0.f, 0.f, 0.f};
    {
        const float* nst = (const float*)(a.ws + OFF_MLN) + (size_t)item * 128 + 8 * fq;
        const bf16* CST = (const bf16*)((const unsigned char*)a.out + OUT_CST) + ((size_t)item * 128 + fr) * 128 + 8 * fq;
        f4 nv[8];
#pragma unroll
        for (int ks = 0; ks < 4; ++ks) { nv[2 * ks] = *(const f4*)(nst + ks * 32); nv[2 * ks + 1] = *(const f4*)(nst + ks * 32 + 4); }
        bf16x8 GA[2][4], GB[2][4];
#define LOAD_C(G, cb0) do { _Pragma("unroll") for (int c_ = 0; c_ < 2; ++c_) _Pragma("unroll") for (int ks = 0; ks < 4; ++ks) G[c_][ks] = *(const bf16x8*)(CST + (size_t)((cb0) + c_) * 16 * 128 + ks * 32); } while (0)
#define COMP_C(G, cb0) do { _Pragma("unroll") for (int c_ = 0; c_ < 2; ++c_) { pg8::f32x4 accC = (pg8::f32x4){0.f, 0.f, 0.f, 0.f}; \
        _Pragma("unroll") for (int ks = 0; ks < 4; ++ks) accC = __builtin_amdgcn_mfma_f32_16x16x32_bf16(Aq[ks], G[c_][ks], accC, 0, 0, 0); \
        _Pragma("unroll") for (int q = 0; q < 4; ++q) { const float v = (num[(cb0) + c_][q] + sc_t[q] * accC[q]) * inv[q]; num[(cb0) + c_][q] = v; ss[q] += v * v; } } } while (0)
        LOAD_C(GA, 0); LOAD_C(GB, 2);
        const unsigned msk = fr == 0 ? 0xffffffffu : 0u;
        pg8::f32x4 accn = (pg8::f32x4){0.f, 0.f, 0.f, 0.f};
#pragma unroll
        for (int ks = 0; ks < 4; ++ks) { const f4 n0 = nv[2 * ks], n1 = nv[2 * ks + 1];
            v4u w; w.x = pk2(n0.x, n0.y) & msk; w.y = pk2(n0.z, n0.w) & msk; w.z = pk2(n1.x, n1.y) & msk; w.w = pk2(n1.z, n1.w) & msk;
            accn = __builtin_amdgcn_mfma_f32_16x16x32_bf16(Aq[ks], __builtin_bit_cast(bf16x8, w), accn, 0, 0, 0); }
#pragma unroll
        for (int q = 0; q < 4; ++q) { const int tg = 16 * wave + 4 * fq + q; sc_t[q] = gsc[tg]; const float qn = __shfl(accn[q], lane & 48); const float den = rs[q] + sc_t[q] * qn; inv[q] = __builtin_amdgcn_rcpf(fmaxf(fabsf(den), gen[tg])); }
        COMP_C(GA, 0); LOAD_C(GA, 4);
        COMP_C(GB, 2); LOAD_C(GB, 6);
        COMP_C(GA, 4); COMP_C(GB, 6);
#undef LOAD_C
#undef COMP_C
    }
    TOC(34) TIC(35)
    { const int nc = next_item & 63, nbh = next_item >> 6, nh = nbh & 3, nb = nbh >> 2; const bf16* nq = (const bf16*)(a.ws + OFF_QK) + (size_t)(nb * SEQ) * 1024 + nh * 128;
      kq_load(Ra, nq, nc * 128 + s, col0); kq_load(Rb, nq, nc * 128 + 64 + s, col0); }
    __syncthreads();
    LAS float* Hw = (LAS float*)(L + wave * 8448);
    const LAS float* ghn = scr + 64;
#pragma unroll
    for (int q = 0; q < 4; ++q) { ss[q] += __shfl_xor(ss[q], 1); ss[q] += __shfl_xor(ss[q], 2); ss[q] += __shfl_xor(ss[q], 4); ss[q] += __shfl_xor(ss[q], 8);
        const float rstd = rsqrtf(ss[q] * (1.f / 128.f) + EPS);
#pragma unroll
        for (int cb = 0; cb < 8; ++cb) Hw[(4 * fq + q) * 132 + cb * 16 + fr] = num[cb][q] * rstd; }
    __syncthreads();
    {
        const int t = lane >> 2, vq = lane & 3;
        const LAS float* hg = ghn + vq * 8;
        bf16* MIX = (bf16*)(a.ws + OFF_H1) + (size_t)(tok0 + 16 * wave + t) * 1024 + h * 128 + vq * 8;
#pragma unroll
        for (int i = 0; i < 4; ++i) { const v4u ow = ow4[i]; const f4 h0 = *(const LAS f4*)(Hw + t * 132 + vq * 8 + 32 * i), h1 = *(const LAS f4*)(Hw + t * 132 + vq * 8 + 32 * i + 4);
            const f4 g0 = *(const LAS f4*)(hg + 32 * i), g1 = *(const LAS f4*)(hg + 32 * i + 4);
            float y[8];
            y[0] = sigmoidf_(bflo(ow.x)) * h0.x * g0.x; y[1] = sigmoidf_(bfhi(ow.x)) * h0.y * g0.y; y[2] = sigmoidf_(bflo(ow.y)) * h0.z * g0.z; y[3] = sigmoidf_(bfhi(ow.y)) * h0.w * g0.w;
            y[4] = sigmoidf_(bflo(ow.z)) * h1.x * g1.x; y[5] = sigmoidf_(bfhi(ow.z)) * h1.y * g1.y; y[6] = sigmoidf_(bflo(ow.w)) * h1.z * g1.z; y[7] = sigmoidf_(bfhi(ow.w)) * h1.w * g1.w;
            *(v4u*)(MIX + 32 * i) = pack8(y); }
    }
    __syncthreads();
    TOC(35) TOC(36)
}

template <int N, int MASK> __device__ __forceinline__ void rs_step(float* v, int lane) {
    const bool hi = (lane & MASK) != 0;
#pragma unroll
    for (int i = 0; i < N; ++i) { const float send = hi ? v[i] : v[i + N], keep = hi ? v[i + N] : v[i]; v[i] = keep + __shfl_xor(send, MASK); }
}
__device__ __forceinline__ void phase7(const KArgs& a, LAS unsigned char* L, int G) {
    const int tid = otid(), lane = tid & 63, wave = __builtin_amdgcn_readfirstlane(tid >> 6);
    LAS float* wrT = (LAS float*)L;
    LAS float* g2l = (LAS float*)(L + 131584);
    LAS unsigned char* le = L + 131584 + 4096;
    LAS int* lcnt = (LAS int*)(L + 131584 + 4096 + 1024);
    LAS float* sc = (LAS float*)(L + 131584 + 4096 + 1024 + 128) + wave * 528;
    const float* wr = a.in[I_WR]; const float* g2 = a.in[I_N2G]; const float* br = a.in[I_BR];
    for (int idx = tid; idx < 1024; idx += 512) g2l[idx] = g2[idx];
    for (int idx = tid; idx < 32768; idx += 512) wrT[(idx & 31) * 1028 + (idx >> 5)] = wr[idx] * g2[idx >> 5];
    const float* X1 = a.in[I_X]; const bf16* MO = (const bf16*)(a.ws + OFF_MO);
    unsigned char* H2 = a.ws + OFF_H2; float* RSTD = (float*)(a.ws + OFF_RSTD2);
    int* ENTE = (int*)(a.ws + OFF_ENTE); float* ENTG = (float*)(a.ws + OFF_ENTG); int* ENTR = (int*)(a.ws + OFF_ENTR); int* CNT = (int*)(a.ws + OFF_CNT);
    const int ti = lane & 31, kh = lane >> 5;
    for (int chunk = blockIdx.x; chunk < 256; chunk += G) {
        if (tid < 32) lcnt[tid] = 0;
        __syncthreads();
        {
            const int t0 = chunk * 256 + wave * 32;
            const float* xrow = X1 + (size_t)(t0 + ti) * DM + 512 * kh; const bf16* mrow = MO + (size_t)(t0 + ti) * DM + 512 * kh; unsigned char* hrow = H2 + (size_t)(t0 + ti) * DM + 512 * kh;
            const LAS float* wl = wrT + ti * 1028 + 512 * kh; const LAS float* gl = g2l + 512 * kh;
            f32x16 acc;
#pragma unroll
            for (int i = 0; i < 16; ++i) acc[i] = 0.f;
            float ssq = 0.f;
            f4 xc[16];
#define X1_LOAD(xr_, mr_, e0) do { _Pragma("unroll") for (int q = 0; q < 16; ++q) xr_[q] = *(const f4*)(xrow + (e0) + 4 * q); _Pragma("unroll") for (int q = 0; q < 8; ++q) mr_[q] = *(const v4u*)(mrow + (e0) + 8 * q); } while (0)
#define X1_ADD(dst, xr_, mr_) do { _Pragma("unroll") for (int q = 0; q < 8; ++q) { dst[2 * q].x = xr_[2 * q].x + bflo(mr_[q].x); dst[2 * q].y = xr_[2 * q].y + bfhi(mr_[q].x); dst[2 * q].z = xr_[2 * q].z + bflo(mr_[q].y); dst[2 * q].w = xr_[2 * q].w + bfhi(mr_[q].y); \
                dst[2 * q + 1].x = xr_[2 * q + 1].x + bflo(mr_[q].z); dst[2 * q + 1].y = xr_[2 * q + 1].y + bfhi(mr_[q].z); dst[2 * q + 1].z = xr_[2 * q + 1].z + bflo(mr_[q].w); dst[2 * q + 1].w = xr_[2 * q + 1].w + bfhi(mr_[q].w); } } while (0)
            { f4 x0[16]; v4u m0[8]; X1_LOAD(x0, m0, 0); X1_ADD(xc, x0, m0); }
#pragma unroll 1
            for (int c = 0; c < 8; ++c) {
                f4 xn[16]; v4u mn[8]; const int ne = 64 * (c < 7 ? c + 1 : 7);
                X1_LOAD(xn, mn, ne);
#pragma unroll
                for (int q4 = 0; q4 < 4; ++q4) { v4u hw;
#pragma unroll
                    for (int qq = 0; qq < 4; ++qq) { const int q = 4 * q4 + qq; const f4 w4 = *(const LAS f4*)(wl + 64 * c + 4 * q), g4 = *(const LAS f4*)(gl + 64 * c + 4 * q); const f4 x = xc[q];
                        acc = __builtin_amdgcn_mfma_f32_32x32x2f32(x.x, w4.x, acc, 0, 0, 0); acc = __builtin_amdgcn_mfma_f32_32x32x2f32(x.y, w4.y, acc, 0, 0, 0);
                        acc = __builtin_amdgcn_mfma_f32_32x32x2f32(x.z, w4.z, acc, 0, 0, 0); acc = __builtin_amdgcn_mfma_f32_32x32x2f32(x.w, w4.w, acc, 0, 0, 0);
                        ssq += (x.x * x.x + x.y * x.y) + (x.z * x.z + x.w * x.w);
                        hw[qq] = pk4_fp8(x.x * g4.x * FP8_ASCALE, x.y * g4.y * FP8_ASCALE, x.z * g4.z * FP8_ASCALE, x.w * g4.w * FP8_ASCALE); }
                    *(v4u*)(hrow + 64 * c + 16 * q4) = hw; }
                X1_ADD(xc, xn, mn);
            }
            ssq += __shfl_xor(ssq, 32);
            const float rstd = rsqrtf(ssq * (1.f / DM) + EPS);
            if (lane < 32) RSTD[t0 + lane] = rstd;
#pragma unroll
            for (int p = 0; p < 2; ++p) {
#pragma unroll
                for (int r8 = 0; r8 < 8; ++r8) { const int r = 8 * p + r8, rowl = (r & 3) + 8 * ((r >> 2) & 1) + 4 * kh; sc[rowl * 33 + ti] = acc[r]; }
                const float rs_t = __shfl(rstd, 16 * p + (lane & 15));
                if (lane < 16) {
                    float v[32];
#pragma unroll
                    for (int e = 0; e < 32; ++e) v[e] = sc[lane * 33 + e] * rs_t + br[e];
                    float tv[4]; int te[4];
#pragma unroll
                    for (int k = 0; k < 4; ++k) { float bv = v[0]; int be = 0;
#pragma unroll
                        for (int e = 1; e < 32; ++e) if (v[e] > bv) { bv = v[e]; be = e; }
                        tv[k] = bv; te[k] = be;
#pragma unroll
                        for (int e = 0; e < 32; ++e) v[e] = (e == be) ? -3.0e38f : v[e]; }
                    const float e1 = __expf(tv[1] - tv[0]), e2 = __expf(tv[2] - tv[0]), e3 = __expf(tv[3] - tv[0]), inv = __builtin_amdgcn_rcpf(1.f + e1 + e2 + e3);
                    const int tl = wave * 32 + 16 * p + lane, tt = chunk * 256 + tl;
                    *(int4*)(ENTE + (size_t)tt * 4) = make_int4(te[0], te[1], te[2], te[3]);
                    *(f4*)(ENTG + (size_t)tt * 4) = (f4){inv, e1 * inv, e2 * inv, e3 * inv};
                    *(LAS unsigned*)(le + tl * 4) = (unsigned)te[0] | ((unsigned)te[1] << 8) | ((unsigned)te[2] << 16) | ((unsigned)te[3] << 24);
                }
            }
        }
        __syncthreads();
#pragma unroll
        for (int q = 0; q < 2; ++q) { const int idx = tid + 512 * q; const int e = le[idx]; const int rk = __hip_atomic_fetch_add(&lcnt[e], 1, __ATOMIC_RELAXED, __HIP_MEMORY_SCOPE_WORKGROUP); ENTR[chunk * 1024 + idx] = rk; }
        __syncthreads();
        if (tid < 32) CNT[chunk * 32 + tid] = lcnt[tid];
        __syncthreads();
    }
}

__device__ __forceinline__ int wsum32(int v) { v += __shfl_xor(v, 1); v += __shfl_xor(v, 2); v += __shfl_xor(v, 4); v += __shfl_xor(v, 8); v += __shfl_xor(v, 16); return v; }
__device__ __forceinline__ int place_preamble(const KArgs& a, LAS unsigned char* L, bool write_tiles) {
    const int tid = otid();
    LAS int* tot = (LAS int*)L; LAS int* pst = tot + 64; LAS int* misc = pst + 96; LAS int* cntl = (LAS int*)(L + 1024);
    const int* CNT = (const int*)(a.ws + OFF_CNT); int* TILEE = (int*)(a.ws + OFF_TILEE); int* NTILE = (int*)(a.ws + OFF_NTILE);
    for (int i = tid; i < 8192; i += 512) cntl[i] = CNT[i];
    __syncthreads();
    if (tid < 64) { const int e = tid & 31;
        int all = 0; for (int c = 0; c < 256; ++c) all += cntl[c * 32 + e];
        int run = 0, best = 1 << 30, bestc = 192, bestrun = 0;
        for (int c = 0; c < 232; ++c) { run += cntl[c * 32 + e];
            if (c + 1 >= 160) { const int nA = wsum32((run + 255) >> 8), nB = wsum32((all - run + 255) >> 8);
                const int cost = 32 * (((nA + 31) >> 5) + ((nB + 31) >> 5) + ((nA + 63) >> 6) + ((nB + 63) >> 6)) + (256 - (c + 1));
                if (nA <= 896 && nB <= 544 && cost <= best) { best = cost; bestc = c + 1; bestrun = run; } } }
        if (best == (1 << 30)) { bestrun = 0; for (int c = 0; c < 192; ++c) bestrun += cntl[c * 32 + e]; }
        if (tid < 32) { tot[e] = bestrun; tot[32 + e] = all - bestrun; if (tid == 0) misc[0] = bestc; } }
    __syncthreads();
    if (tid < 2) { const int hf = tid; int run = 0;
        for (int e = 0; e < 32; ++e) { pst[hf * 32 + e] = run; run += ((tot[hf * 32 + e] + 255) >> 8) << 8; }
        misc[1 + hf] = run >> 8;
        if (write_tiles) { NTILE[hf] = run >> 8; if (hf == 0) NTILE[2] = misc[0]; } }
    __syncthreads();
    if (write_tiles) {
        for (int hf = 0; hf < 2; ++hf) for (int i = tid; i < misc[1 + hf]; i += 512) { int e = 0;
#pragma unroll
            for (int q = 1; q < 32; ++q) e = (pst[hf * 32 + q] <= (i << 8) && tot[hf * 32 + q] > 0) ? q : e;
            TILEE[hf * 1024 + i] = e; } }
    return misc[0];
}
__device__ __forceinline__ void phase8(const KArgs& a, LAS unsigned char* L, int G) {
    const int tid = otid();
    LAS int* tot = (LAS int*)L; LAS int* pst = tot + 64; LAS int* base = pst + 64; LAS int* cntl = (LAS int*)(L + 1024);
    const int* ENTE = (const int*)(a.ws + OFF_ENTE); const int* ENTR = (const int*)(a.ws + OFF_ENTR); const float* ENTG = (const float*)(a.ws + OFF_ENTG);
    int* SDEST = (int*)(a.ws + OFF_SDEST); float* RGATE = (float*)(a.ws + OFF_RGATE); int* ROWMAP = (int*)(a.ws + OFF_ROWMAP); float* RSTDS = (float*)(a.ws + OFF_RSTDS); const float* RSTD = (const float*)(a.ws + OFF_RSTD2);
    const int cA = place_preamble(a, L, blockIdx.x == 0);
    if (blockIdx.x == 0 && tid < 64) { const int hf = tid >> 5, t0 = tot[tid], p0 = pst[tid], pe = p0 + (((t0 + 255) >> 8) << 8);
        for (int r = p0 + t0; r < pe; ++r) { ROWMAP[hf * RCAP + r] = 0; RGATE[hf * RCAP + r] = 0.f; RSTDS[hf * RCAP + r] = 0.f; } }
    for (int chunk = blockIdx.x; chunk < 256; chunk += G) {
        const int hf = chunk >= cA ? 1 : 0;
        if (tid < 32) { int s = pst[hf * 32 + tid]; for (int c = hf ? cA : 0; c < chunk; ++c) s += cntl[c * 32 + tid]; base[tid] = s; }
        __syncthreads();
#pragma unroll
        for (int q = 0; q < 2; ++q) { const int gi = chunk * 1024 + tid + 512 * q; const int e = ENTE[gi]; const int d = base[e] + ENTR[gi]; SDEST[gi] = d; RGATE[hf * RCAP + d] = ENTG[gi]; ROWMAP[hf * RCAP + d] = gi >> 2; RSTDS[hf * RCAP + d] = RSTD[gi >> 2]; }
        __syncthreads();
    }
}

__device__ __forceinline__ void combine_half(const KArgs& a, int hf, const unsigned char* YS, int G) {
    const int tid = otid(), lane = tid & 63, wave = tid >> 6;
    const int gw = blockIdx.x * 8 + wave, NGW = G * 8;
    const int* SDEST = (const int*)(a.ws + OFF_SDEST); const float* gf = a.in[I_NFG];
    f4 gv[4];
#pragma unroll
    for (int j = 0; j < 4; ++j) gv[j] = ((const f4*)gf)[lane + 64 * j];
    const int cA = ((const int*)(a.ws + OFF_NTILE))[2], tbeg = hf ? cA * 256 : 0, tend = hf ? T : cA * 256;
    for (int t = tbeg + gw; t < tend; t += NGW) {
        f4* xr = (f4*)(a.out + (size_t)t * DM) + lane; const f4* xin = (const f4*)(a.in[I_X] + (size_t)t * DM) + lane; const v2u* mo8 = (const v2u*)((const bf16*)(a.ws + OFF_MO) + (size_t)t * DM) + lane;
        f4 v[4];
#pragma unroll
        for (int j = 0; j < 4; ++j) { v[j] = xin[64 * j]; const v2u w = mo8[64 * j]; v[j].x += bflo(w.x); v[j].y += bfhi(w.x); v[j].z += bflo(w.y); v[j].w += bfhi(w.y); }
#pragma unroll
        for (int k = 0; k < 4; ++k) { const int d = SDEST[t * 4 + k]; const unsigned* y4 = (const unsigned*)(YS + (size_t)d * DM) + lane;
#pragma unroll
            for (int j = 0; j < 4; ++j) { const int w = (int)y4[64 * j]; const f2 lo = __builtin_amdgcn_cvt_pk_f32_fp8(w, false), hi = __builtin_amdgcn_cvt_pk_f32_fp8(w, true);
                v[j].x += lo.x * (1.f / FP8_YSCALE); v[j].y += lo.y * (1.f / FP8_YSCALE); v[j].z += hi.x * (1.f / FP8_YSCALE); v[j].w += hi.y * (1.f / FP8_YSCALE); } }
        float ss = 0.f;
#pragma unroll
        for (int j = 0; j < 4; ++j) ss += (v[j].x * v[j].x + v[j].y * v[j].y) + (v[j].z * v[j].z + v[j].w * v[j].w);
        const float rstd = rsqrtf(wave_sum(ss) * (1.f / DM) + EPS);
#pragma unroll
        for (int j = 0; j < 4; ++j) xr[64 * j] = v[j] * rstd * gv[j];
    }
}

#define XB_TMO      128
#define XB_XCNT(j)  (256  + 64 * (j))
#define XB_XSUB(j)  (1280 + 64 * (j))
#define XB_XGEN(j)  (2304 + 64 * (j))
#define XB_TOP      3328
#define XB_TOPGEN   3392
#define XCD_BAR_WORDS 3456
#define XB_SPIN_CAP (1u << 18)

__device__ __forceinline__ unsigned xb_ld(unsigned* p)              { return __hip_atomic_load(p, __ATOMIC_RELAXED, __HIP_MEMORY_SCOPE_AGENT); }
__device__ __forceinline__ unsigned xb_add(unsigned* p, unsigned v) { return __hip_atomic_fetch_add(p, v, __ATOMIC_RELAXED, __HIP_MEMORY_SCOPE_AGENT); }
__device__ __forceinline__ unsigned xb_xcc_id() { return (unsigned)__builtin_amdgcn_s_getreg((3 << 11) | 20) & 0xFu; }
#define XB_SPIN(cond, bar) do { unsigned _sp = 0; while (cond) { __builtin_amdgcn_s_sleep(1); \
    if ((++_sp & 255u) == 0u) { if (xb_ld(&(bar)[XB_TMO])) break; if (_sp > XB_SPIN_CAP) { atomicAdd(&(bar)[XB_TMO], 1u); break; } } } } while (0)

struct XcdBarrier {
    unsigned* bar; unsigned x;
    volatile LAS unsigned* st;
};

__device__ __forceinline__ XcdBarrier xcd_barrier_post(unsigned* bar, volatile LAS unsigned* st) {
    XcdBarrier b; b.bar = bar; b.x = xb_xcc_id(); b.st = st;
    if (threadIdx.x == 0) (void)xb_add(&bar[XB_XCNT(b.x)], 1u);
    return b;
}
__device__ __forceinline__ void xcd_barrier_complete(unsigned* bar, unsigned x, unsigned& nloc, unsigned& nx) {
    const unsigned G = gridDim.x * gridDim.y * gridDim.z;
    unsigned sum, cnt, mine, sp = 0u;
    for (;;) {
        sum = 0u; cnt = 0u; mine = 0u;
#pragma unroll
        for (unsigned j = 0; j < 16; ++j) { const unsigned c = xb_ld(&bar[XB_XCNT(j)]); sum += c; cnt += (c > 0u) ? 1u : 0u; mine = (j == x) ? c : mine; }
        if (sum == G) break;
        __builtin_amdgcn_s_sleep(1);
        if ((++sp & 255u) == 0u) { if (xb_ld(&bar[XB_TMO])) break; if (sp > XB_SPIN_CAP) { atomicAdd(&bar[XB_TMO], 1u); break; } }
    }
    nloc = mine > 0u ? mine : 1u; nx = cnt > 0u ? cnt : 1u;
}

__device__ __forceinline__ void xcd_barrier(const XcdBarrier& b) {
    asm volatile("s_waitcnt vmcnt(0)" ::: "memory");
    __syncthreads();
    if (threadIdx.x == 0) {
        unsigned* bar = b.bar;
        __builtin_amdgcn_s_waitcnt(0);
        unsigned nloc = b.st[0], nx = b.st[1];
        if (nloc == 0u) { xcd_barrier_complete(bar, b.x, nloc, nx); b.st[0] = nloc; b.st[1] = nx; }
        const unsigned old = xb_add(&bar[XB_XSUB(b.x)], 1u);
        const unsigned gen = old / nloc;
        if (old + 1u == (gen + 1u) * nloc) {
            __builtin_amdgcn_fence(__ATOMIC_RELEASE, "agent");
            asm volatile("s_waitcnt vmcnt(0)" ::: "memory");
            const unsigned og = xb_add(&bar[XB_TOP], 1u);
            const unsigned tg = og / nx;
            if (og + 1u == (tg + 1u) * nx) xb_add(&bar[XB_TOPGEN], 1u);
            else XB_SPIN(xb_ld(&bar[XB_TOPGEN]) == tg, bar);
            __builtin_amdgcn_fence(__ATOMIC_ACQUIRE, "agent");
            xb_add(&bar[XB_XGEN(b.x)], 1u);
            asm volatile("s_waitcnt vmcnt(0)" ::: "memory");
        } else {
            XB_SPIN(xb_ld(&bar[XB_XGEN(b.x)]) == gen, bar);
            __builtin_amdgcn_fence(__ATOMIC_ACQUIRE, "agent");
            asm volatile("s_waitcnt vmcnt(0)" ::: "memory");
        }
    }
    __syncthreads();
}

#ifdef XCD_CONTIG
#define BX_EXPR ((int)blockIdx.x)
#else
#define BX_EXPR __builtin_amdgcn_readfirstlane((int)MISC[12])
#endif
#ifndef PROBE_MASK
#define PROBE_MASK 0u
#endif
#ifndef PROBE_REPS
#define PROBE_REPS 3
#endif
#ifndef MK_SINGLE
#define MK_SINGLE 1
#endif
__device__ __forceinline__ void touch_buffer(const unsigned char* p, size_t bytes, int G) {
    const size_t per = bytes / (size_t)G; const v4u* q = (const v4u*)(p + per * blockIdx.x) + otid();
    v4u acc = (v4u){0u, 0u, 0u, 0u};
    for (size_t i = 0; i < per / (512 * 16); i += 8) {
        v4u t[8];
#pragma unroll
        for (int k = 0; k < 8; ++k) t[k] = q[(i + k) * 512];
#pragma unroll
        for (int k = 0; k < 8; ++k) { acc.x |= t[k].x; acc.y |= t[k].y; acc.z |= t[k].z; acc.w |= t[k].w; }
    }
    asm volatile("" :: "v"(acc.x | acc.y | acc.z | acc.w));
}
typedef const __attribute__((address_space(4))) KArgs* KArgsP;
__device__ __forceinline__ KArgs kargs() {
#if defined(__HIP_DEVICE_COMPILE__)
    KArgsP p = (KArgsP)__builtin_amdgcn_kernarg_segment_ptr(); asm volatile("" : "+s"(p)); KArgs r; __builtin_memcpy(&r, (const __attribute__((address_space(4))) void*)p, sizeof(KArgs)); return r;
#else
    return KArgs{};
#endif
}
__global__ void __launch_bounds__(512, 2) mk_fwd(KArgs a_in) {
    extern __shared__ __attribute__((aligned(16))) unsigned char lds_raw[];
    LAS unsigned char* L = (LAS unsigned char*)lds_raw;
    cg::grid_group grid = cg::this_grid();
    const int ph_lo = a_in.ph_lo, ph_hi = a_in.ph_hi;
    volatile LAS unsigned* MISC = (volatile LAS unsigned*)(L + LDS_BYTES - 64);
    if (otid() < 16) MISC[otid()] = 0u;
    __syncthreads();
    XcdBarrier xbar = xcd_barrier_post((unsigned*)a_in.ws, MISC);
    if (otid() == 0) { MISC[10] = xb_add((unsigned*)a_in.ws + 3584 + 64 * (xbar.x & 7u), 1u); MISC[11] = xbar.x & 7u; MISC[12] = blockIdx.x; }
    __syncthreads();
#define IN(k) (ph_lo <= (k) && (k) < ph_hi)
#define SEAM(k) do { if (IN(k) && IN((k) + 1)) { if ((k) == 0) { grid.sync(); \
        if (otid() == 0) { bool ok = (gridDim.x == 256); for (int j_ = 0; j_ < 8; ++j_) ok = ok && (xb_ld((unsigned*)a_in.ws + 3584 + 64 * j_) == 32u); if (ok) MISC[12] = MISC[10] * 8u + MISC[11]; } __syncthreads(); } \
        else xcd_barrier(xbar); } } while (0)
#define PEND(k) do { if ((PROBE_MASK >> (k)) & 1u) { const unsigned long long t1_ = __builtin_amdgcn_s_memrealtime(); while (__builtin_amdgcn_s_memrealtime() < t1_ + (PROBE_REPS - 1) * (t1_ - t0_)) __builtin_amdgcn_s_sleep(8); } } while (0)
#define REP(k) for (int rep_ = 0, nrep_ = (((PROBE_MASK >> (k)) & 1u) ? PROBE_REPS : 1); rep_ < nrep_; ++rep_)
#define GBX const unsigned long long t0_ = PROBE_MASK ? __builtin_amdgcn_s_memrealtime() : 0ull; (void)t0_; const int G = gridDim.x, bx = BX_EXPR; const KArgs a = kargs(); unsigned char* ws = a.ws; (void)G; (void)bx; (void)ws
    if (IN(0)) { GBX; REP(0) phase0(a, L, G); }
    SEAM(0);
    if (IN(1)) { GBX; REP(1) {
        s5_expand(a, G);
        pg8::Gemm g{(const bf16*)(ws + OFF_H1), (const bf16*)(ws + OFF_WIN), 1024, 1024, 1024, nullptr, 0, 0}; pg8::StaticOrder S; S.init(T, 2560, G, bx);
        EpiInProj E{(bf16*)(ws + OFF_QK), (bf16*)(ws + OFF_V), (bf16*)(ws + OFF_O), (bf16*)(ws + OFF_UG)};
        pg8::gemm_phase<EpiInProj, pg8::StaticOrder, true, true, false, false, true, true>(L, g, S, E); }
    }
    SEAM(1);
    if (IN(2)) { GBX;
        REP(16) for (int item = bx; item < 2048; item += G) mlstm_state_item(a, L, item);
        pg8::Gemm g{(const bf16*)(ws + OFF_UG) + 128, (const bf16*)(ws + OFF_S5P), 1152, 1024, 1024, nullptr, 0, 0}; S5EOrder S{G, bx};
        EpiS5E E{(float*)(ws + OFF_S5E)};
        REP(17) pg8::gemm_phase<EpiS5E, S5EOrder, true, true>(L, g, S, E);
    }
    SEAM(2);
    if (IN(3)) { GBX; REP(3) phase3(a, L, G); }
    SEAM(3);
    if (IN(4)) { GBX;
        REP(18) { int h_loaded = -1; KvRaw Ra, Rb;
            if (bx < 2048) { const int it0 = bx, c0 = it0 & 63, bh0 = it0 >> 6; const bf16* q0 = (const bf16*)(ws + OFF_QK) + (size_t)((bh0 >> 2) * SEQ) * 1024 + (bh0 & 3) * 128; const int s_ = otid() >> 3, col_ = (otid() & 7) * 16;
                kq_load(Ra, q0, c0 * 128 + s_, col_); kq_load(Rb, q0, c0 * 128 + 64 + s_, col_); }
            for (int item = bx; item < 2048; item += G) mlstm_out_item(a, L, item, item + G < 2048 ? item + G : item, Ra, Rb, h_loaded); }
        pg8::Gemm g{(const bf16*)(ws + OFF_UG), (const bf16*)(ws + OFF_S5M), 1152, 1152, 1152, nullptr, 0, 0}; S5YOrder S{G, bx};
        EpiS5Y E{(const bf16*)(ws + OFF_UG), a.in[I_DSKIP], (bf16*)(ws + OFF_YSG)};
        REP(19) pg8::gemm_phase<EpiS5Y, S5YOrder, true, true>(L, g, S, E);
    }
    SEAM(4);
    if (IN(5)) { GBX; REP(5) {
        pg8::Gemm g{(const bf16*)(ws + OFF_YSG), (const bf16*)(ws + OFF_WGLU), 512, 512, 512, nullptr, 0, 0}; pg8::StaticOrder S; S.init(T, 512, G, bx);
        EpiGlu E{(const bf16*)(ws + OFF_YSG), a.in[I_BGLU], (bf16*)(ws + OFF_H1)};
        pg8::gemm_phase<EpiGlu, pg8::StaticOrder, true, true>(L, g, S, E); }
    }
    SEAM(5);
    if (IN(6)) { GBX; REP(6) {
        pg8::Gemm g{(const bf16*)(ws + OFF_H1), (const bf16*)(ws + OFF_WOUT), 1024, 1024, 1024, nullptr, 0, 0}; pg8::StaticOrder S; S.init(T, 1024, G, bx);
        EpiOut E{(bf16*)(ws + OFF_MO)};
        pg8::gemm_phase<EpiOut, pg8::StaticOrder, true, true>(L, g, S, E); }
    }
    SEAM(6);
    if (IN(7)) { GBX; REP(7) phase7(a, L, G); }
    SEAM(7);
    if (IN(8)) { GBX; REP(8) phase8(a, L, G); }
    SEAM(8);
#pragma unroll 1
    for (int hf = 0; hf < 2; ++hf) {
        const int pb = 9 + 2 * hf;
        if (IN(pb)) { GBX;
            const int ntile = ((const int*)(ws + OFF_NTILE))[hf];
            pg8::Gemm g{(const bf16*)(ws + OFF_H2), (const bf16*)(ws + OFF_WGU), 1024, 1024, 1024, (const int*)(ws + OFF_ROWMAP) + hf * RCAP, 0, 0}; MoeOrder S{(const int*)(ws + OFF_TILEE) + hf * 1024, ntile, 8, G, bx, (unsigned*)ws + 4096 + 512 * (2 * hf)};
            EpiMoeGU E{a.in[I_BGU], ws + OFF_R1, (const float*)(ws + OFF_RSTDS) + hf * RCAP};
#ifdef TOUCH_WGU
            touch_buffer(ws + OFF_WGU, (size_t)134217728, G);
#endif
            REP(pb) pg8::gemm_phase<EpiMoeGU, MoeOrder, true, true, true, true, false, true>(L, g, S, E);
        }
        if (IN(pb) && hf == 1) { GBX; combine_half(a, 0, ws + OFF_R2, G); PEND(pb); }
        SEAM(pb);
        if (IN(pb + 1)) { GBX;
            const int ntile = ((const int*)(ws + OFF_NTILE))[hf];
            pg8::Gemm g{(const bf16*)(ws + OFF_R1), (const bf16*)(ws + OFF_WDN), 1024, 1024, 1024, nullptr, 1, 1}; MoeOrder S{(const int*)(ws + OFF_TILEE) + hf * 1024, ntile, 4, G, bx, (unsigned*)ws + 4096 + 512 * (2 * hf + 1)};
            EpiMoeDN E{a.in[I_BDN], (const float*)(ws + OFF_RGATE) + hf * RCAP, ws + OFF_R2};
            REP(pb + 1) pg8::gemm_phase<EpiMoeDN, MoeOrder, true, true, false, true, true, true>(L, g, S, E);
        }
        SEAM(pb + 1);
    }
    if (IN(13)) { GBX; combine_half(a, 1, ws + OFF_R2, G); PEND(13); }
    if (PROBE_SECT && blockIdx.x == 0 && otid() == 0) { const unsigned long long t1_ = __builtin_amdgcn_s_memrealtime(), w_ = (unsigned long long)(*PROBE_LDS_WORD) * PROBE_SCALE; while (__builtin_amdgcn_s_memrealtime() - t1_ < w_) __builtin_amdgcn_s_sleep(8); }
#undef IN
#undef SEAM
#undef GBX
#undef PEND
#undef REP
}

extern "C" void kernel_launch(void* const* d_in, const int* in_sizes, int n_in, void* d_out, int out_size, void* d_ws, size_t ws_size, hipStream_t stream) {
    static int grid = 0;
    if (grid == 0) {
        if (n_in != 26 || out_size != T * DM || ws_size < WS_NEED) { fprintf(stderr, "kernel_launch: unexpected problem (n_in %d, out %d, ws %zu)\n", n_in, out_size, ws_size); grid = -1; return; }
        int dev = 0, cus = 0, per_cu = 0;
        (void)hipGetDevice(&dev); (void)hipDeviceGetAttribute(&cus, hipDeviceAttributeMultiprocessorCount, dev);
        if (hipFuncSetAttribute((const void*)mk_fwd, hipFuncAttributeMaxDynamicSharedMemorySize, LDS_BYTES) != hipSuccess) { fprintf(stderr, "kernel_launch: hipFuncSetAttribute failed\n"); grid = -1; return; }
        if (hipOccupancyMaxActiveBlocksPerMultiprocessor(&per_cu, (const void*)mk_fwd, 512, LDS_BYTES) != hipSuccess || per_cu < 1) { fprintf(stderr, "kernel_launch: occupancy query says %d\n", per_cu); per_cu = 1; }
        (void)hipGetLastError();
        grid = cus;
    }
    if (grid < 0) return;
    if (hipMemsetAsync(d_ws, 0, 32768, stream) != hipSuccess) { fprintf(stderr, "kernel_launch: memset failed\n"); return; }
    KArgs a{};
    for (int i = 0; i < 26; ++i) a.in[i] = (const float*)d_in[i];
    a.out = (float*)d_out; a.ws = (unsigned char*)d_ws;
#if MK_SINGLE
    a.ph_lo = 0; a.ph_hi = NPH;
    void* args[] = {&a};
    hipError_t e = hipLaunchCooperativeKernel((const void*)mk_fwd, dim3(grid), dim3(512), args, LDS_BYTES, stream);
    if (e != hipSuccess) fprintf(stderr, "cooperative launch failed: %s (grid %d)\n", hipGetErrorString(e), grid);
#else
    for (int p = 0; p < NPH; ++p) { a.ph_lo = p; a.ph_hi = p + 1; hipLaunchKernelGGL(mk_fwd, dim3(grid), dim3(512), LDS_BYTES, stream, a); }
#endif
}
```

```cpp
#include <hip/hip_runtime.h>
#include <hip/hip_cooperative_groups.h>
#include <cstdio>
#include <cstdint>
namespace cg = cooperative_groups;
__device__ __forceinline__ int otid() { int t = (int)threadIdx.x; asm volatile("" : "+v"(t)); return t; }

#ifndef PROBE_SECT
#define PROBE_SECT 0
#endif
#ifndef PROBE_SCALE
#define PROBE_SCALE 16
#endif
#define PROBE_LDS_WORD ((volatile __attribute__((address_space(3))) unsigned*)(155648 - 32))
#define TIC(id) unsigned long long tic_##id = 0; if (PROBE_SECT == (id)) { __builtin_amdgcn_sched_barrier(0); tic_##id = __builtin_amdgcn_s_memrealtime(); __builtin_amdgcn_sched_barrier(0); }
#define TOC(id) if (PROBE_SECT == (id)) { __builtin_amdgcn_sched_barrier(0); asm volatile("s_waitcnt vmcnt(0) lgkmcnt(0)" ::: "memory"); const unsigned d_ = (unsigned)(__builtin_amdgcn_s_memrealtime() - tic_##id); if (blockIdx.x == 0 && threadIdx.x == 0) *PROBE_LDS_WORD += d_; __builtin_amdgcn_sched_barrier(0); }
namespace pg8 {
#define PG8_LAS __attribute__((address_space(3)))
typedef unsigned short bf16_t;
typedef short bf16x8 __attribute__((ext_vector_type(8)));
typedef float f32x4 __attribute__((ext_vector_type(4)));
typedef unsigned u32x4 __attribute__((ext_vector_type(4)));
typedef long lx2 __attribute__((ext_vector_type(2)));
constexpr int BM = 256, BK = 64, HALF = 128, HTB = HALF * BK * 2  , STAGE_BYTES = 8 * HTB, NXCD = 8, WGM = 8;

__host__ __device__ __forceinline__ int lds_byte(int r, int c) { const int st = (r >> 4) * 2 + (c >> 5), rr = r & 15, cc = c & 31, ob = rr * 64 + cc * 2; return st * 1024 + (ob ^ (((ob >> 9) & 1) << 5)); }
__host__ __device__ __forceinline__ void stage_rc(int b, int& R, int& C) { const int st = b / 1024, sb = b % 1024, swz = sb ^ (((sb >> 9) & 1) << 5); R = (st >> 1) * 16 + swz / 64; C = (st & 1) * 32 + (swz % 64) / 2; }
__host__ __device__ __forceinline__ int perm32(int rho) { const int n = rho >> 4, i = rho & 15; return 8 * (i >> 2) + 4 * n + (i & 3); }

struct Unit { int pm, pn, rd, nt; };
struct Gemm { const bf16_t* A; const bf16_t* Bt; int lda, ldb, K; const int* rowmap; int blkA, blkB; };

struct StaticOrder {
    int nM, nN, nwg, G, c;
    __host__ __device__ void init(int M, int N, int G_, int c_) { nM = M / BM; nN = N / BM; nwg = nM * nN; G = G_; c = c_; }
    __host__ __device__ bool next(int i, Unit& u) const {
        const long L = (long)i * G + c; if (L >= nwg) return false;
        int wgid = (int)L; { const int q = nwg / NXCD, r = nwg % NXCD, xcd = wgid % NXCD, off = wgid / NXCD; wgid = (xcd < r ? xcd * (q + 1) : r * (q + 1) + (xcd - r) * q) + off; }
        const int nig = WGM * nN, gid = wgid / nig, fm = gid * WGM, gsz = (nM - fm) < WGM ? (nM - fm) : WGM;
        u.pm = fm + ((wgid % nig) % gsz); u.pn = (wgid % nig) / gsz; u.rd = 0; u.nt = 0; return true;
    }
    __device__ __forceinline__ void a_ready(const Unit&) const {}
    __device__ __forceinline__ void done(const Unit&) const {}
};

__device__ __forceinline__ unsigned cvt_pk_bf16(float lo, float hi) { unsigned r; asm volatile("v_cvt_pk_bf16_f32 %0, %1, %2" : "=v"(r) : "v"(lo), "v"(hi)); return r; }

template <class Epi, class Sched, bool ALIGN_EPI = false, bool SP2 = false, bool GATHER = false, bool FP8 = false, bool BLKA = false, bool BLKB = false>
__device__ __forceinline__ void gemm_phase(PG8_LAS unsigned char* lds, const Gemm g, const Sched& S, const Epi& E) {
    const int tid = otid(), wid = __builtin_amdgcn_readfirstlane(tid >> 6), lane = tid & 63, wr = wid >> 2, wc = wid & 3, fr = lane & 15, fq = lane >> 4;
    const int K = g.K, nt = FP8 ? K / 128 : K / BK;
    const unsigned ldaB = BLKA ? 128u : (FP8 ? (unsigned)g.lda : 2u * (unsigned)g.lda), ldbB = BLKB ? 128u : (FP8 ? (unsigned)g.ldb : 2u * (unsigned)g.ldb);
    unsigned voffA[2], voffB[2];
#pragma unroll
    for (int i = 0; i < 2; ++i) { int R, C; stage_rc(tid * 16 + i * 8192, R, C); const int Rb = Epi::PERM ? ((R & ~31) + perm32(R & 31)) : R;
        voffA[i] = (unsigned)R * ldaB + 2u * (unsigned)C; voffB[i] = (unsigned)Rb * ldbB + 2u * (unsigned)C; }
    int gR0, gC0; stage_rc(tid * 16, gR0, gC0);
    const unsigned gRowBytes = ldaB, gColBytes = (unsigned)gC0 * 2u;
    unsigned offC[2][2], offN[2][2];
#define PG8_GOFF(dst, pm) do { if constexpr (GATHER) { _Pragma("unroll") for (int _h = 0; _h < 2; ++_h) _Pragma("unroll") for (int _i = 0; _i < 2; ++_i) \
        dst[_h][_i] = (unsigned)g.rowmap[(pm) * BM + _h * HALF + _i * 64 + gR0] * gRowBytes + gColBytes; } } while (0)
    constexpr size_t kstepA = BLKA ? (size_t)32768 : (size_t)128, kstepB = BLKB ? (size_t)32768 : (size_t)128;
    const size_t hstepA = (size_t)HALF * ldaB, hstepB = (size_t)HALF * ldbB;
    const size_t tstepA = BLKA ? (size_t)nt * 32768 : 2 * hstepA, tstepB = BLKB ? (size_t)nt * 32768 : 2 * hstepB;
    const unsigned ldsw = (unsigned)wid * 1024u;
    const int aoff = lds_byte(wr * 64 + fr, fq * 8), boff = lds_byte(wc * 32 + fr, fq * 8);
#define PG8_SA(b, h) (((b) * 2 + (h)) * HTB)
#define PG8_SB(b, h) ((4 + (b) * 2 + (h)) * HTB)
#ifndef PG8_AUX
#define PG8_AUX 0
#endif
#define PG8_STAGE(bufoff, gbase, voff) do { _Pragma("unroll") for (int _i = 0; _i < 2; ++_i) \
        __builtin_amdgcn_global_load_lds((const unsigned*)((const char*)(gbase) + (voff)[_i]), (PG8_LAS unsigned*)(lds + (bufoff) + ldsw + _i * 8192), 16, 0, FP8 ? PG8_AUX : 0); } while (0)
#define PG8_LDA(dst, b, h) do { _Pragma("unroll") for (int m = 0; m < 4; ++m) _Pragma("unroll") for (int k = 0; k < 2; ++k) dst[m][k] = *(const PG8_LAS bf16x8*)(lds + PG8_SA(b, h) + aoff + m * 2048 + k * 1024); } while (0)
#define PG8_LDB(dst, b, h) do { _Pragma("unroll") for (int n = 0; n < 2; ++n) _Pragma("unroll") for (int k = 0; k < 2; ++k) dst[n][k] = *(const PG8_LAS bf16x8*)(lds + PG8_SB(b, h) + boff + n * 2048 + k * 1024); } while (0)
#define PG8_MMA(ai, bj, At, Bt) do { __builtin_amdgcn_s_setprio(1); _Pragma("unroll") for (int m = 0; m < 4; ++m) _Pragma("unroll") for (int n = 0; n < 2; ++n) _Pragma("unroll") for (int k = 0; k < 2; ++k) { \
        if constexpr (FP8) { const lx2 a_ = __builtin_bit_cast(lx2, At[m][k]), b_ = __builtin_bit_cast(lx2, Bt[n][k]);        \
            acc[ai][bj][m][n] = __builtin_amdgcn_mfma_f32_16x16x32_fp8_fp8(b_.x, a_.x, acc[ai][bj][m][n], 0, 0, 0); acc[ai][bj][m][n] = __builtin_amdgcn_mfma_f32_16x16x32_fp8_fp8(b_.y, a_.y, acc[ai][bj][m][n], 0, 0, 0); } \
        else acc[ai][bj][m][n] = __builtin_amdgcn_mfma_f32_16x16x32_bf16(Bt[n][k], At[m][k], acc[ai][bj][m][n], 0, 0, 0); } __builtin_amdgcn_s_setprio(0); } while (0)
#define PG8_WAIT_V(n) asm volatile("s_waitcnt vmcnt(" #n ")" ::: "memory")
#define PG8_WAIT_L(n) asm volatile("s_waitcnt lgkmcnt(" #n ")" ::: "memory")
#define PG8_BAR __builtin_amdgcn_s_barrier()
#define PG8_SCHED __builtin_amdgcn_sched_barrier(0)
    Unit cur, nxt; int ui = 0;
    if (!S.next(0, cur)) return;
    f32x4 acc[2][2][4][2];
#pragma unroll
    for (int a = 0; a < 2; ++a)
#pragma unroll
        for (int b = 0; b < 2; ++b)
#pragma unroll
            for (int m = 0; m < 4; ++m)
#pragma unroll
                for (int n = 0; n < 2; ++n) acc[a][b][m][n] = (f32x4){0.f, 0.f, 0.f, 0.f};
    bf16x8 At[4][2], B0[2][2], B1[2][2];
    const char* cA = (const char*)g.A + (size_t)cur.pm * tstepA; const char* cB = (const char*)g.Bt + (size_t)cur.pn * tstepB;
    S.a_ready(cur);
    const char* gA = (const char*)g.A;
    PG8_GOFF(offC, cur.pm);
#define PG8_STAGE_A(bufoff, h, ptr_plain, kt, offs) do { if constexpr (GATHER) PG8_STAGE(bufoff, gA + (size_t)(kt) * kstepA, (offs)[h]); else PG8_STAGE(bufoff, ptr_plain, voffA); } while (0)
    if constexpr (SP2) {
        PG8_STAGE(PG8_SB(0, 0), cB, voffB); PG8_STAGE(PG8_SB(0, 1), cB + hstepB, voffB); PG8_STAGE_A(PG8_SA(0, 0), 0, cA, 0, offC); PG8_STAGE_A(PG8_SA(0, 1), 1, cA + hstepA, 0, offC);
        if (wr == 1) PG8_BAR;
        PG8_WAIT_V(2); PG8_BAR;
        PG8_STAGE(PG8_SB(1, 0), cB + kstepB, voffB); PG8_STAGE_A(PG8_SA(1, 0), 0, cA + kstepA, 1, offC); PG8_STAGE(PG8_SB(1, 1), cB + hstepB + kstepB, voffB);
        PG8_WAIT_V(6); PG8_BAR;
    } else {
        PG8_STAGE(PG8_SB(0, 0), cB, voffB); PG8_STAGE(PG8_SA(0, 0), cA, voffA); PG8_STAGE(PG8_SB(0, 1), cB + hstepB, voffB); PG8_STAGE(PG8_SA(0, 1), cA + hstepA, voffA);
        if (wr == 1) PG8_BAR;
        PG8_WAIT_V(4); PG8_BAR;
        PG8_STAGE(PG8_SB(1, 0), cB + kstepB, voffB); PG8_STAGE(PG8_SA(1, 0), cA + kstepA, voffA); PG8_STAGE(PG8_SB(1, 1), cB + hstepB + kstepB, voffB);
        PG8_WAIT_V(6); PG8_BAR;
    }
    for (;;) {
        const bool has_next = S.next(ui + 1, nxt);
        if constexpr (GATHER) { if (has_next) PG8_GOFF(offN, nxt.pm); else { _Pragma("unroll") for (int _h = 0; _h < 2; ++_h) _Pragma("unroll") for (int _i = 0; _i < 2; ++_i) offN[_h][_i] = offC[_h][_i]; } }
        const char* nA = has_next ? (const char*)g.A + (size_t)nxt.pm * tstepA : cA; const char* nB = has_next ? (const char*)g.Bt + (size_t)nxt.pn * tstepB : cB;
#ifndef PROBE_KREP_G
#define PROBE_KREP_G 1
#endif
#ifndef PROBE_KREP_N
#define PROBE_KREP_N 1
#endif
#ifndef PROBE_KREP_D
#define PROBE_KREP_D 1
#endif
        constexpr int KREP = GATHER ? PROBE_KREP_G : (FP8 ? PROBE_KREP_D : PROBE_KREP_N);
        TIC(21)
        for (int pass = 0; pass < KREP; ++pass) {
        const bool fpass = (pass == KREP - 1);
        if (KREP > 1 && pass > 0) {
#pragma unroll
            for (int a = 0; a < 2; ++a)
#pragma unroll
                for (int b = 0; b < 2; ++b)
#pragma unroll
                    for (int m = 0; m < 4; ++m)
#pragma unroll
                        for (int n = 0; n < 2; ++n) acc[a][b][m][n] = (f32x4){0.f, 0.f, 0.f, 0.f}; }
        const int ntc = cur.nt > 0 ? cur.nt : nt;
        for (int t = 0; t < ntc; t += 2) {
            const bool lastk = (t == ntc - 2), last = lastk && fpass;
            const char* a1 = cA + (size_t)(t + 1) * kstepA;
            const char* a2 = lastk ? (fpass ? nA : cA) : cA + (size_t)(t + 2) * kstepA; const char* b2 = lastk ? (fpass ? nB : cB) : cB + (size_t)(t + 2) * kstepB;
            const char* a3 = a2 + kstepA; const char* b3 = b2 + kstepB;
            if (last && has_next) S.a_ready(nxt);
            if constexpr (SP2) {
            const int k2 = lastk ? 0 : t + 2;
            unsigned offS[2][2];
            if constexpr (GATHER) { _Pragma("unroll") for (int _h = 0; _h < 2; ++_h) _Pragma("unroll") for (int _i = 0; _i < 2; ++_i) offS[_h][_i] = last ? offN[_h][_i] : offC[_h][_i]; }
            PG8_LDB(B0, 0, 0); PG8_LDB(B1, 0, 1); PG8_SCHED; PG8_LDA(At, 0, 0); PG8_STAGE_A(PG8_SA(1, 1), 1, a1 + hstepA, t + 1, offC);
            PG8_WAIT_V(8); PG8_WAIT_L(0); PG8_BAR; PG8_MMA(0, 0, At, B0); PG8_MMA(0, 1, At, B1); PG8_BAR; PG8_SCHED;
            PG8_LDA(At, 0, 1); PG8_STAGE(PG8_SB(0, 0), b2, voffB); PG8_STAGE(PG8_SB(0, 1), b2 + hstepB, voffB); PG8_STAGE_A(PG8_SA(0, 0), 0, a2, k2, offS);
            PG8_WAIT_V(8); PG8_WAIT_L(0); PG8_BAR; PG8_MMA(1, 0, At, B0); PG8_MMA(1, 1, At, B1); PG8_BAR; PG8_SCHED;
            PG8_LDB(B0, 1, 0); PG8_LDB(B1, 1, 1); PG8_SCHED; PG8_LDA(At, 1, 0); PG8_STAGE_A(PG8_SA(0, 1), 1, a2 + hstepA, k2, offS);
            PG8_WAIT_V(8); PG8_WAIT_L(0); PG8_BAR; PG8_MMA(0, 0, At, B0); PG8_MMA(0, 1, At, B1); PG8_BAR; PG8_SCHED;
            PG8_LDA(At, 1, 1); PG8_STAGE(PG8_SB(1, 0), b3, voffB); PG8_STAGE(PG8_SB(1, 1), b3 + hstepB, voffB); PG8_STAGE_A(PG8_SA(1, 0), 0, a3, k2 + 1, offS);
            PG8_WAIT_V(8); PG8_WAIT_L(0); PG8_BAR; PG8_MMA(1, 0, At, B0); PG8_MMA(1, 1, At, B1); PG8_BAR; PG8_SCHED;
            } else {
            PG8_LDB(B0, 0, 0); PG8_SCHED; PG8_LDA(At, 0, 0); PG8_STAGE(PG8_SA(1, 1), a1 + hstepA, voffA);
            PG8_WAIT_L(8); PG8_BAR; PG8_WAIT_L(0); PG8_MMA(0, 0, At, B0); PG8_BAR; PG8_SCHED;
            PG8_LDB(B1, 0, 1); PG8_STAGE(PG8_SB(0, 0), b2, voffB);
            PG8_BAR; PG8_WAIT_L(0); PG8_MMA(0, 1, At, B1); PG8_BAR;
            PG8_LDA(At, 0, 1); PG8_STAGE(PG8_SA(0, 0), a2, voffA);
            PG8_BAR; PG8_WAIT_L(0); PG8_MMA(1, 0, At, B0); PG8_BAR; PG8_SCHED;
            PG8_STAGE(PG8_SB(0, 1), b2 + hstepB, voffB);
            PG8_WAIT_V(6); PG8_BAR; PG8_MMA(1, 1, At, B1); PG8_BAR;
            PG8_LDB(B0, 1, 0); PG8_SCHED; PG8_LDA(At, 1, 0); PG8_STAGE(PG8_SA(0, 1), a2 + hstepA, voffA);
            PG8_WAIT_L(8); PG8_BAR; PG8_WAIT_L(0); PG8_MMA(0, 0, At, B0); PG8_BAR; PG8_SCHED;
            PG8_LDB(B1, 1, 1); PG8_STAGE(PG8_SB(1, 0), b3, voffB);
            PG8_BAR; PG8_WAIT_L(0); PG8_MMA(0, 1, At, B1); PG8_BAR;
            PG8_LDA(At, 1, 1); PG8_STAGE(PG8_SA(1, 0), a3, voffA);
            PG8_BAR; PG8_WAIT_L(0); PG8_MMA(1, 0, At, B0); PG8_BAR; PG8_SCHED;
            PG8_STAGE(PG8_SB(1, 1), b3 + hstepB, voffB);
            PG8_WAIT_V(6); PG8_BAR; PG8_MMA(1, 1, At, B1); PG8_BAR;
            }
        }
        }
        if (FP8) { TOC(21) }
        if constexpr (ALIGN_EPI) { if (wr == 0) PG8_BAR; }
        TIC(22)
        E(acc, cur, wr, wc, fr, fq); S.done(cur);
        if (FP8) { TOC(22) }
        if (!has_next) break;
#pragma unroll
        for (int a = 0; a < 2; ++a)
#pragma unroll
            for (int b = 0; b < 2; ++b)
#pragma unroll
                for (int m = 0; m < 4; ++m)
#pragma unroll
                    for (int n = 0; n < 2; ++n) acc[a][b][m][n] = (f32x4){0.f, 0.f, 0.f, 0.f};
        cur = nxt; cA = nA; cB = nB; ++ui;
        if constexpr (GATHER) { _Pragma("unroll") for (int _h = 0; _h < 2; ++_h) _Pragma("unroll") for (int _i = 0; _i < 2; ++_i) offC[_h][_i] = offN[_h][_i]; }
        if constexpr (ALIGN_EPI) { if (wr == 1) PG8_BAR; }
    }
    PG8_WAIT_V(0);
    if constexpr (!ALIGN_EPI) { if (wr == 0) PG8_BAR; }
    PG8_BAR;
#undef PG8_SA
#undef PG8_SB
#undef PG8_STAGE
#undef PG8_STAGE_A
#undef PG8_GOFF
#undef PG8_LDA
#undef PG8_LDB
#undef PG8_MMA
#undef PG8_WAIT_V
#undef PG8_WAIT_L
#undef PG8_BAR
#undef PG8_SCHED
}
}

#define LAS __attribute__((address_space(3)))
typedef unsigned short bf16;
typedef float f4 __attribute__((ext_vector_type(4)));
typedef float f2 __attribute__((ext_vector_type(2)));
typedef float f32x16 __attribute__((ext_vector_type(16)));
typedef short bf16x8 __attribute__((ext_vector_type(8)));
typedef unsigned v4u __attribute__((ext_vector_type(4)));
typedef unsigned v2u __attribute__((ext_vector_type(2)));

constexpr int T = 65536, DM = 1024, SEQ = 8192, NPROJ = 2568;
constexpr int NE = 32;
constexpr float EPS = 1e-6f;
constexpr int NPH = 14;
constexpr int RCAP = 229376;
constexpr int LDS_BYTES = 155648;

constexpr size_t MiB = (size_t)1 << 20;
constexpr size_t OFF_GATES = 1 * MiB, OFF_MLG = 3 * MiB, OFF_MLA = 3 * MiB + 16384, OFF_MLM = 3 * MiB + 32768;
constexpr size_t OFF_MLNP = 4 * MiB, OFF_MLN = 6 * MiB, OFF_KT = 8 * MiB, OFF_S5E = 10 * MiB, OFF_RSTD2 = 26 * MiB;
constexpr size_t OFF_ENTE = 27 * MiB, OFF_ENTG = 28 * MiB, OFF_ENTR = 29 * MiB, OFF_SDEST = 30 * MiB;
constexpr size_t OFF_CNT = 31 * MiB, OFF_TILEE = 31 * MiB + 65536, OFF_NTILE = 31 * MiB + 131072, OFF_RGATE = 32 * MiB;
constexpr size_t OFF_WIN = 64 * MiB, OFF_WGLU = 70 * MiB, OFF_WOUT = 71 * MiB, OFF_WGU = 74 * MiB, OFF_WDN = 202 * MiB;
constexpr size_t OFF_S5M = 266 * MiB, OFF_S5P = 338 * MiB, OFF_H1 = 354 * MiB, OFF_QK = 482 * MiB, OFF_V = 610 * MiB, OFF_O = 674 * MiB, OFF_UG = 738 * MiB, OFF_YSG = 810 * MiB;
constexpr size_t OFF_H2 = 266 * MiB, OFF_R1 = 394 * MiB, OFF_R2 = 620 * MiB, WS_NEED = 1002 * MiB;
constexpr size_t OFF_MO = 874 * MiB;
constexpr size_t OFF_ROWMAP = 34 * MiB, OFF_RSTDS = 36 * MiB;
constexpr size_t OFF_QC = 874 * MiB, OFF_VT = 938 * MiB, OFF_KCTW = 810 * MiB;
constexpr size_t OUT_UP = 0, OUT_CST = 134217728;

struct KArgs { const float* in[26]; float* out; unsigned char* ws; int ph_lo, ph_hi; };
enum { I_X = 0, I_N1G, I_WIN, I_BIF, I_CONVW, I_CONVB, I_HNG, I_LRE, I_LIM, I_LDT, I_BRE, I_BIM, I_CRE, I_CIM, I_DSKIP, I_WGLU, I_BGLU, I_WOUT, I_N2G, I_WR, I_BR, I_WGU, I_BGU, I_WDN, I_BDN, I_NFG };

typedef float f32x2_t_ __attribute__((ext_vector_type(2))); typedef __bf16 bf16x2_t_ __attribute__((ext_vector_type(2)));
__device__ __forceinline__ unsigned f2bf(float f) { const f32x2_t_ v = {f, 0.f}; const bf16x2_t_ b = __builtin_convertvector(v, bf16x2_t_); return __builtin_bit_cast(unsigned, b) & 0xffffu; }
typedef float f32x2_t __attribute__((ext_vector_type(2))); typedef __bf16 bf16x2_t __attribute__((ext_vector_type(2)));
__device__ __forceinline__ unsigned pk2(float lo, float hi) { const f32x2_t v = {lo, hi}; const bf16x2_t b = __builtin_convertvector(v, bf16x2_t); return __builtin_bit_cast(unsigned, b); }
__device__ __forceinline__ unsigned pk4_fp8(float a, float b, float c, float d) { int r = 0; r = __builtin_amdgcn_cvt_pk_fp8_f32(a, b, r, false); r = __builtin_amdgcn_cvt_pk_fp8_f32(c, d, r, true); return (unsigned)r; }
constexpr float FP8_WSCALE = 64.f, FP8_ASCALE = 4.f, FP8_YSCALE = 16.f;
__device__ __forceinline__ float bf2f(unsigned b) { return __builtin_bit_cast(float, b << 16); }
__device__ __forceinline__ float bflo(unsigned w) { return __builtin_bit_cast(float, w << 16); }
__device__ __forceinline__ float bfhi(unsigned w) { return __builtin_bit_cast(float, w & 0xffff0000u); }
__device__ __forceinline__ float wave_sum(float v) {
#pragma unroll
    for (int o = 1; o < 64; o <<= 1) v += __shfl_xor(v, o);
    return v;
}
__device__ __forceinline__ float wave_max(float v) {
#pragma unroll
    for (int o = 1; o < 64; o <<= 1) v = fmaxf(v, __shfl_xor(v, o));
    return v;
}
__device__ __forceinline__ float sigmoidf_(float x) { return __builtin_amdgcn_rcpf(1.f + __expf(-x)); }
__device__ __forceinline__ float siluf_(float x) { return x * __builtin_amdgcn_rcpf(1.f + __expf(-x)); }
__device__ __forceinline__ float logsigmoidf_(float x) { return x >= 0.f ? -log1pf(expf(-x)) : x - log1pf(expf(x)); }
__device__ __forceinline__ float gelu_tanh(float x) { const float z = 0.7978845608028654f * (x + 0.044715f * x * x * x); const float e = __expf(2.f * z); return 0.5f * x * (2.f - 2.f * __builtin_amdgcn_rcpf(e + 1.f)); }
#define LDS_WAIT() asm volatile("s_waitcnt lgkmcnt(0)" ::: "memory")

struct TrLoc { const float* src; bf16* dst; int ldw, ldt; int fp8; int blk_n; };
__device__ __forceinline__ void tr_load(const TrLoc& t, int lane, float (&v)[32]) {
    unsigned off = (unsigned)((lane >> 5) * t.ldw + (lane & 31)) * 4u; const unsigned st = 8u * (unsigned)t.ldw;
#pragma unroll
    for (int i = 0; i < 32; ++i) { v[i] = *(const float*)((const char*)t.src + off); off += st; }
}
__device__ __forceinline__ void tr_finish(const TrLoc& t, LAS float* scr, int lane, const float (&v)[32]) {
#pragma unroll
    for (int i = 0; i < 32; ++i) scr[(2 * i + (lane >> 5)) * 33 + (lane & 31)] = v[i];
    LDS_WAIT(); asm volatile("" ::: "memory");
    const int c = lane & 7;
    if (t.fp8) {
#pragma unroll
        for (int j = 0; j < 4; ++j) { const int n = (lane >> 3) + 8 * j; const LAS float* s = scr + (8 * c) * 33 + n;
            v2u o; o.x = pk4_fp8(s[0 * 33] * FP8_WSCALE, s[1 * 33] * FP8_WSCALE, s[2 * 33] * FP8_WSCALE, s[3 * 33] * FP8_WSCALE); o.y = pk4_fp8(s[4 * 33] * FP8_WSCALE, s[5 * 33] * FP8_WSCALE, s[6 * 33] * FP8_WSCALE, s[7 * 33] * FP8_WSCALE);
            *(v2u*)((unsigned char*)t.dst + (size_t)n * t.ldt + 8 * c) = o; }
    } else {
#pragma unroll
        for (int j = 0; j < 4; ++j) { const int n = (lane >> 3) + 8 * j; const LAS float* s = scr + (8 * c) * 33 + n;
            v4u o; o.x = pk2(s[0 * 33], s[1 * 33]); o.y = pk2(s[2 * 33], s[3 * 33]); o.z = pk2(s[4 * 33], s[5 * 33]); o.w = pk2(s[6 * 33], s[7 * 33]);
            *(v4u*)(t.dst + (size_t)n * t.ldt + 8 * c) = o; }
    }
    LDS_WAIT(); asm volatile("" ::: "memory");
}

__device__ __forceinline__ void lam_pow(float lre, float lim, float dt, int n, float& re, float& im) {
    const float mag = expf(lre * dt * (float)n);
    double th = (double)lim * (double)dt * (double)n;
    th -= 6.283185307179586476925 * rint(th * 0.15915494309189533577);
    const float s = __sinf((float)th), c = __cosf((float)th);
    re = mag * c; im = mag * s;
}

__device__ __forceinline__ void phase0(const KArgs& a, LAS unsigned char* L, int G) {
    const int tid = otid(), lane = tid & 63, wave = __builtin_amdgcn_readfirstlane(tid >> 6);
    const int gw = blockIdx.x * 8 + wave, NGW = G * 8;
    unsigned char* ws = a.ws;
    TIC(11)
    {
        LAS float* scr = (LAS float*)(L + wave * 8448);
        constexpr int N_IN = 16 * 80, N_GLU = 8 * 16, N_OUT = 16 * 32, N_GU = 32 * 16 * 64, N_DN = 32 * 16 * 32;
        constexpr int NITEMS = N_IN + N_GLU + N_OUT + N_GU + N_DN;
        auto locate = [&](int it) -> TrLoc {
            int r = it;
            if (r < N_IN) { const int kb = r / 80, nb = r % 80, n0 = 32 * nb, sc = n0 < 2048 ? n0 : n0 + 8;
                return TrLoc{a.in[I_WIN] + (size_t)(64 * kb) * NPROJ + sc, (bf16*)(ws + OFF_WIN) + (((size_t)(n0 >> 8) * 16 + kb) * 256 + (n0 & 255)) * 64, NPROJ, 64, 0, n0 & 255}; } r -= N_IN;
            if (r < N_GLU) { const int kb = r / 16, nb = r % 16, n0 = 32 * nb;
                return TrLoc{a.in[I_WGLU] + (size_t)(64 * kb) * 512 + n0, (bf16*)(ws + OFF_WGLU) + (size_t)n0 * 512 + 64 * kb, 512, 512, 0, -1}; } r -= N_GLU;
            if (r < N_OUT) { const int kb = r / 32, nb = r % 32, n0 = 32 * nb;
                return TrLoc{a.in[I_WOUT] + (size_t)(64 * kb) * 1024 + n0, (bf16*)(ws + OFF_WOUT) + (size_t)n0 * 1024 + 64 * kb, 1024, 1024, 0, -1}; } r -= N_OUT;
            if (r < N_GU) { const int e = r / 1024, q = r % 1024, kb = q / 64, nb = q % 64, n0 = 32 * nb, pn = n0 >> 8, wi = n0 & 255;
                const int sc = wi < 128 ? 128 * pn + wi : 1024 + 128 * pn + (wi - 128);
                return TrLoc{a.in[I_WGU] + (size_t)e * 1024 * 2048 + (size_t)(64 * kb) * 2048 + sc, (bf16*)(ws + OFF_WGU + ((((size_t)e * 8 + (n0 >> 8)) * 8 + (kb >> 1)) * 256 + (n0 & 255)) * 128 + (kb & 1) * 64), 2048, 128, 1, n0 & 255}; } r -= N_GU;
            { const int e = r / 512, q = r % 512, kb = q / 32, nb = q % 32, n0 = 32 * nb;
                return TrLoc{a.in[I_WDN] + (size_t)e * 1024 * 1024 + (size_t)(64 * kb) * 1024 + n0, (bf16*)(ws + OFF_WDN + ((((size_t)e * 4 + (n0 >> 8)) * 8 + (kb >> 1)) * 256 + (n0 & 255)) * 128 + (kb & 1) * 64), 1024, 128, 1, n0 & 255}; }
        };
        if (gw < NITEMS) {
            TrLoc cur = locate(gw); float vc[32]; tr_load(cur, lane, vc);
            for (int it = gw; it < NITEMS; it += NGW) {
                const int itn = (it + NGW < NITEMS) ? it + NGW : it;
                const TrLoc nxt = locate(itn); float vn[32]; tr_load(nxt, lane, vn);
                tr_finish(cur, scr, lane, vc);
                cur = nxt;
#pragma unroll
                for (int i = 0; i < 32; ++i) vc[i] = vn[i];
            }
        }
    }
    TOC(11)
    __syncthreads();
    TIC(12)
    {
        const float* lre = a.in[I_LRE]; const float* lim = a.in[I_LIM]; const float* ldt = a.in[I_LDT];
        const float* bre = a.in[I_BRE]; const float* bim = a.in[I_BIM]; const float* cre = a.in[I_CRE]; const float* cim = a.in[I_CIM];
        const int gt = blockIdx.x * 512 + tid, GT = G * 512;
        float* KT = (float*)(ws + OFF_KT);
        for (int task4 = gt; task4 < 32 * 64 * 16 * 4; task4 += GT) {
            const int task = task4 >> 2, pq = task4 & 3;
            const int g = task >> 10, tau = (task >> 4) & 63, i = task & 15;
            const float dt = expf(ldt[g]);
            float acc[16];
#pragma unroll
            for (int j = 0; j < 16; ++j) acc[j] = 0.f;
#pragma unroll 2
            for (int p = pq * 16; p < pq * 16 + 16; ++p) {
                const float lr = lre[g * 64 + p], li = lim[g * 64 + p];
                float pr, pi; lam_pow(lr, li, dt, tau, pr, pi);
                float l1r, l1i; lam_pow(lr, li, dt, 1, l1r, l1i);
                const float nr = l1r - 1.f, ni = l1i, den = lr * lr + li * li;
                const float fr = (nr * lr + ni * li) / den, fi = (ni * lr - nr * li) / den;
                const float cr = cre[(g * 16 + i) * 64 + p], ci = cim[(g * 16 + i) * 64 + p];
                const float zr = cr * pr - ci * pi, zi = cr * pi + ci * pr;
                const float yr = zr * fr - zi * fi, yi = zr * fi + zi * fr;
                const f4* br4 = (const f4*)(bre + (size_t)(g * 64 + p) * 16); const f4* bi4 = (const f4*)(bim + (size_t)(g * 64 + p) * 16);
#pragma unroll
                for (int q = 0; q < 4; ++q) { const f4 x = br4[q], y = bi4[q];
                    acc[4 * q + 0] += yr * x.x - yi * y.x; acc[4 * q + 1] += yr * x.y - yi * y.y; acc[4 * q + 2] += yr * x.z - yi * y.z; acc[4 * q + 3] += yr * x.w - yi * y.w; }
            }
#pragma unroll
            for (int j = 0; j < 16; ++j) { acc[j] += __shfl_xor(acc[j], 1); acc[j] += __shfl_xor(acc[j], 2); }
            if (pq == 0) { f4* o = (f4*)(KT + (size_t)task * 16);
#pragma unroll
                for (int q = 0; q < 4; ++q) o[q] = (f4){acc[4 * q], acc[4 * q + 1], acc[4 * q + 2], acc[4 * q + 3]}; }
        }
        bf16* S5P = (bf16*)(ws + OFF_S5P);
        for (int task = gt; task < 32 * 64 * 64; task += GT) {
            const int g = task >> 12, p = (task >> 6) & 63, s = task & 63;
            const float dt = expf(ldt[g]); const float lr = lre[g * 64 + p], li = lim[g * 64 + p];
            float pr, pi; lam_pow(lr, li, dt, 63 - s, pr, pi);
            float l1r, l1i; lam_pow(lr, li, dt, 1, l1r, l1i);
            const float nr = l1r - 1.f, ni = l1i, den = lr * lr + li * li;
            const float fr = (nr * lr + ni * li) / den, fi = (ni * lr - nr * li) / den;
            const float yr = pr * fr - pi * fi, yi = pr * fi + pi * fr;
            const float* br = bre + (size_t)(g * 64 + p) * 16; const float* bi = bim + (size_t)(g * 64 + p) * 16;
            unsigned ore[8], oim[8];
#pragma unroll
            for (int j = 0; j < 8; ++j) { const float x0 = br[2 * j], y0 = bi[2 * j], x1 = br[2 * j + 1], y1 = bi[2 * j + 1];
                ore[j] = pk2(yr * x0 - yi * y0, yr * x1 - yi * y1); oim[j] = pk2(yr * y0 + yi * x0, yr * y1 + yi * x1); }
            v4u* d0 = (v4u*)(S5P + ((size_t)(g * 256 + 2 * p) * 1024 + s * 16)); v4u* d1 = (v4u*)(S5P + ((size_t)(g * 256 + 2 * p + 1) * 1024 + s * 16));
            d0[0] = (v4u){ore[0], ore[1], ore[2], ore[3]}; d0[1] = (v4u){ore[4], ore[5], ore[6], ore[7]};
            d1[0] = (v4u){oim[0], oim[1], oim[2], oim[3]}; d1[1] = (v4u){oim[4], oim[5], oim[6], oim[7]};
        }
        for (int task = gt; task < 32 * 128 * 128; task += GT) {
            const int g = task >> 14, r = (task >> 7) & 127, c8 = task & 127;
            *(v4u*)(S5P + ((size_t)(g * 256 + 128 + r) * 1024 + c8 * 8)) = (v4u){0u, 0u, 0u, 0u};
        }
        bf16* S5M = (bf16*)(ws + OFF_S5M);
        for (int task = gt; task < 32 * 64 * 64; task += GT) {
            const int g = task >> 12, t = (task >> 6) & 63, p = task & 63;
            const float dt = expf(ldt[g]); const float lr = lre[g * 64 + p], li = lim[g * 64 + p];
            float pr, pi; lam_pow(lr, li, dt, t + 1, pr, pi);
#pragma unroll
            for (int i = 0; i < 16; ++i) { const float cr = cre[(g * 16 + i) * 64 + p], ci = cim[(g * 16 + i) * 64 + p];
                *(unsigned*)(S5M + ((size_t)(g * 1024 + t * 16 + i) * 1152 + 2 * p)) = pk2(cr * pr - ci * pi, -(cr * pi + ci * pr)); }
        }
    }
    TOC(12) TIC(13)
    {
        LAS float* wif = (LAS float*)(L + 69632);
        const float* win = a.in[I_WIN];
        for (int idx = tid; idx < 8192; idx += 512) wif[idx] = win[(size_t)(idx >> 3) * NPROJ + 2048 + (idx & 7)];
        __syncthreads();
        const float* x = a.in[I_X]; const float* g1 = a.in[I_N1G]; const float* bif = a.in[I_BIF];
        bf16* H1 = (bf16*)(ws + OFF_H1); float* GATES = (float*)(ws + OFF_GATES);
        f4 gv[4];
#pragma unroll
        for (int j = 0; j < 4; ++j) gv[j] = ((const f4*)g1)[lane + 64 * j];
        for (int m0 = 2 * gw; m0 < T; m0 += 2 * NGW) {
            f4 v2[2][4];
#pragma unroll
            for (int rr = 0; rr < 2; ++rr) { const f4* xr = (const f4*)(x + (size_t)(m0 + rr) * DM) + lane;
#pragma unroll
                for (int j = 0; j < 4; ++j) v2[rr][j] = xr[64 * j]; }
#pragma unroll
            for (int rr = 0; rr < 2; ++rr) { const int m = m0 + rr;
            f4 v[4]; float ss = 0.f;
#pragma unroll
            for (int j = 0; j < 4; ++j) { v[j] = v2[rr][j]; ss += (v[j].x * v[j].x + v[j].y * v[j].y) + (v[j].z * v[j].z + v[j].w * v[j].w); }
            const float rstd = rsqrtf(wave_sum(ss) * (1.f / DM) + EPS);
            float ga[8];
#pragma unroll
            for (int c = 0; c < 8; ++c) ga[c] = 0.f;
            bf16* o8 = H1 + (((size_t)(m >> 8) * 16 + (lane >> 4)) * 256 + (m & 255)) * 64 + 4 * (lane & 15);
#pragma unroll
            for (int j = 0; j < 4; ++j) { v[j] = v[j] * rstd * gv[j];
                *(unsigned long long*)(o8 + (size_t)j * 4 * 256 * 64) = (unsigned long long)pk2(v[j].x, v[j].y) | ((unsigned long long)pk2(v[j].z, v[j].w) << 32);
#pragma unroll
                for (int e = 0; e < 4; ++e) { const int k = 4 * lane + 256 * j + e; const f4 w0 = *(const LAS f4*)(wif + k * 8), w1 = *(const LAS f4*)(wif + k * 8 + 4); const float hv = v[j][e];
                    ga[0] += hv * w0.x; ga[1] += hv * w0.y; ga[2] += hv * w0.z; ga[3] += hv * w0.w; ga[4] += hv * w1.x; ga[5] += hv * w1.y; ga[6] += hv * w1.z; ga[7] += hv * w1.w; }
            }
            float r4[4], r2[2], r1;
            { const bool hi = lane & 32;
#pragma unroll
              for (int i = 0; i < 4; ++i) { const float send = hi ? ga[i] : ga[i + 4], keep = hi ? ga[i + 4] : ga[i]; r4[i] = keep + __shfl_xor(send, 32); } }
            { const bool hi = lane & 16;
#pragma unroll
              for (int i = 0; i < 2; ++i) { const float send = hi ? r4[i] : r4[i + 2], keep = hi ? r4[i + 2] : r4[i]; r2[i] = keep + __shfl_xor(send, 16); } }
            { const bool hi = lane & 8; const float send = hi ? r2[0] : r2[1], keep = hi ? r2[1] : r2[0]; r1 = keep + __shfl_xor(send, 8); }
            r1 += __shfl_xor(r1, 4); r1 += __shfl_xor(r1, 2); r1 += __shfl_xor(r1, 1);
            if ((lane & 7) == 0) { const int c = (lane >> 3) & 7; GATES[(size_t)m * 8 + c] = r1 + bif[c]; }
            }
        }
    }
    TOC(13)
}

__device__ __forceinline__ void s5_expand(const KArgs& a, int G) {
    const float* KT = (const float*)(a.ws + OFF_KT); bf16* S5M = (bf16*)(a.ws + OFF_S5M);
    const int gt = blockIdx.x * 512 + otid(), GT = G * 512;
    for (int task = gt; task < 32 * 1024 * 64; task += GT) {
        const int s = task & 63, row = task >> 6, g = row >> 10, t = (row >> 4) & 63, i = row & 15;
        if (s >= ((t >> 4) + 1) * 16) continue;
        v4u o0 = (v4u){0u, 0u, 0u, 0u}, o1 = o0;
        if (s <= t) { const f4* k4 = (const f4*)(KT + ((size_t)((g * 64 + (t - s)) * 16 + i)) * 16); const f4 a0 = k4[0], a1 = k4[1], a2 = k4[2], a3 = k4[3];
            o0 = (v4u){pk2(a0.x, a0.y), pk2(a0.z, a0.w), pk2(a1.x, a1.y), pk2(a1.z, a1.w)}; o1 = (v4u){pk2(a2.x, a2.y), pk2(a2.z, a2.w), pk2(a3.x, a3.y), pk2(a3.z, a3.w)}; }
        v4u* d = (v4u*)(S5M + ((size_t)row * 1152 + 128 + s * 16)); d[0] = o0; d[1] = o1;
    }
}

using pg8::Unit; using pg8::cvt_pk_bf16;
struct EpiInProj {
    static constexpr bool PERM = true;
    bf16 *QK, *V, *O, *UG;
    __device__ __forceinline__ void operator()(const pg8::f32x4 (&acc)[2][2][4][2], const Unit& u, int wr, int wc, int fr, int fq) const {
        const int row0 = u.pm * 256 + wr * 64 + fr, c0 = wc * 32 + 8 * fq;
#pragma unroll
        for (int ai = 0; ai < 2; ++ai)
#pragma unroll
            for (int m = 0; m < 4; ++m) { const int row = row0 + ai * 128 + m * 16;
#pragma unroll
                for (int bj = 0; bj < 2; ++bj) { const pg8::f32x4 v0 = acc[ai][bj][m][0], v1 = acc[ai][bj][m][1];
                    v4u w; w.x = cvt_pk_bf16(v0[0], v0[1]); w.y = cvt_pk_bf16(v0[2], v0[3]); w.z = cvt_pk_bf16(v1[0], v1[1]); w.w = cvt_pk_bf16(v1[2], v1[3]);
                    const int col = c0 + bj * 128;
                    bf16* dst;
                    if (u.pn < 4) dst = QK + (size_t)row * 1024 + u.pn * 256 + col;
                    else if (u.pn < 6) dst = V + (size_t)row * 512 + (u.pn - 4) * 256 + col;
                    else if (u.pn < 8) dst = O + (size_t)row * 512 + (u.pn - 6) * 256 + col;
                    else { const int uc = (u.pn - 8) * 256 + col, g = uc >> 4, j = uc & 15; dst = UG + ((size_t)(g * 1024 + (row >> 6)) * 1152 + 128 + (row & 63) * 16 + j); }
                    *(v4u*)dst = w; } }
    }
};
struct EpiS5E {
    static constexpr bool PERM = false;
    float* E;
    __device__ __forceinline__ void operator()(const pg8::f32x4 (&acc)[2][2][4][2], const Unit& u, int wr, int wc, int fr, int fq) const {
        const int row0 = u.pm * 256 + wr * 64 + fr, col0 = wc * 32 + 4 * fq;
#pragma unroll
        for (int ai = 0; ai < 2; ++ai)
#pragma unroll
            for (int m = 0; m < 4; ++m) { float* rowp = E + (size_t)(row0 + ai * 128 + m * 16) * 128 + col0;
#pragma unroll
                for (int n = 0; n < 2; ++n) *(pg8::f32x4*)(rowp + n * 16) = acc[ai][0][m][n]; }
    }
};
struct EpiS5Y {
    static constexpr bool PERM = true;
    const bf16* UG; const float* dskip; bf16* YSG;
    __device__ __forceinline__ void operator()(const pg8::f32x4 (&acc)[2][2][4][2], const Unit& u, int wr, int wc, int fr, int fq) const {
        const int g = u.pm >> 2, row0 = u.pm * 256 + wr * 64 + fr, c0 = (u.pn & 3) * 256 + wc * 32 + 8 * fq;
#pragma unroll
        for (int ai = 0; ai < 2; ++ai)
#pragma unroll
            for (int m = 0; m < 4; ++m) { const int row = row0 + ai * 128 + m * 16, chunk = row & 1023;
#pragma unroll
                for (int bj = 0; bj < 2; ++bj) { const int n = c0 + bj * 128, t = n >> 4, i0 = n & 15;
                    const v4u uw = *(const v4u*)(UG + ((size_t)row * 1152 + 128 + n));
                    const f4 d0 = *(const f4*)(dskip + g * 16 + i0), d1 = *(const f4*)(dskip + g * 16 + i0 + 4);
                    const pg8::f32x4 v0 = acc[ai][bj][m][0], v1 = acc[ai][bj][m][1];
                    float y[8];
                    y[0] = v0[0] + d0.x * bflo(uw.x); y[1] = v0[1] + d0.y * bfhi(uw.x); y[2] = v0[2] + d0.z * bflo(uw.y); y[3] = v0[3] + d0.w * bfhi(uw.y);
                    y[4] = v1[0] + d1.x * bflo(uw.z); y[5] = v1[1] + d1.y * bfhi(uw.z); y[6] = v1[2] + d1.z * bflo(uw.w); y[7] = v1[3] + d1.w * bfhi(uw.w);
#pragma unroll
                    for (int e = 0; e < 8; ++e) y[e] = gelu_tanh(y[e]);
                    v4u w; w.x = cvt_pk_bf16(y[0], y[1]); w.y = cvt_pk_bf16(y[2], y[3]); w.z = cvt_pk_bf16(y[4], y[5]); w.w = cvt_pk_bf16(y[6], y[7]);
                    *(v4u*)(YSG + ((size_t)(chunk * 64 + t) * 512 + g * 16 + i0)) = w; } }
    }
};
struct EpiGlu {
    static constexpr bool PERM = true;
    const bf16* YSG; const float* bglu; bf16* MIX;
    __device__ __forceinline__ void operator()(const pg8::f32x4 (&acc)[2][2][4][2], const Unit& u, int wr, int wc, int fr, int fq) const {
        const int row0 = u.pm * 256 + wr * 64 + fr, c0 = u.pn * 256 + wc * 32 + 8 * fq;
#pragma unroll
        for (int ai = 0; ai < 2; ++ai)
#pragma unroll
            for (int m = 0; m < 4; ++m) { const int row = row0 + ai * 128 + m * 16;
#pragma unroll
                for (int bj = 0; bj < 2; ++bj) { const int col = c0 + bj * 128;
                    const v4u yw = *(const v4u*)(YSG + (size_t)row * 512 + col);
                    const f4 b0 = *(const f4*)(bglu + col), b1 = *(const f4*)(bglu + col + 4);
                    const pg8::f32x4 v0 = acc[ai][bj][m][0], v1 = acc[ai][bj][m][1];
                    float y[8];
                    y[0] = bflo(yw.x) * sigmoidf_(v0[0] + b0.x); y[1] = bfhi(yw.x) * sigmoidf_(v0[1] + b0.y); y[2] = bflo(yw.y) * sigmoidf_(v0[2] + b0.z); y[3] = bfhi(yw.y) * sigmoidf_(v0[3] + b0.w);
                    y[4] = bflo(yw.z) * sigmoidf_(v1[0] + b1.x); y[5] = bfhi(yw.z) * sigmoidf_(v1[1] + b1.y); y[6] = bflo(yw.w) * sigmoidf_(v1[2] + b1.z); y[7] = bfhi(yw.w) * sigmoidf_(v1[3] + b1.w);
                    v4u w; w.x = cvt_pk_bf16(y[0], y[1]); w.y = cvt_pk_bf16(y[2], y[3]); w.z = cvt_pk_bf16(y[4], y[5]); w.w = cvt_pk_bf16(y[6], y[7]);
                    *(v4u*)(MIX + (size_t)row * 1024 + 512 + col) = w; } }
    }
};
struct EpiOut {
    static constexpr bool PERM = true;
    bf16* MO;
    __device__ __forceinline__ void operator()(const pg8::f32x4 (&acc)[2][2][4][2], const Unit& u, int wr, int wc, int fr, int fq) const {
        const int row0 = u.pm * 256 + wr * 64 + fr, c0 = u.pn * 256 + wc * 32 + 8 * fq;
#pragma unroll
        for (int ai = 0; ai < 2; ++ai)
#pragma unroll
            for (int m = 0; m < 4; ++m) { bf16* rowp = MO + (size_t)(row0 + ai * 128 + m * 16) * 1024 + c0;
#pragma unroll
                for (int bj = 0; bj < 2; ++bj) { const pg8::f32x4 v0 = acc[ai][bj][m][0], v1 = acc[ai][bj][m][1];
                    v4u w; w.x = cvt_pk_bf16(v0[0], v0[1]); w.y = cvt_pk_bf16(v0[2], v0[3]); w.z = cvt_pk_bf16(v1[0], v1[1]); w.w = cvt_pk_bf16(v1[2], v1[3]);
                    *(v4u*)(rowp + bj * 128) = w; } }
    }
};
struct EpiMoeGU {
    static constexpr bool PERM = true;
    const float* bgu; unsigned char* ACT; const float* rstds;
    __device__ __forceinline__ void operator()(const pg8::f32x4 (&acc)[2][2][4][2], const Unit& u, int wr, int wc, int fr, int fq) const {
        const int e = u.pn >> 3, pnl = u.pn & 7, row0 = u.pm * 256 + wr * 64 + fr, c0 = pnl * 128 + wc * 32 + 8 * fq;
        const float* bg = bgu + (size_t)e * 2048 + c0; const float* bu = bg + 1024;
        const f4 g0 = *(const f4*)bg, g1 = *(const f4*)(bg + 4), u0 = *(const f4*)bu, u1 = *(const f4*)(bu + 4);
        const float gb[8] = {g0.x, g0.y, g0.z, g0.w, g1.x, g1.y, g1.z, g1.w}, ub[8] = {u0.x, u0.y, u0.z, u0.w, u1.x, u1.y, u1.z, u1.w};
        constexpr float inv = 1.f / (FP8_WSCALE * FP8_ASCALE);
#pragma unroll
        for (int ai = 0; ai < 2; ++ai)
#pragma unroll
            for (int m = 0; m < 4; ++m) { const int row = row0 + ai * 128 + m * 16; const float ri = rstds[row] * inv;
                float y[8];
#pragma unroll
                for (int n = 0; n < 2; ++n)
#pragma unroll
                    for (int q = 0; q < 4; ++q) { const int k = 4 * n + q;
                        const float gate = fminf(acc[ai][0][m][n][q] * ri + gb[k], 7.0f); const float up = fminf(fmaxf(acc[ai][1][m][n][q] * ri + ub[k], -7.0f), 7.0f);
                        y[k] = (up + 1.0f) * gate * sigmoidf_(1.702f * gate) * FP8_ASCALE; }
                v2u w; w.x = pk4_fp8(y[0], y[1], y[2], y[3]); w.y = pk4_fp8(y[4], y[5], y[6], y[7]);
                *(v2u*)(ACT + ((size_t)(u.pm * 8 + pnl) * 256 + (row & 255)) * 128 + (wc * 32 + 8 * fq)) = w; }
    }
};
struct EpiMoeDN {
    static constexpr bool PERM = true;
    const float* bdn; const float* rgate; unsigned char* YS;
    __device__ __forceinline__ void operator()(const pg8::f32x4 (&acc)[2][2][4][2], const Unit& u, int wr, int wc, int fr, int fq) const {
        const int e = u.pn >> 2, pnl = u.pn & 3, row0 = u.pm * 256 + wr * 64 + fr, c0 = pnl * 256 + wc * 32 + 8 * fq;
#pragma unroll
        for (int bj = 0; bj < 2; ++bj) { const int col = c0 + bj * 128;
            const f4 b0 = *(const f4*)(bdn + (size_t)e * 1024 + col), b1 = *(const f4*)(bdn + (size_t)e * 1024 + col + 4);
#pragma unroll
            for (int ai = 0; ai < 2; ++ai)
#pragma unroll
                for (int m = 0; m < 4; ++m) { const int row = row0 + ai * 128 + m * 16; const float gt = rgate[row];
                    const pg8::f32x4 v0 = acc[ai][bj][m][0] * (1.f / (FP8_WSCALE * FP8_ASCALE)), v1 = acc[ai][bj][m][1] * (1.f / (FP8_WSCALE * FP8_ASCALE));
                    const float gs = gt * FP8_YSCALE;
                    v2u w; w.x = pk4_fp8((v0[0] + b0.x) * gs, (v0[1] + b0.y) * gs, (v0[2] + b0.z) * gs, (v0[3] + b0.w) * gs);
                    w.y = pk4_fp8((v1[0] + b1.x) * gs, (v1[1] + b1.y) * gs, (v1[2] + b1.z) * gs, (v1[3] + b1.w) * gs);
                    *(v2u*)(YS + (size_t)row * 1024 + col) = w; } }
    }
};

struct S5EOrder {
    int G, c;
    __device__ __forceinline__ bool next(int i, Unit& u) const { const int x = c & 7, j = c >> 3; if (i > 0 || j >= 16) return false; const int g = x + 8 * (j >> 2); u.pm = g * 4 + (j & 3); u.pn = g; u.rd = 0; u.nt = 0; return true; }
    __device__ __forceinline__ void a_ready(const Unit&) const {}
    __device__ __forceinline__ void done(const Unit&) const {}
};
struct S5YOrder {
    int G, c;
    __device__ __forceinline__ bool next(int i, Unit& u) const { if (i >= 2) return false; const int x = c & 7, j = c >> 3, g = x + 8 * (2 * i + (j >> 4)), r = j & 15, b = i ? 3 - (r & 3) : (r & 3);
        u.pm = g * 4 + (r >> 2); u.pn = g * 4 + b; u.rd = i; u.nt = 6 + 4 * b; return true; }
    __device__ __forceinline__ void a_ready(const Unit&) const {}
    __device__ __forceinline__ void done(const Unit&) const {}
};
struct MoeOrder {
    const int* tile_e; int ntile, NT, G, c;
    unsigned* sync;
    __device__ __forceinline__ bool next(int i, Unit& u) const {
#ifdef HALF_CHIP
        const int x = c & 7, RT = 32 / NT; if ((c >> 3) >= 16) return false; const int j = (c >> 3) + 16 * (i & 1); i >>= 1;
#else
        const int x = c & 7, j = c >> 3, RT = 32 / NT;
#endif
        const int it = (i * 8 + x) * RT + j / NT, pnl = j % NT;
        if (it >= ntile) return false;
#ifdef DN_REVERSE
        if (NT == 4) { const int itr = ntile - 1 - it; u.pm = itr; u.pn = tile_e[itr] * NT + pnl; u.rd = i; u.nt = 0; return true; }
#endif
        u.pm = it; u.pn = tile_e[it] * NT + pnl; u.rd = i; u.nt = 0; return true; }
    __device__ __forceinline__ void a_ready(const Unit&) const {}
    __device__ __forceinline__ void done(const Unit&) const {}
};

typedef short v4i16_t __attribute__((ext_vector_type(4)));
__device__ __forceinline__ bf16x8 tr_frag(const LAS unsigned char* img, int RS, int ks, int n0, int lane) {
    const int h = lane >> 5, blk = (lane >> 4) & 1, q = (lane & 15) >> 2, p = lane & 3;
    const LAS unsigned char* a0 = img + (16 * ks + 8 * h + q) * RS + (n0 + 16 * blk + 4 * p) * 2;
    const v4i16_t lo = __builtin_amdgcn_ds_read_tr16_b64_v4i16((LAS v4i16_t*)a0), hi = __builtin_amdgcn_ds_read_tr16_b64_v4i16((LAS v4i16_t*)(a0 + 4 * RS));
    return (bf16x8){lo[0], lo[1], lo[2], lo[3], hi[0], hi[1], hi[2], hi[3]};
}
__device__ __forceinline__ int tr_base(int RS, int lane) { const int h = lane >> 5, blk = (lane >> 4) & 1, q = (lane & 15) >> 2, p = lane & 3; return (8 * h + q) * RS + (16 * blk + 4 * p) * 2; }
__device__ __forceinline__ bf16x8 tr_frag_b(const LAS unsigned char* lanebase, int RS, int off) {
    const v4i16_t lo = __builtin_amdgcn_ds_read_tr16_b64_v4i16((LAS v4i16_t*)(lanebase + off)), hi = __builtin_amdgcn_ds_read_tr16_b64_v4i16((LAS v4i16_t*)(lanebase + off + 4 * RS));
    return (bf16x8){lo[0], lo[1], lo[2], lo[3], hi[0], hi[1], hi[2], hi[3]};
}
__device__ __forceinline__ v4u pack8(const float (&v)[8]) { v4u w; w.x = pk2(v[0], v[1]); w.y = pk2(v[2], v[3]); w.z = pk2(v[4], v[5]); w.w = pk2(v[6], v[7]); return w; }
constexpr int ML_KT = 0, ML_VT = 34816, ML_TILE = 17408;
constexpr int ML_CW = 69632;
constexpr int ML_GA = 74752;
constexpr int ML_PW = 79616;
struct KvRaw { v4u k[4][2]; v4u v[2]; unsigned m[4]; };
__device__ __forceinline__ void kv_load(KvRaw& R, const bf16* QKb  , const bf16* Vb  , int srow  , int col0) {
#pragma unroll
    for (int i = 0; i < 4; ++i) { const int r = srow - 3 + i; const v4u* p = (const v4u*)(QKb + (size_t)(r < 0 ? 0 : r) * 1024 + col0); R.k[i][0] = p[0]; R.k[i][1] = p[1]; R.m[i] = r < 0 ? 0u : 0xffffffffu; }
    const v4u* pv = (const v4u*)(Vb + (size_t)srow * 512 + col0); R.v[0] = pv[0]; R.v[1] = pv[1];
}
__device__ __forceinline__ void kv_conv(const KvRaw& R, const LAS float* cw, int col0, float mul, float (&o)[16]) {
#pragma unroll
    for (int q = 0; q < 4; ++q) { const f4 bv = *(const LAS f4*)(cw + 4 * 128 + col0 + 4 * q); o[4 * q] = bv.x; o[4 * q + 1] = bv.y; o[4 * q + 2] = bv.z; o[4 * q + 3] = bv.w; }
#pragma unroll
    for (int i = 0; i < 4; ++i) { const unsigned m = R.m[i];
        const unsigned xw[8] = {R.k[i][0].x & m, R.k[i][0].y & m, R.k[i][0].z & m, R.k[i][0].w & m, R.k[i][1].x & m, R.k[i][1].y & m, R.k[i][1].z & m, R.k[i][1].w & m};
#pragma unroll
        for (int q = 0; q < 4; ++q) { const f4 w = *(const LAS f4*)(cw + i * 128 + col0 + 4 * q);
            o[4 * q] += w.x * bflo(xw[2 * q]); o[4 * q + 1] += w.y * bfhi(xw[2 * q]); o[4 * q + 2] += w.z * bflo(xw[2 * q + 1]); o[4 * q + 3] += w.w * bfhi(xw[2 * q + 1]); } }
#pragma unroll
    for (int e = 0; e < 16; ++e) o[e] = siluf_(o[e]) * mul;
}
__device__ __forceinline__ void gate_part1(const float* GATES, int tok0, int h, int tid, float& bbw, float& ig, LAS float* scr, int nw) {
    const int lane = tid & 63, wave = tid >> 6;
    if (wave < nw) { const float fg = GATES[(size_t)(tok0 + tid) * 8 + 4 + h]; ig = GATES[(size_t)(tok0 + tid) * 8 + h];
        bbw = logsigmoidf_(fg);
#pragma unroll
        for (int o = 1; o < 64; o <<= 1) { const float t = __shfl_up(bbw, o); if (lane >= o) bbw += t; }
        if (lane == 63) scr[wave] = bbw; }
}
__device__ __forceinline__ void mlstm_state_item(const KArgs& a, LAS unsigned char* L, int item) {
    const int tid = otid(), lane = tid & 63, wave = tid >> 6;
    const int c = item & 63, bh = item >> 6, h = bh & 3, b = bh >> 2, tok0 = b * SEQ + c * 128;
    LAS float* cwk = (LAS float*)(L + ML_CW) + 640; LAS float* wsv = (LAS float*)(L + ML_GA); LAS float* scr = wsv + 1024;
    const bf16* QKb = (const bf16*)(a.ws + OFF_QK) + (size_t)(b * SEQ) * 1024 + 512 + h * 128; const bf16* Vb = (const bf16*)(a.ws + OFF_V) + (size_t)(b * SEQ) * 512 + h * 128;
    const int s = tid >> 3, col0 = (tid & 7) * 16;
    KvRaw R; kv_load(R, QKb, Vb, c * 128 + s, col0);
    if (tid < 160) { const int r = tid >> 5, q4 = (tid & 31) * 4; *(LAS f4*)(cwk + r * 128 + q4) = r < 4 ? *(const f4*)(a.in[I_CONVW] + r * 1024 + 512 + h * 128 + q4) : *(const f4*)(a.in[I_CONVB] + 512 + h * 128 + q4); }
    float bbw = 0.f, ig = 0.f; gate_part1((const float*)(a.ws + OFF_GATES), tok0, h, tid, bbw, ig, scr, 2);
    __syncthreads();
    float wl = -3.0e38f;
    if (wave < 2) { float off = 0.f;
#pragma unroll
        for (int w = 0; w < 2; ++w) if (w < wave) off += scr[w];
        const float g = scr[0] + scr[1]; wl = g - (bbw + off) + ig;
        const float wm = wave_max(wl); if (lane == 0) scr[8 + wave] = wm;
        if (tid == 0) ((float*)(a.ws + OFF_MLG))[item] = g; }
    __syncthreads();
    if (wave < 2) { const float amax = fmaxf(scr[8], scr[9]); wsv[tid] = expf(wl - amax); if (tid == 0) ((float*)(a.ws + OFF_MLA))[item] = amax; }
    __syncthreads();
    const int kdb = wave >> 1, vb0 = (wave & 1) * 2, r32 = lane & 31, hh = lane >> 5;
    f32x16 acc0, acc1;
#pragma unroll
    for (int i = 0; i < 16; ++i) { acc0[i] = 0.f; acc1[i] = 0.f; }
    float np = 0.f;
#pragma unroll 1
    for (int j = 0; j < 2; ++j) {
        LAS unsigned char* kt = L + ML_KT + (j & 1) * ML_TILE; LAS unsigned char* vt = L + ML_VT + (j & 1) * ML_TILE;
        { float o[16]; kv_conv(R, cwk, col0, 0.08838834764831845f * wsv[64 * j + s], o);
          const float o0[8] = {o[0], o[1], o[2], o[3], o[4], o[5], o[6], o[7]}, o1[8] = {o[8], o[9], o[10], o[11], o[12], o[13], o[14], o[15]};
          *(LAS v4u*)(kt + s * 272 + col0 * 2) = pack8(o0); *(LAS v4u*)(kt + s * 272 + col0 * 2 + 16) = pack8(o1);
          *(LAS v4u*)(vt + s * 272 + col0 * 2) = R.v[0]; *(LAS v4u*)(vt + s * 272 + col0 * 2 + 16) = R.v[1]; }
        kv_load(R, QKb, Vb, c * 128 + 64 + s, col0);
        __syncthreads();
#pragma unroll
        for (int ks = 0; ks < 4; ++ks) { const bf16x8 A = tr_frag(kt, 272, ks, kdb * 32, lane), B0 = tr_frag(vt, 272, ks, vb0 * 32, lane), B1 = tr_frag(vt, 272, ks, vb0 * 32 + 32, lane);
            acc0 = __builtin_amdgcn_mfma_f32_32x32x16_bf16(A, B0, acc0, 0, 0, 0); acc1 = __builtin_amdgcn_mfma_f32_32x32x16_bf16(A, B1, acc1, 0, 0, 0); }
        if (tid < 128) {
#pragma unroll 8
            for (int q = 0; q < 64; ++q) np += bf2f(*(const LAS bf16*)(kt + q * 272 + tid * 2)); }
    }
    {
        bf16* UP = (bf16*)((unsigned char*)a.out + OUT_UP) + (size_t)item * 16384;
#pragma unroll
        for (int q = 0; q < 4; ++q) { const int kd = kdb * 32 + 8 * q + 4 * hh;
            v2u w0; w0.x = pk2(acc0[4 * q], acc0[4 * q + 1]); w0.y = pk2(acc0[4 * q + 2], acc0[4 * q + 3]);
            v2u w1; w1.x = pk2(acc1[4 * q], acc1[4 * q + 1]); w1.y = pk2(acc1[4 * q + 2], acc1[4 * q + 3]);
            *(v2u*)(UP + (size_t)(vb0 * 32 + r32) * 128 + kd) = w0; *(v2u*)(UP + (size_t)((vb0 + 1) * 32 + r32) * 128 + kd) = w1; }
        if (tid < 128) ((float*)(a.ws + OFF_MLNP))[(size_t)item * 128 + tid] = np;
    }
    __syncthreads();
}

__device__ __forceinline__ void phase3(const KArgs& a, LAS unsigned char* L, int G) {
    const int tid = otid(), lane = tid & 63, wave = tid >> 6;
    LAS float* ga = (LAS float*)L; LAS float* aa = ga + 64; LAS float* dec = aa + 64; LAS float* scl = dec + 64;
    for (int w = blockIdx.x; w < 256; w += G) {
        const int bh = w >> 3, slice = w & 7;
        if (tid < 64) { ga[tid] = ((const float*)(a.ws + OFF_MLG))[bh * 64 + tid]; aa[tid] = ((const float*)(a.ws + OFF_MLA))[bh * 64 + tid]; }
        __syncthreads();
        if (tid == 0) { float m = 0.f; float* MLM = (float*)(a.ws + OFF_MLM);
            for (int c = 0; c < 64; ++c) { const float g = ga[c], am = aa[c], mn = fmaxf(g + m, am); dec[c] = expf(g + m - mn); scl[c] = expf(am - mn); if (slice == 0) MLM[bh * 64 + c] = m; m = mn; } }
        __syncthreads();
        {
            const size_t e0 = (size_t)bh * 64 * 16384 + slice * 2048 + tid * 4;
            const bf16* up = (const bf16*)((const unsigned char*)a.out + OUT_UP) + e0; bf16* cs = (bf16*)((unsigned char*)a.out + OUT_CST) + e0;
            float C0 = 0.f, C1 = 0.f, C2 = 0.f, C3 = 0.f;
            for (int c0 = 0; c0 < 64; c0 += 16) {
                v2u uv[16];
#pragma unroll
                for (int q = 0; q < 16; ++q) uv[q] = *(const v2u*)(up + (size_t)(c0 + q) * 16384);
#pragma unroll
                for (int q = 0; q < 16; ++q) { v2u o; o.x = pk2(C0, C1); o.y = pk2(C2, C3); *(v2u*)(cs + (size_t)(c0 + q) * 16384) = o;
                    const float d = dec[c0 + q], sc = scl[c0 + q];
                    C0 = d * C0 + sc * bflo(uv[q].x); C1 = d * C1 + sc * bfhi(uv[q].x); C2 = d * C2 + sc * bflo(uv[q].y); C3 = d * C3 + sc * bfhi(uv[q].y); }
            }
        }
        if (slice == 0 && tid < 128) { const float* np = (const float*)(a.ws + OFF_MLNP) + (size_t)bh * 64 * 128 + tid; float* ns = (float*)(a.ws + OFF_MLN) + (size_t)bh * 64 * 128 + tid; float n = 0.f;
            for (int c = 0; c < 64; ++c) { ns[c * 128] = n; n = dec[c] * n + scl[c] * np[c * 128]; } }
        __syncthreads();
    }
    if (wave == 7) for (int w = blockIdx.x; w < 256; w += G) {
        const int b = w >> 5, g = w & 31, p = lane;
        const float dt = expf(a.in[I_LDT][g]); float lr, li; lam_pow(a.in[I_LRE][g * 64 + p], a.in[I_LIM][g * 64 + p], dt, 64, lr, li);
        const float* E = (const float*)(a.ws + OFF_S5E) + ((size_t)(g * 1024 + b * 128) * 128 + 2 * p);
        bf16* UG = (bf16*)(a.ws + OFF_UG) + ((size_t)(g * 1024 + b * 128) * 1152 + 2 * p);
        float xr = 0.f, xi = 0.f;
        for (int c0 = 0; c0 < 128; c0 += 8) {
            f2 ev[8];
#pragma unroll
            for (int q = 0; q < 8; ++q) ev[q] = *(const f2*)(E + (size_t)(c0 + q) * 128);
#pragma unroll
            for (int q = 0; q < 8; ++q) { *(unsigned*)(UG + (size_t)(c0 + q) * 1152) = pk2(xr, xi);
                const float nr = lr * xr - li * xi + ev[q].x, ni = lr * xi + li * xr + ev[q].y; xr = nr; xi = ni; }
        }
    }
}

__device__ __forceinline__ void kq_load(KvRaw& R, const bf16* QKq, int srow, int col0) {
#pragma unroll
    for (int i = 0; i < 4; ++i) { const int r = srow - 3 + i; const v4u* p = (const v4u*)(QKq + (size_t)(r < 0 ? 0 : r) * 1024 + col0); R.k[i][0] = p[0]; R.k[i][1] = p[1]; R.m[i] = r < 0 ? 0u : 0xffffffffu; }
}
__device__ __forceinline__ bf16x8 tr16_frag(const LAS unsigned char* lanebase, int off) {
    const v4i16_t lo = __builtin_amdgcn_ds_read_tr16_b64_v4i16((LAS v4i16_t*)(lanebase + off)), hi = __builtin_amdgcn_ds_read_tr16_b64_v4i16((LAS v4i16_t*)(lanebase + off + 4 * 272));
    return (bf16x8){lo[0], lo[1], lo[2], lo[3], hi[0], hi[1], hi[2], hi[3]};
}
__device__ __forceinline__ void mlstm_out_item(const KArgs& a, LAS unsigned char* L, int item, int next_item, KvRaw& Ra, KvRaw& Rb, int& h_loaded) {
    const int tid = otid(), lane = tid & 63, wave = __builtin_amdgcn_readfirstlane(tid >> 6);
    const int c = item & 63, bh = item >> 6, h = bh & 3, b = bh >> 2, tok0 = b * SEQ + c * 128;
    const int fr = lane & 15, fq = lane >> 4;
    LAS float* cwq = (LAS float*)(L + ML_CW); LAS float* cwk = cwq + 640;
    LAS float* gcs = (LAS float*)(L + ML_GA); LAS float* grr = gcs + 256; LAS float* gsc = grr + 256; LAS float* gen = gsc + 256; LAS float* scr = gen + 256;
    LAS bf16* Pw = (LAS bf16*)(L + ML_PW + wave * 2304);
    const bf16* QKq = (const bf16*)(a.ws + OFF_QK) + (size_t)(b * SEQ) * 1024 + h * 128;
    const bf16* QKb = QKq + 512; const bf16* Vb = (const bf16*)(a.ws + OFF_V) + (size_t)(b * SEQ) * 512 + h * 128;
    const int s = tid >> 3, col0 = (tid & 7) * 16;
    TIC(31) TIC(36)
    if (h != h_loaded) {
    if (tid < 320) { const int t2 = tid < 160 ? tid : tid - 160, r = t2 >> 5, q4 = (t2 & 31) * 4, ch = (tid < 160 ? 0 : 512) + h * 128 + q4;
        *(LAS f4*)((tid < 160 ? cwq : cwk) + r * 128 + q4) = r < 4 ? *(const f4*)(a.in[I_CONVW] + r * 1024 + ch) : *(const f4*)(a.in[I_CONVB] + ch); }
    else if (tid < 352) *(LAS f4*)(scr + 64 + 4 * (tid - 320)) = *(const f4*)(a.in[I_HNG] + h * 128 + 4 * (tid - 320));
    h_loaded = h; }
    float bbw = 0.f, ig = 0.f; gate_part1((const float*)(a.ws + OFF_GATES), tok0, h, tid, bbw, ig, scr, 2);
    __syncthreads();
    float cs = 0.f, pmw = -3.0e38f, bb = 0.f;
    if (wave < 2) { const float off = wave ? scr[0] : 0.f;
        bb = bbw + off; cs = ig - bb; pmw = cs;
#pragma unroll
        for (int o = 1; o < 64; o <<= 1) { const float t = __shfl_up(pmw, o); if (lane >= o) pmw = fmaxf(pmw, t); }
        if (lane == 63) scr[8 + wave] = pmw; }
    {
        float o[16]; kv_conv(Ra, cwq, col0, 1.f, o);
        { const float o0[8] = {o[0], o[1], o[2], o[3], o[4], o[5], o[6], o[7]}, o1[8] = {o[8], o[9], o[10], o[11], o[12], o[13], o[14], o[15]};
          *(LAS v4u*)(L + s * 272 + col0 * 2) = pack8(o0); *(LAS v4u*)(L + s * 272 + col0 * 2 + 16) = pack8(o1); }
        kv_conv(Rb, cwq, col0, 1.f, o);
        { const float o0[8] = {o[0], o[1], o[2], o[3], o[4], o[5], o[6], o[7]}, o1[8] = {o[8], o[9], o[10], o[11], o[12], o[13], o[14], o[15]};
          *(LAS v4u*)(L + (64 + s) * 272 + col0 * 2) = pack8(o0); *(LAS v4u*)(L + (64 + s) * 272 + col0 * 2 + 16) = pack8(o1); }
    }
    KvRaw R; kv_load(R, QKb, Vb, c * 128 + s, col0);
    __syncthreads();
    TOC(31) TIC(32)
    bf16x8 Aq[4];
#pragma unroll
    for (int ks = 0; ks < 4; ++ks) Aq[ks] = *(const LAS bf16x8*)(L + (16 * wave + fr) * 272 + (32 * ks + 8 * fq) * 2);
    if (wave < 2) { const float pm = wave ? fmaxf(pmw, scr[8]) : pmw;
        const float mk = ((const float*)(a.ws + OFF_MLM))[item], rr = fmaxf(pm, mk);
        gcs[tid] = cs; grr[tid] = rr; gsc[tid] = expf(mk - rr); gen[tid] = expf(-bb - rr); }
    __syncthreads();
    TOC(32) TIC(33)
    pg8::f32x4 num[8]; float rs[4] = {0.f, 0.f, 0.f, 0.f};
#pragma unroll
    for (int cb = 0; cb < 8; ++cb) num[cb] = (pg8::f32x4){0.f, 0.f, 0.f, 0.f};
    const int jmax = wave >> 2;
#pragma unroll 1
    for (int j = 0; j < 2; ++j) {
        LAS unsigned char* kt = L + ML_KT + (j & 1) * ML_TILE; LAS unsigned char* vt = L + ML_VT + (j & 1) * ML_TILE;
        { float o[16]; kv_conv(R, cwk, col0, 0.08838834764831845f, o);
          const float o0[8] = {o[0], o[1], o[2], o[3], o[4], o[5], o[6], o[7]}, o1[8] = {o[8], o[9], o[10], o[11], o[12], o[13], o[14], o[15]};
          *(LAS v4u*)(kt + s * 272 + col0 * 2) = pack8(o0); *(LAS v4u*)(kt + s * 272 + col0 * 2 + 16) = pack8(o1);
          *(LAS v4u*)(vt + s * 272 + col0 * 2) = R.v[0]; *(LAS v4u*)(vt + s * 272 + col0 * 2 + 16) = R.v[1]; }
        kv_load(R, QKb, Vb, c * 128 + 64 + s, col0);
        __syncthreads();
        if (j <= jmax) {
            const LAS unsigned char* ktb = kt + fr * 272 + 16 * fq; const LAS unsigned char* vtb = vt + (8 * fq + (fr >> 2)) * 272 + 8 * (fr & 3);
            LAS bf16* pwb = Pw + (4 * fq) * 72 + fr; const LAS bf16* pab = Pw + fr * 72 + 8 * fq; const LAS float* grb = grr + 16 * wave + 4 * fq; const int tg0 = 16 * wave + 4 * fq;
            asm volatile("" : "+v"(ktb), "+v"(vtb), "+v"(pwb), "+v"(pab), "+v"(grb));
#pragma unroll
            for (int st = 0; st < 4; ++st) {
                pg8::f32x4 sacc = (pg8::f32x4){0.f, 0.f, 0.f, 0.f};
#pragma unroll
                for (int ks = 0; ks < 4; ++ks) { const bf16x8 Bk = *(const LAS bf16x8*)(ktb + st * 16 * 272 + 64 * ks); sacc = __builtin_amdgcn_mfma_f32_16x16x32_bf16(Aq[ks], Bk, sacc, 0, 0, 0); }
                const int sg = 64 * j + 16 * st + fr; const float csv = gcs[sg];
#pragma unroll
                for (int q = 0; q < 4; ++q) { const float ev = __expf(fminf(csv - grb[q], 0.f)); const float pv = (sg <= tg0 + q) ? sacc[q] * ev : 0.f; rs[q] += pv; pwb[q * 72 + 16 * st] = (bf16)f2bf(pv); }
            }
#pragma unroll
            for (int ks = 0; ks < 2; ++ks) { const bf16x8 Ap = *(const LAS bf16x8*)(pab + 32 * ks);
#pragma unroll
                for (int cb = 0; cb < 8; ++cb) num[cb] = __builtin_amdgcn_mfma_f32_16x16x32_bf16(Ap, tr16_frag(vtb, 32 * ks * 272 + 32 * cb), num[cb], 0, 0, 0); }
        }
    }
    TOC(33) TIC(34)
    v4u ow4[4];
    { const bf16* Op = (const bf16*)(a.ws + OFF_O) + (size_t)(tok0 + 16 * wave + (lane >> 2)) * 512 + h * 128 + (lane & 3) * 8;
#pragma unroll
      for (int i = 0; i < 4; ++i) ow4[i] = *(const v4u*)(Op + 32 * i); }
#pragma unroll
    for (int q = 0; q < 4; ++q) { rs[q] += __shfl_xor(rs[q], 1); rs[q] += __shfl_xor(rs[q], 2); rs[q] += __shfl_xor(rs[q], 4); rs[q] += __shfl_xor(rs[q], 8); }
    float sc_t[4], inv[4]; float ss[4] = {0.f, 0.f, 0.f, 0.f};
    {
        const float* nst = (const float*)(a.ws + OFF_MLN) + (size_t)item * 128 + 8 * fq;
        const bf16* CST = (const bf16*)((const unsigned char*)a.out + OUT_CST) + ((size_t)item * 128 + fr) * 128 + 8 * fq;
        f4 nv[8];
#pragma unroll
        for (int ks = 0; ks < 4; ++ks) { nv[2 * ks] = *(const f4*)(nst + ks * 32); nv[2 * ks + 1] = *(const f4*)(nst + ks * 32 + 4); }
        bf16x8 GA[2][4], GB[2][4];
#define LOAD_C(G, cb0) do { _Pragma("unroll") for (int c_ = 0; c_ < 2; ++c_) _Pragma("unroll") for (int ks = 0; ks < 4; ++ks) G[c_][ks] = *(const bf16x8*)(CST + (size_t)((cb0) + c_) * 16 * 128 + ks * 32); } while (0)
#define COMP_C(G, cb0) do { _Pragma("unroll") for (int c_ = 0; c_ < 2; ++c_) { pg8::f32x4 accC = (pg8::f32x4){0.f, 0.f, 0.f, 0.f}; \
        _Pragma("unroll") for (int ks = 0; ks < 4; ++ks) accC = __builtin_amdgcn_mfma_f32_16x16x32_bf16(Aq[ks], G[c_][ks], accC, 0, 0, 0); \
        _Pragma("unroll") for (int q = 0; q < 4; ++q) { const float v = (num[(cb0) + c_][q] + sc_t[q] * accC[q]) * inv[q]; num[(cb0) + c_][q] = v; ss[q] += v * v; } } } while (0)
        LOAD_C(GA, 0); LOAD_C(GB, 2);
        const unsigned msk = fr == 0 ? 0xffffffffu : 0u;
        pg8::f32x4 accn = (pg8::f32x4){0.f, 0.f, 0.f, 0.f};
#pragma unroll
        for (int ks = 0; ks < 4; ++ks) { const f4 n0 = nv[2 * ks], n1 = nv[2 * ks + 1];
            v4u w; w.x = pk2(n0.x, n0.y) & msk; w.y = pk2(n0.z, n0.w) & msk; w.z = pk2(n1.x, n1.y) & msk; w.w = pk2(n1.z, n1.w) & msk;
            accn = __builtin_amdgcn_mfma_f32_16x16x32_bf16(Aq[ks], __builtin_bit_cast(bf16x8, w), accn, 0, 0, 0); }
#pragma unroll
        for (int q = 0; q < 4; ++q) { const int tg = 16 * wave + 4 * fq + q; sc_t[q] = gsc[tg]; const float qn = __shfl(accn[q], lane & 48); const float den = rs[q] + sc_t[q] * qn; inv[q] = __builtin_amdgcn_rcpf(fmaxf(fabsf(den), gen[tg])); }
        COMP_C(GA, 0); LOAD_C(GA, 4);
        COMP_C(GB, 2); LOAD_C(GB, 6);
        COMP_C(GA, 4); COMP_C(GB, 6);
#undef LOAD_C
#undef COMP_C
    }
    TOC(34) TIC(35)
    { const int nc = next_item & 63, nbh = next_item >> 6, nh = nbh & 3, nb = nbh >> 2; const bf16* nq = (const bf16*)(a.ws + OFF_QK) + (size_t)(nb * SEQ) * 1024 + nh * 128;
      kq_load(Ra, nq, nc * 128 + s, col0); kq_load(Rb, nq, nc * 128 + 64 + s, col0); }
    __syncthreads();
    LAS float* Hw = (LAS float*)(L + wave * 8448);
    const LAS float* ghn = scr + 64;
#pragma unroll
    for (int q = 0; q < 4; ++q) { ss[q] += __shfl_xor(ss[q], 1); ss[q] += __shfl_xor(ss[q], 2); ss[q] += __shfl_xor(ss[q], 4); ss[q] += __shfl_xor(ss[q], 8);
        const float rstd = rsqrtf(ss[q] * (1.f / 128.f) + EPS);
#pragma unroll
        for (int cb = 0; cb < 8; ++cb) Hw[(4 * fq + q) * 132 + cb * 16 + fr] = num[cb][q] * rstd; }
    __syncthreads();
    {
        const int t = lane >> 2, vq = lane & 3;
        const LAS float* hg = ghn + vq * 8;
        bf16* MIX = (bf16*)(a.ws + OFF_H1) + (size_t)(tok0 + 16 * wave + t) * 1024 + h * 128 + vq * 8;
#pragma unroll
        for (int i = 0; i < 4; ++i) { const v4u ow = ow4[i]; const f4 h0 = *(const LAS f4*)(Hw + t * 132 + vq * 8 + 32 * i), h1 = *(const LAS f4*)(Hw + t * 132 + vq * 8 + 32 * i + 4);
            const f4 g0 = *(const LAS f4*)(hg + 32 * i), g1 = *(const LAS f4*)(hg + 32 * i + 4);
            float y[8];
            y[0] = sigmoidf_(bflo(ow.x)) * h0.x * g0.x; y[1] = sigmoidf_(bfhi(ow.x)) * h0.y * g0.y; y[2] = sigmoidf_(bflo(ow.y)) * h0.z * g0.z; y[3] = sigmoidf_(bfhi(ow.y)) * h0.w * g0.w;
            y[4] = sigmoidf_(bflo(ow.z)) * h1.x * g1.x; y[5] = sigmoidf_(bfhi(ow.z)) * h1.y * g1.y; y[6] = sigmoidf_(bflo(ow.w)) * h1.z * g1.z; y[7] = sigmoidf_(bfhi(ow.w)) * h1.w * g1.w;
            *(v4u*)(MIX + 32 * i) = pack8(y); }
    }
    __syncthreads();
    TOC(35) TOC(36)
}

template <int N, int MASK> __device__ __forceinline__ void rs_step(float* v, int lane) {
    const bool hi = (lane & MASK) != 0;
#pragma unroll
    for (int i = 0; i < N; ++i) { const float send = hi ? v[i] : v[i + N], keep = hi ? v[i + N] : v[i]; v[i] = keep + __shfl_xor(send, MASK); }
}
__device__ __forceinline__ void phase7(const KArgs& a, LAS unsigned char* L, int G) {
    const int tid = otid(), lane = tid & 63, wave = __builtin_amdgcn_readfirstlane(tid >> 6);
    LAS float* wrT = (LAS float*)L;
    LAS float* g2l = (LAS float*)(L + 131584);
    LAS unsigned char* le = L + 131584 + 4096;
    LAS int* lcnt = (LAS int*)(L + 131584 + 4096 + 1024);
    LAS float* sc = (LAS float*)(L + 131584 + 4096 + 1024 + 128) + wave * 528;
    const float* wr = a.in[I_WR]; const float* g2 = a.in[I_N2G]; const float* br = a.in[I_BR];
    for (int idx = tid; idx < 1024; idx += 512) g2l[idx] = g2[idx];
    for (int idx = tid; idx < 32768; idx += 512) wrT[(idx & 31) * 1028 + (idx >> 5)] = wr[idx] * g2[idx >> 5];
    const float* X1 = a.in[I_X]; const bf16* MO = (const bf16*)(a.ws + OFF_MO);
    unsigned char* H2 = a.ws + OFF_H2; float* RSTD = (float*)(a.ws + OFF_RSTD2);
    int* ENTE = (int*)(a.ws + OFF_ENTE); float* ENTG = (float*)(a.ws + OFF_ENTG); int* ENTR = (int*)(a.ws + OFF_ENTR); int* CNT = (int*)(a.ws + OFF_CNT);
    const int ti = lane & 31, kh = lane >> 5;
    for (int chunk = blockIdx.x; chunk < 256; chunk += G) {
        if (tid < 32) lcnt[tid] = 0;
        __syncthreads();
        {
            const int t0 = chunk * 256 + wave * 32;
            const float* xrow = X1 + (size_t)(t0 + ti) * DM + 512 * kh; const bf16* mrow = MO + (size_t)(t0 + ti) * DM + 512 * kh; unsigned char* hrow = H2 + (size_t)(t0 + ti) * DM + 512 * kh;
            const LAS float* wl = wrT + ti * 1028 + 512 * kh; const LAS float* gl = g2l + 512 * kh;
            f32x16 acc;
#pragma unroll
            for (int i = 0; i < 16; ++i) acc[i] = 0.f;
            float ssq = 0.f;
            f4 xc[16];
#define X1_LOAD(xr_, mr_, e0) do { _Pragma("unroll") for (int q = 0; q < 16; ++q) xr_[q] = *(const f4*)(xrow + (e0) + 4 * q); _Pragma("unroll") for (int q = 0; q < 8; ++q) mr_[q] = *(const v4u*)(mrow + (e0) + 8 * q); } while (0)
#define X1_ADD(dst, xr_, mr_) do { _Pragma("unroll") for (int q = 0; q < 8; ++q) { dst[2 * q].x = xr_[2 * q].x + bflo(mr_[q].x); dst[2 * q].y = xr_[2 * q].y + bfhi(mr_[q].x); dst[2 * q].z = xr_[2 * q].z + bflo(mr_[q].y); dst[2 * q].w = xr_[2 * q].w + bfhi(mr_[q].y); \
                dst[2 * q + 1].x = xr_[2 * q + 1].x + bflo(mr_[q].z); dst[2 * q + 1].y = xr_[2 * q + 1].y + bfhi(mr_[q].z); dst[2 * q + 1].z = xr_[2 * q + 1].z + bflo(mr_[q].w); dst[2 * q + 1].w = xr_[2 * q + 1].w + bfhi(mr_[q].w); } } while (0)
            { f4 x0[16]; v4u m0[8]; X1_LOAD(x0, m0, 0); X1_ADD(xc, x0, m0); }
#pragma unroll 1
            for (int c = 0; c < 8; ++c) {
                f4 xn[16]; v4u mn[8]; const int ne = 64 * (c < 7 ? c + 1 : 7);
                X1_LOAD(xn, mn, ne);
#pragma unroll
                for (int q4 = 0; q4 < 4; ++q4) { v4u hw;
#pragma unroll
                    for (int qq = 0; qq < 4; ++qq) { const int q = 4 * q4 + qq; const f4 w4 = *(const LAS f4*)(wl + 64 * c + 4 * q), g4 = *(const LAS f4*)(gl + 64 * c + 4 * q); const f4 x = xc[q];
                        acc = __builtin_amdgcn_mfma_f32_32x32x2f32(x.x, w4.x, acc, 0, 0, 0); acc = __builtin_amdgcn_mfma_f32_32x32x2f32(x.y, w4.y, acc, 0, 0, 0);
                        acc = __builtin_amdgcn_mfma_f32_32x32x2f32(x.z, w4.z, acc, 0, 0, 0); acc = __builtin_amdgcn_mfma_f32_32x32x2f32(x.w, w4.w, acc, 0, 0, 0);
                        ssq += (x.x * x.x + x.y * x.y) + (x.z * x.z + x.w * x.w);
                        hw[qq] = pk4_fp8(x.x * g4.x * FP8_ASCALE, x.y * g4.y * FP8_ASCALE, x.z * g4.z * FP8_ASCALE, x.w * g4.w * FP8_ASCALE); }
                    *(v4u*)(hrow + 64 * c + 16 * q4) = hw; }
                X1_ADD(xc, xn, mn);
            }
            ssq += __shfl_xor(ssq, 32);
            const float rstd = rsqrtf(ssq * (1.f / DM) + EPS);
            if (lane < 32) RSTD[t0 + lane] = rstd;
#pragma unroll
            for (int p = 0; p < 2; ++p) {
#pragma unroll
                for (int r8 = 0; r8 < 8; ++r8) { const int r = 8 * p + r8, rowl = (r & 3) + 8 * ((r >> 2) & 1) + 4 * kh; sc[rowl * 33 + ti] = acc[r]; }
                const float rs_t = __shfl(rstd, 16 * p + (lane & 15));
                if (lane < 16) {
                    float v[32];
#pragma unroll
                    for (int e = 0; e < 32; ++e) v[e] = sc[lane * 33 + e] * rs_t + br[e];
                    float tv[4]; int te[4];
#pragma unroll
                    for (int k = 0; k < 4; ++k) { float bv = v[0]; int be = 0;
#pragma unroll
                        for (int e = 1; e < 32; ++e) if (v[e] > bv) { bv = v[e]; be = e; }
                        tv[k] = bv; te[k] = be;
#pragma unroll
                        for (int e = 0; e < 32; ++e) v[e] = (e == be) ? -3.0e38f : v[e]; }
                    const float e1 = __expf(tv[1] - tv[0]), e2 = __expf(tv[2] - tv[0]), e3 = __expf(tv[3] - tv[0]), inv = __builtin_amdgcn_rcpf(1.f + e1 + e2 + e3);
                    const int tl = wave * 32 + 16 * p + lane, tt = chunk * 256 + tl;
                    *(int4*)(ENTE + (size_t)tt * 4) = make_int4(te[0], te[1], te[2], te[3]);
                    *(f4*)(ENTG + (size_t)tt * 4) = (f4){inv, e1 * inv, e2 * inv, e3 * inv};
                    *(LAS unsigned*)(le + tl * 4) = (unsigned)te[0] | ((unsigned)te[1] << 8) | ((unsigned)te[2] << 16) | ((unsigned)te[3] << 24);
                }
            }
        }
        __syncthreads();
#pragma unroll
        for (int q = 0; q < 2; ++q) { const int idx = tid + 512 * q; const int e = le[idx]; const int rk = __hip_atomic_fetch_add(&lcnt[e], 1, __ATOMIC_RELAXED, __HIP_MEMORY_SCOPE_WORKGROUP); ENTR[chunk * 1024 + idx] = rk; }
        __syncthreads();
        if (tid < 32) CNT[chunk * 32 + tid] = lcnt[tid];
        __syncthreads();
    }
}

__device__ __forceinline__ int wsum32(int v) { v += __shfl_xor(v, 1); v += __shfl_xor(v, 2); v += __shfl_xor(v, 4); v += __shfl_xor(v, 8); v += __shfl_xor(v, 16); return v; }
__device__ __forceinline__ int place_preamble(const KArgs& a, LAS unsigned char* L, bool write_tiles) {
    const int tid = otid();
    LAS int* tot = (LAS int*)L; LAS int* pst = tot + 64; LAS int* misc = pst + 96; LAS int* cntl = (LAS int*)(L + 1024);
    const int* CNT = (const int*)(a.ws + OFF_CNT); int* TILEE = (int*)(a.ws + OFF_TILEE); int* NTILE = (int*)(a.ws + OFF_NTILE);
    for (int i = tid; i < 8192; i += 512) cntl[i] = CNT[i];
    __syncthreads();
    if (tid < 64) { const int e = tid & 31;
        int all = 0; for (int c = 0; c < 256; ++c) all += cntl[c * 32 + e];
        int run = 0, best = 1 << 30, bestc = 192, bestrun = 0;
        for (int c = 0; c < 224; ++c) { run += cntl[c * 32 + e];
            if (c + 1 >= 160) { const int nA = wsum32((run + 255) >> 8), nB = wsum32((all - run + 255) >> 8);
                const int cost = ((nA + 31) >> 5) + ((nB + 31) >> 5) + ((nA + 63) >> 6) + ((nB + 63) >> 6);
                if (nA <= 800 && nB <= 544 && cost <= best) { best = cost; bestc = c + 1; bestrun = run; } } }
        if (best == (1 << 30)) { bestrun = 0; for (int c = 0; c < 192; ++c) bestrun += cntl[c * 32 + e]; }
        if (tid < 32) { tot[e] = bestrun; tot[32 + e] = all - bestrun; if (tid == 0) misc[0] = bestc; } }
    __syncthreads();
    if (tid < 2) { const int hf = tid; int run = 0;
        for (int e = 0; e < 32; ++e) { pst[hf * 32 + e] = run; run += ((tot[hf * 32 + e] + 255) >> 8) << 8; }
        misc[1 + hf] = run >> 8;
        if (write_tiles) { NTILE[hf] = run >> 8; if (hf == 0) NTILE[2] = misc[0]; } }
    __syncthreads();
    if (write_tiles) {
        for (int hf = 0; hf < 2; ++hf) for (int i = tid; i < misc[1 + hf]; i += 512) { int e = 0;
#pragma unroll
            for (int q = 1; q < 32; ++q) e = (pst[hf * 32 + q] <= (i << 8) && tot[hf * 32 + q] > 0) ? q : e;
            TILEE[hf * 1024 + i] = e; } }
    return misc[0];
}
__device__ __forceinline__ void phase8(const KArgs& a, LAS unsigned char* L, int G) {
    const int tid = otid();
    LAS int* tot = (LAS int*)L; LAS int* pst = tot + 64; LAS int* base = pst + 64; LAS int* cntl = (LAS int*)(L + 1024);
    const int* ENTE = (const int*)(a.ws + OFF_ENTE); const int* ENTR = (const int*)(a.ws + OFF_ENTR); const float* ENTG = (const float*)(a.ws + OFF_ENTG);
    int* SDEST = (int*)(a.ws + OFF_SDEST); float* RGATE = (float*)(a.ws + OFF_RGATE); int* ROWMAP = (int*)(a.ws + OFF_ROWMAP); float* RSTDS = (float*)(a.ws + OFF_RSTDS); const float* RSTD = (const float*)(a.ws + OFF_RSTD2);
    const int cA = place_preamble(a, L, blockIdx.x == 0);
    if (blockIdx.x == 0 && tid < 64) { const int hf = tid >> 5, t0 = tot[tid], p0 = pst[tid], pe = p0 + (((t0 + 255) >> 8) << 8);
        for (int r = p0 + t0; r < pe; ++r) { ROWMAP[hf * RCAP + r] = 0; RGATE[hf * RCAP + r] = 0.f; RSTDS[hf * RCAP + r] = 0.f; } }
    for (int chunk = blockIdx.x; chunk < 256; chunk += G) {
        const int hf = chunk >= cA ? 1 : 0;
        if (tid < 32) { int s = pst[hf * 32 + tid]; for (int c = hf ? cA : 0; c < chunk; ++c) s += cntl[c * 32 + tid]; base[tid] = s; }
        __syncthreads();
#pragma unroll
        for (int q = 0; q < 2; ++q) { const int gi = chunk * 1024 + tid + 512 * q; const int e = ENTE[gi]; const int d = base[e] + ENTR[gi]; SDEST[gi] = d; RGATE[hf * RCAP + d] = ENTG[gi]; ROWMAP[hf * RCAP + d] = gi >> 2; RSTDS[hf * RCAP + d] = RSTD[gi >> 2]; }
        __syncthreads();
    }
}

__device__ __forceinline__ void combine_half(const KArgs& a, int hf, const unsigned char* YS, int G) {
    const int tid = otid(), lane = tid & 63, wave = tid >> 6;
    const int gw = blockIdx.x * 8 + wave, NGW = G * 8;
    const int* SDEST = (const int*)(a.ws + OFF_SDEST); const float* gf = a.in[I_NFG];
    f4 gv[4];
#pragma unroll
    for (int j = 0; j < 4; ++j) gv[j] = ((const f4*)gf)[lane + 64 * j];
    const int cA = ((const int*)(a.ws + OFF_NTILE))[2], tbeg = hf ? cA * 256 : 0, tend = hf ? T : cA * 256;
    for (int t = tbeg + gw; t < tend; t += NGW) {
        f4* xr = (f4*)(a.out + (size_t)t * DM) + lane; const f4* xin = (const f4*)(a.in[I_X] + (size_t)t * DM) + lane; const v2u* mo8 = (const v2u*)((const bf16*)(a.ws + OFF_MO) + (size_t)t * DM) + lane;
        f4 v[4];
#pragma unroll
        for (int j = 0; j < 4; ++j) { v[j] = xin[64 * j]; const v2u w = mo8[64 * j]; v[j].x += bflo(w.x); v[j].y += bfhi(w.x); v[j].z += bflo(w.y); v[j].w += bfhi(w.y); }
#pragma unroll
        for (int k = 0; k < 4; ++k) { const int d = SDEST[t * 4 + k]; const unsigned* y4 = (const unsigned*)(YS + (size_t)d * DM) + lane;
#pragma unroll
            for (int j = 0; j < 4; ++j) { const int w = (int)y4[64 * j]; const f2 lo = __builtin_amdgcn_cvt_pk_f32_fp8(w, false), hi = __builtin_amdgcn_cvt_pk_f32_fp8(w, true);
                v[j].x += lo.x * (1.f / FP8_YSCALE); v[j].y += lo.y * (1.f / FP8_YSCALE); v[j].z += hi.x * (1.f / FP8_YSCALE); v[j].w += hi.y * (1.f / FP8_YSCALE); } }
        float ss = 0.f;
#pragma unroll
        for (int j = 0; j < 4; ++j) ss += (v[j].x * v[j].x + v[j].y * v[j].y) + (v[j].z * v[j].z + v[j].w * v[j].w);
        const float rstd = rsqrtf(wave_sum(ss) * (1.f / DM) + EPS);
#pragma unroll
        for (int j = 0; j < 4; ++j) xr[64 * j] = v[j] * rstd * gv[j];
    }
}

#define XB_TMO      128
#define XB_XCNT(j)  (256  + 64 * (j))
#define XB_XSUB(j)  (1280 + 64 * (j))
#define XB_XGEN(j)  (2304 + 64 * (j))
#define XB_TOP      3328
#define XB_TOPGEN   3392
#define XCD_BAR_WORDS 3456
#define XB_SPIN_CAP (1u << 18)

__device__ __forceinline__ unsigned xb_ld(unsigned* p)              { return __hip_atomic_load(p, __ATOMIC_RELAXED, __HIP_MEMORY_SCOPE_AGENT); }
__device__ __forceinline__ unsigned xb_add(unsigned* p, unsigned v) { return __hip_atomic_fetch_add(p, v, __ATOMIC_RELAXED, __HIP_MEMORY_SCOPE_AGENT); }
__device__ __forceinline__ unsigned xb_xcc_id() { return (unsigned)__builtin_amdgcn_s_getreg((3 << 11) | 20) & 0xFu; }
#define XB_SPIN(cond, bar) do { unsigned _sp = 0; while (cond) { __builtin_amdgcn_s_sleep(1); \
    if ((++_sp & 255u) == 0u) { if (xb_ld(&(bar)[XB_TMO])) break; if (_sp > XB_SPIN_CAP) { atomicAdd(&(bar)[XB_TMO], 1u); break; } } } } while (0)

struct XcdBarrier {
    unsigned* bar; unsigned x;
    volatile LAS unsigned* st;
};

__device__ __forceinline__ XcdBarrier xcd_barrier_post(unsigned* bar, volatile LAS unsigned* st) {
    XcdBarrier b; b.bar = bar; b.x = xb_xcc_id(); b.st = st;
    if (threadIdx.x == 0) (void)xb_add(&bar[XB_XCNT(b.x)], 1u);
    return b;
}
__device__ __forceinline__ void xcd_barrier_complete(unsigned* bar, unsigned x, unsigned& nloc, unsigned& nx) {
    const unsigned G = gridDim.x * gridDim.y * gridDim.z;
    unsigned sum, cnt, mine, sp = 0u;
    for (;;) {
        sum = 0u; cnt = 0u; mine = 0u;
#pragma unroll
        for (unsigned j = 0; j < 16; ++j) { const unsigned c = xb_ld(&bar[XB_XCNT(j)]); sum += c; cnt += (c > 0u) ? 1u : 0u; mine = (j == x) ? c : mine; }
        if (sum == G) break;
        __builtin_amdgcn_s_sleep(1);
        if ((++sp & 255u) == 0u) { if (xb_ld(&bar[XB_TMO])) break; if (sp > XB_SPIN_CAP) { atomicAdd(&bar[XB_TMO], 1u); break; } }
    }
    nloc = mine > 0u ? mine : 1u; nx = cnt > 0u ? cnt : 1u;
}

__device__ __forceinline__ void xcd_barrier(const XcdBarrier& b) {
    asm volatile("s_waitcnt vmcnt(0)" ::: "memory");
    __syncthreads();
    if (threadIdx.x == 0) {
        unsigned* bar = b.bar;
        __builtin_amdgcn_s_waitcnt(0);
        unsigned nloc = b.st[0], nx = b.st[1];
        if (nloc == 0u) { xcd_barrier_complete(bar, b.x, nloc, nx); b.st[0] = nloc; b.st[1] = nx; }
        const unsigned old = xb_add(&bar[XB_XSUB(b.x)], 1u);
        const unsigned gen = old / nloc;
        if (old + 1u == (gen + 1u) * nloc) {
            __builtin_amdgcn_fence(__ATOMIC_RELEASE, "agent");
            asm volatile("s_waitcnt vmcnt(0)" ::: "memory");
            const unsigned og = xb_add(&bar[XB_TOP], 1u);
            const unsigned tg = og / nx;
            if (og + 1u == (tg + 1u) * nx) xb_add(&bar[XB_TOPGEN], 1u);
            else XB_SPIN(xb_ld(&bar[XB_TOPGEN]) == tg, bar);
            __builtin_amdgcn_fence(__ATOMIC_ACQUIRE, "agent");
            xb_add(&bar[XB_XGEN(b.x)], 1u);
            asm volatile("s_waitcnt vmcnt(0)" ::: "memory");
        } else {
            XB_SPIN(xb_ld(&bar[XB_XGEN(b.x)]) == gen, bar);
            __builtin_amdgcn_fence(__ATOMIC_ACQUIRE, "agent");
            asm volatile("s_waitcnt vmcnt(0)" ::: "memory");
        }
    }
    __syncthreads();
}

#ifdef XCD_CONTIG
#define BX_EXPR ((int)blockIdx.x)
#else
#define BX_EXPR __builtin_amdgcn_readfirstlane((int)MISC[12])
#endif
#ifndef PROBE_MASK
#define PROBE_MASK 0u
#endif
#ifndef PROBE_REPS
#define PROBE_REPS 3
#endif
#ifndef MK_SINGLE
#define MK_SINGLE 1
#endif
__device__ __forceinline__ void touch_buffer(const unsigned char* p, size_t bytes, int G) {
    const size_t per = bytes / (size_t)G; const v4u* q = (const v4u*)(p + per * blockIdx.x) + otid();
    v4u acc = (v4u){0u, 0u, 0u, 0u};
    for (size_t i = 0; i < per / (512 * 16); i += 8) {
        v4u t[8];
#pragma unroll
        for (int k = 0; k < 8; ++k) t[k] = q[(i + k) * 512];
#pragma unroll
        for (int k = 0; k < 8; ++k) { acc.x |= t[k].x; acc.y |= t[k].y; acc.z |= t[k].z; acc.w |= t[k].w; }
    }
    asm volatile("" :: "v"(acc.x | acc.y | acc.z | acc.w));
}
typedef const __attribute__((address_space(4))) KArgs* KArgsP;
__device__ __forceinline__ KArgs kargs() {
#if defined(__HIP_DEVICE_COMPILE__)
    KArgsP p = (KArgsP)__builtin_amdgcn_kernarg_segment_ptr(); asm volatile("" : "+s"(p)); KArgs r; __builtin_memcpy(&r, (const __attribute__((address_space(4))) void*)p, sizeof(KArgs)); return r;
#else
    return KArgs{};
#endif
}
__global__ void __launch_bounds__(512, 2) mk_fwd(KArgs a_in) {
    extern __shared__ __attribute__((aligned(16))) unsigned char lds_raw[];
    LAS unsigned char* L = (LAS unsigned char*)lds_raw;
    cg::grid_group grid = cg::this_grid();
    const int ph_lo = a_in.ph_lo, ph_hi = a_in.ph_hi;
    volatile LAS unsigned* MISC = (volatile LAS unsigned*)(L + LDS_BYTES - 64);
    if (otid() < 16) MISC[otid()] = 0u;
    __syncthreads();
    XcdBarrier xbar = xcd_barrier_post((unsigned*)a_in.ws, MISC);
    if (otid() == 0) { MISC[10] = xb_add((unsigned*)a_in.ws + 3584 + 64 * (xbar.x & 7u), 1u); MISC[11] = xbar.x & 7u; MISC[12] = blockIdx.x; }
    __syncthreads();
#define IN(k) (ph_lo <= (k) && (k) < ph_hi)
#define SEAM(k) do { if (IN(k) && IN((k) + 1)) { if ((k) == 0) { grid.sync(); \
        if (otid() == 0) { bool ok = (gridDim.x == 256); for (int j_ = 0; j_ < 8; ++j_) ok = ok && (xb_ld((unsigned*)a_in.ws + 3584 + 64 * j_) == 32u); if (ok) MISC[12] = MISC[10] * 8u + MISC[11]; } __syncthreads(); } \
        else xcd_barrier(xbar); } } while (0)
#define PEND(k) do { if ((PROBE_MASK >> (k)) & 1u) { const unsigned long long t1_ = __builtin_amdgcn_s_memrealtime(); while (__builtin_amdgcn_s_memrealtime() < t1_ + (PROBE_REPS - 1) * (t1_ - t0_)) __builtin_amdgcn_s_sleep(8); } } while (0)
#define REP(k) for (int rep_ = 0, nrep_ = (((PROBE_MASK >> (k)) & 1u) ? PROBE_REPS : 1); rep_ < nrep_; ++rep_)
#define GBX const unsigned long long t0_ = PROBE_MASK ? __builtin_amdgcn_s_memrealtime() : 0ull; (void)t0_; const int G = gridDim.x, bx = BX_EXPR; const KArgs a = kargs(); unsigned char* ws = a.ws; (void)G; (void)bx; (void)ws
    if (IN(0)) { GBX; REP(0) phase0(a, L, G); }
    SEAM(0);
    if (IN(1)) { GBX; REP(1) {
        s5_expand(a, G);
        pg8::Gemm g{(const bf16*)(ws + OFF_H1), (const bf16*)(ws + OFF_WIN), 1024, 1024, 1024, nullptr, 0, 0}; pg8::StaticOrder S; S.init(T, 2560, G, bx);
        EpiInProj E{(bf16*)(ws + OFF_QK), (bf16*)(ws + OFF_V), (bf16*)(ws + OFF_O), (bf16*)(ws + OFF_UG)};
        pg8::gemm_phase<EpiInProj, pg8::StaticOrder, true, true, false, false, true, true>(L, g, S, E); }
    }
    SEAM(1);
    if (IN(2)) { GBX;
        REP(16) for (int item = bx; item < 2048; item += G) mlstm_state_item(a, L, item);
        pg8::Gemm g{(const bf16*)(ws + OFF_UG) + 128, (const bf16*)(ws + OFF_S5P), 1152, 1024, 1024, nullptr, 0, 0}; S5EOrder S{G, bx};
        EpiS5E E{(float*)(ws + OFF_S5E)};
        REP(17) pg8::gemm_phase<EpiS5E, S5EOrder, true, true>(L, g, S, E);
    }
    SEAM(2);
    if (IN(3)) { GBX; REP(3) phase3(a, L, G); }
    SEAM(3);
    if (IN(4)) { GBX;
        REP(18) { int h_loaded = -1; KvRaw Ra, Rb;
            if (bx < 2048) { const int it0 = bx, c0 = it0 & 63, bh0 = it0 >> 6; const bf16* q0 = (const bf16*)(ws + OFF_QK) + (size_t)((bh0 >> 2) * SEQ) * 1024 + (bh0 & 3) * 128; const int s_ = otid() >> 3, col_ = (otid() & 7) * 16;
                kq_load(Ra, q0, c0 * 128 + s_, col_); kq_load(Rb, q0, c0 * 128 + 64 + s_, col_); }
            for (int item = bx; item < 2048; item += G) mlstm_out_item(a, L, item, item + G < 2048 ? item + G : item, Ra, Rb, h_loaded); }
        pg8::Gemm g{(const bf16*)(ws + OFF_UG), (const bf16*)(ws + OFF_S5M), 1152, 1152, 1152, nullptr, 0, 0}; S5YOrder S{G, bx};
        EpiS5Y E{(const bf16*)(ws + OFF_UG), a.in[I_DSKIP], (bf16*)(ws + OFF_YSG)};
        REP(19) pg8::gemm_phase<EpiS5Y, S5YOrder, true, true>(L, g, S, E);
    }
    SEAM(4);
    if (IN(5)) { GBX; REP(5) {
        pg8::Gemm g{(const bf16*)(ws + OFF_YSG), (const bf16*)(ws + OFF_WGLU), 512, 512, 512, nullptr, 0, 0}; pg8::StaticOrder S; S.init(T, 512, G, bx);
        EpiGlu E{(const bf16*)(ws + OFF_YSG), a.in[I_BGLU], (bf16*)(ws + OFF_H1)};
        pg8::gemm_phase<EpiGlu, pg8::StaticOrder, true, true>(L, g, S, E); }
    }
    SEAM(5);
    if (IN(6)) { GBX; REP(6) {
        pg8::Gemm g{(const bf16*)(ws + OFF_H1), (const bf16*)(ws + OFF_WOUT), 1024, 1024, 1024, nullptr, 0, 0}; pg8::StaticOrder S; S.init(T, 1024, G, bx);
        EpiOut E{(bf16*)(ws + OFF_MO)};
        pg8::gemm_phase<EpiOut, pg8::StaticOrder, true, true>(L, g, S, E); }
    }
    SEAM(6);
    if (IN(7)) { GBX; REP(7) phase7(a, L, G); }
    SEAM(7);
    if (IN(8)) { GBX; REP(8) phase8(a, L, G); }
    SEAM(8);
#pragma unroll 1
    for (int hf = 0; hf < 2; ++hf) {
        const int pb = 9 + 2 * hf;
        if (IN(pb)) { GBX;
            const int ntile = ((const int*)(ws + OFF_NTILE))[hf];
            pg8::Gemm g{(const bf16*)(ws + OFF_H2), (const bf16*)(ws + OFF_WGU), 1024, 1024, 1024, (const int*)(ws + OFF_ROWMAP) + hf * RCAP, 0, 0}; MoeOrder S{(const int*)(ws + OFF_TILEE) + hf * 1024, ntile, 8, G, bx, (unsigned*)ws + 4096 + 512 * (2 * hf)};
            EpiMoeGU E{a.in[I_BGU], ws + OFF_R1, (const float*)(ws + OFF_RSTDS) + hf * RCAP};
#ifdef TOUCH_WGU
            touch_buffer(ws + OFF_WGU, (size_t)134217728, G);
#endif
            REP(pb) pg8::gemm_phase<EpiMoeGU, MoeOrder, true, true, true, true, false, true>(L, g, S, E);
        }
        if (IN(pb) && hf == 1) { GBX; combine_half(a, 0, ws + OFF_R2, G); PEND(pb); }
        SEAM(pb);
        if (IN(pb + 1)) { GBX;
            const int ntile = ((const int*)(ws + OFF_NTILE))[hf];
            pg8::Gemm g{(const bf16*)(ws + OFF_R1), (const bf16*)(ws + OFF_WDN), 1024, 1024, 1024, nullptr, 1, 1}; MoeOrder S{(const int*)(ws + OFF_TILEE) + hf * 1024, ntile, 4, G, bx, (unsigned*)ws + 4096 + 512 * (2 * hf + 1)};
            EpiMoeDN E{a.in[I_BDN], (const float*)(ws + OFF_RGATE) + hf * RCAP, ws + OFF_R2};
            REP(pb + 1) pg8::gemm_phase<EpiMoeDN, MoeOrder, true, true, false, true, true, true>(L, g, S, E);
        }
        SEAM(pb + 1);
    }
    if (IN(13)) { GBX; combine_half(a, 1, ws + OFF_R2, G); PEND(13); }
    if (PROBE_SECT && blockIdx.x == 0 && otid() == 0) { const unsigned long long t1_ = __builtin_amdgcn_s_memrealtime(), w_ = (unsigned long long)(*PROBE_LDS_WORD) * PROBE_SCALE; while (__builtin_amdgcn_s_memrealtime() - t1_ < w_) __builtin_amdgcn_s_sleep(8); }
#undef IN
#undef SEAM
#undef GBX
#undef PEND
#undef REP
}

extern "C" void kernel_launch(void* const* d_in, const int* in_sizes, int n_in, void* d_out, int out_size, void* d_ws, size_t ws_size, hipStream_t stream) {
    static int grid = 0;
    if (grid == 0) {
        if (n_in != 26 || out_size != T * DM || ws_size < WS_NEED) { fprintf(stderr, "kernel_launch: unexpected problem (n_in %d, out %d, ws %zu)\n", n_in, out_size, ws_size); grid = -1; return; }
        int dev = 0, cus = 0, per_cu = 0;
        (void)hipGetDevice(&dev); (void)hipDeviceGetAttribute(&cus, hipDeviceAttributeMultiprocessorCount, dev);
        if (hipFuncSetAttribute((const void*)mk_fwd, hipFuncAttributeMaxDynamicSharedMemorySize, LDS_BYTES) != hipSuccess) { fprintf(stderr, "kernel_launch: hipFuncSetAttribute failed\n"); grid = -1; return; }
        if (hipOccupancyMaxActiveBlocksPerMultiprocessor(&per_cu, (const void*)mk_fwd, 512, LDS_BYTES) != hipSuccess || per_cu < 1) { fprintf(stderr, "kernel_launch: occupancy query says %d\n", per_cu); per_cu = 1; }
        (void)hipGetLastError();
        grid = cus;
    }
    if (grid < 0) return;
    if (hipMemsetAsync(d_ws, 0, 32768, stream) != hipSuccess) { fprintf(stderr, "kernel_launch: memset failed\n"); return; }
    KArgs a{};
    for (int i = 0; i < 26; ++i) a.in[i] = (const float*)d_in[i];
    a.out = (float*)d_out; a.ws = (unsigned char*)d_ws;
#if MK_SINGLE
    a.ph_lo = 0; a.ph_hi = NPH;
    void* args[] = {&a};
    hipError_t e = hipLaunchCooperativeKernel((const void*)mk_fwd, dim3(grid), dim3(512), args, LDS_BYTES, stream);
    if (e != hipSuccess) fprintf(stderr, "cooperative launch failed: %s (grid %d)\n", hipGetErrorString(e), grid);
#else
    for (int p = 0; p < NPH; ++p) { a.ph_lo = p; a.ph_hi = p + 1; hipLaunchKernelGGL(mk_fwd, dim3(grid), dim3(512), LDS_BYTES, stream, a); }
#endif
}
```

```cpp
#define XCD_RANGE 1
#include <hip/hip_runtime.h>
#include <hip/hip_cooperative_groups.h>
#include <cstdio>
#include <cstdint>
namespace cg = cooperative_groups;
__device__ __forceinline__ int otid() { int t = (int)threadIdx.x; asm volatile("" : "+v"(t)); return t; }

#ifndef PROBE_SECT
#define PROBE_SECT 0
#endif
#ifndef PROBE_SCALE
#define PROBE_SCALE 16
#endif
#define PROBE_LDS_WORD ((volatile __attribute__((address_space(3))) unsigned*)(155648 - 32))
#define TIC(id) unsigned long long tic_##id = 0; if (PROBE_SECT == (id)) { __builtin_amdgcn_sched_barrier(0); tic_##id = __builtin_amdgcn_s_memrealtime(); __builtin_amdgcn_sched_barrier(0); }
#define TOC(id) if (PROBE_SECT == (id)) { __builtin_amdgcn_sched_barrier(0); asm volatile("s_waitcnt vmcnt(0) lgkmcnt(0)" ::: "memory"); const unsigned d_ = (unsigned)(__builtin_amdgcn_s_memrealtime() - tic_##id); if (blockIdx.x == 0 && threadIdx.x == 0) *PROBE_LDS_WORD += d_; __builtin_amdgcn_sched_barrier(0); }
namespace pg8 {
#define PG8_LAS __attribute__((address_space(3)))
typedef unsigned short bf16_t;
typedef short bf16x8 __attribute__((ext_vector_type(8)));
typedef float f32x4 __attribute__((ext_vector_type(4)));
typedef unsigned u32x4 __attribute__((ext_vector_type(4)));
typedef long lx2 __attribute__((ext_vector_type(2)));
constexpr int BM = 256, BK = 64, HALF = 128, HTB = HALF * BK * 2  , STAGE_BYTES = 8 * HTB, NXCD = 8, WGM = 8;

__host__ __device__ __forceinline__ int lds_byte(int r, int c) { const int st = (r >> 4) * 2 + (c >> 5), rr = r & 15, cc = c & 31, ob = rr * 64 + cc * 2; return st * 1024 + (ob ^ (((ob >> 9) & 1) << 5)); }
__host__ __device__ __forceinline__ void stage_rc(int b, int& R, int& C) { const int st = b / 1024, sb = b % 1024, swz = sb ^ (((sb >> 9) & 1) << 5); R = (st >> 1) * 16 + swz / 64; C = (st & 1) * 32 + (swz % 64) / 2; }
__host__ __device__ __forceinline__ int perm32(int rho) { const int n = rho >> 4, i = rho & 15; return 8 * (i >> 2) + 4 * n + (i & 3); }

struct Unit { int pm, pn, rd, nt; };
struct Gemm { const bf16_t* A; const bf16_t* Bt; int lda, ldb, K; const int* rowmap; int blkA, blkB; };

struct StaticOrder {
    int nM, nN, nwg, G, c;
    __host__ __device__ void init(int M, int N, int G_, int c_) { nM = M / BM; nN = N / BM; nwg = nM * nN; G = G_; c = c_; }
    __host__ __device__ bool next(int i, Unit& u) const {
        const long L = (long)i * G + c; if (L >= nwg) return false;
        int wgid = (int)L; { const int q = nwg / NXCD, r = nwg % NXCD, xcd = wgid % NXCD, off = wgid / NXCD; wgid = (xcd < r ? xcd * (q + 1) : r * (q + 1) + (xcd - r) * q) + off; }
        const int nig = WGM * nN, gid = wgid / nig, fm = gid * WGM, gsz = (nM - fm) < WGM ? (nM - fm) : WGM;
        u.pm = fm + ((wgid % nig) % gsz); u.pn = (wgid % nig) / gsz; u.rd = 0; u.nt = 0; return true;
    }
    __device__ __forceinline__ void a_ready(const Unit&) const {}
    __device__ __forceinline__ void done(const Unit&) const {}
};

__device__ __forceinline__ unsigned cvt_pk_bf16(float lo, float hi) { unsigned r; asm volatile("v_cvt_pk_bf16_f32 %0, %1, %2" : "=v"(r) : "v"(lo), "v"(hi)); return r; }

template <class Epi, class Sched, bool ALIGN_EPI = false, bool SP2 = false, bool GATHER = false, bool FP8 = false, bool BLKA = false, bool BLKB = false>
__device__ __forceinline__ void gemm_phase(PG8_LAS unsigned char* lds, const Gemm g, const Sched& S, const Epi& E) {
    const int tid = otid(), wid = __builtin_amdgcn_readfirstlane(tid >> 6), lane = tid & 63, wr = wid >> 2, wc = wid & 3, fr = lane & 15, fq = lane >> 4;
    const int K = g.K, nt = FP8 ? K / 128 : K / BK;
    const unsigned ldaB = BLKA ? 128u : (FP8 ? (unsigned)g.lda : 2u * (unsigned)g.lda), ldbB = BLKB ? 128u : (FP8 ? (unsigned)g.ldb : 2u * (unsigned)g.ldb);
    unsigned voffA[2], voffB[2];
#pragma unroll
    for (int i = 0; i < 2; ++i) { int R, C; stage_rc(tid * 16 + i * 8192, R, C); const int Rb = Epi::PERM ? ((R & ~31) + perm32(R & 31)) : R;
        voffA[i] = (unsigned)R * ldaB + 2u * (unsigned)C; voffB[i] = (unsigned)Rb * ldbB + 2u * (unsigned)C; }
    int gR0, gC0; stage_rc(tid * 16, gR0, gC0);
    const unsigned gRowBytes = ldaB, gColBytes = (unsigned)gC0 * 2u;
    unsigned offC[2][2], offN[2][2];
#define PG8_GOFF(dst, pm) do { if constexpr (GATHER) { _Pragma("unroll") for (int _h = 0; _h < 2; ++_h) _Pragma("unroll") for (int _i = 0; _i < 2; ++_i) \
        dst[_h][_i] = (unsigned)g.rowmap[(pm) * BM + _h * HALF + _i * 64 + gR0] * gRowBytes + gColBytes; } } while (0)
    constexpr size_t kstepA = BLKA ? (size_t)32768 : (size_t)128, kstepB = BLKB ? (size_t)32768 : (size_t)128;
    const size_t hstepA = (size_t)HALF * ldaB, hstepB = (size_t)HALF * ldbB;
    const size_t tstepA = BLKA ? (size_t)nt * 32768 : 2 * hstepA, tstepB = BLKB ? (size_t)nt * 32768 : 2 * hstepB;
    const unsigned ldsw = (unsigned)wid * 1024u;
    const int aoff = lds_byte(wr * 64 + fr, fq * 8), boff = lds_byte(wc * 32 + fr, fq * 8);
#define PG8_SA(b, h) (((b) * 2 + (h)) * HTB)
#define PG8_SB(b, h) ((4 + (b) * 2 + (h)) * HTB)
#ifndef PG8_AUX
#define PG8_AUX 0
#endif
#define PG8_STAGE(bufoff, gbase, voff) do { _Pragma("unroll") for (int _i = 0; _i < 2; ++_i) \
        __builtin_amdgcn_global_load_lds((const unsigned*)((const char*)(gbase) + (voff)[_i]), (PG8_LAS unsigned*)(lds + (bufoff) + ldsw + _i * 8192), 16, 0, FP8 ? PG8_AUX : 0); } while (0)
#define PG8_LDA(dst, b, h) do { _Pragma("unroll") for (int m = 0; m < 4; ++m) _Pragma("unroll") for (int k = 0; k < 2; ++k) dst[m][k] = *(const PG8_LAS bf16x8*)(lds + PG8_SA(b, h) + aoff + m * 2048 + k * 1024); } while (0)
#define PG8_LDB(dst, b, h) do { _Pragma("unroll") for (int n = 0; n < 2; ++n) _Pragma("unroll") for (int k = 0; k < 2; ++k) dst[n][k] = *(const PG8_LAS bf16x8*)(lds + PG8_SB(b, h) + boff + n * 2048 + k * 1024); } while (0)
#define PG8_MMA(ai, bj, At, Bt) do { __builtin_amdgcn_s_setprio(1); _Pragma("unroll") for (int m = 0; m < 4; ++m) _Pragma("unroll") for (int n = 0; n < 2; ++n) _Pragma("unroll") for (int k = 0; k < 2; ++k) { \
        if constexpr (FP8) { const lx2 a_ = __builtin_bit_cast(lx2, At[m][k]), b_ = __builtin_bit_cast(lx2, Bt[n][k]);        \
            acc[ai][bj][m][n] = __builtin_amdgcn_mfma_f32_16x16x32_fp8_fp8(b_.x, a_.x, acc[ai][bj][m][n], 0, 0, 0); acc[ai][bj][m][n] = __builtin_amdgcn_mfma_f32_16x16x32_fp8_fp8(b_.y, a_.y, acc[ai][bj][m][n], 0, 0, 0); } \
        else acc[ai][bj][m][n] = __builtin_amdgcn_mfma_f32_16x16x32_bf16(Bt[n][k], At[m][k], acc[ai][bj][m][n], 0, 0, 0); } __builtin_amdgcn_s_setprio(0); } while (0)
#define PG8_WAIT_V(n) asm volatile("s_waitcnt vmcnt(" #n ")" ::: "memory")
#define PG8_WAIT_L(n) asm volatile("s_waitcnt lgkmcnt(" #n ")" ::: "memory")
#define PG8_BAR __builtin_amdgcn_s_barrier()
#define PG8_SCHED __builtin_amdgcn_sched_barrier(0)
    Unit cur, nxt; int ui = 0;
    if (!S.next(0, cur)) return;
    f32x4 acc[2][2][4][2];
#pragma unroll
    for (int a = 0; a < 2; ++a)
#pragma unroll
        for (int b = 0; b < 2; ++b)
#pragma unroll
            for (int m = 0; m < 4; ++m)
#pragma unroll
                for (int n = 0; n < 2; ++n) acc[a][b][m][n] = (f32x4){0.f, 0.f, 0.f, 0.f};
    bf16x8 At[4][2], B0[2][2], B1[2][2];
    const char* cA = (const char*)g.A + (size_t)cur.pm * tstepA; const char* cB = (const char*)g.Bt + (size_t)cur.pn * tstepB;
    S.a_ready(cur);
    const char* gA = (const char*)g.A;
    PG8_GOFF(offC, cur.pm);
#define PG8_STAGE_A(bufoff, h, ptr_plain, kt, offs) do { if constexpr (GATHER) PG8_STAGE(bufoff, gA + (size_t)(kt) * kstepA, (offs)[h]); else PG8_STAGE(bufoff, ptr_plain, voffA); } while (0)
    if constexpr (SP2) {
        PG8_STAGE(PG8_SB(0, 0), cB, voffB); PG8_STAGE(PG8_SB(0, 1), cB + hstepB, voffB); PG8_STAGE_A(PG8_SA(0, 0), 0, cA, 0, offC); PG8_STAGE_A(PG8_SA(0, 1), 1, cA + hstepA, 0, offC);
        if (wr == 1) PG8_BAR;
        PG8_WAIT_V(2); PG8_BAR;
        PG8_STAGE(PG8_SB(1, 0), cB + kstepB, voffB); PG8_STAGE_A(PG8_SA(1, 0), 0, cA + kstepA, 1, offC); PG8_STAGE(PG8_SB(1, 1), cB + hstepB + kstepB, voffB);
        PG8_WAIT_V(6); PG8_BAR;
    } else {
        PG8_STAGE(PG8_SB(0, 0), cB, voffB); PG8_STAGE(PG8_SA(0, 0), cA, voffA); PG8_STAGE(PG8_SB(0, 1), cB + hstepB, voffB); PG8_STAGE(PG8_SA(0, 1), cA + hstepA, voffA);
        if (wr == 1) PG8_BAR;
        PG8_WAIT_V(4); PG8_BAR;
        PG8_STAGE(PG8_SB(1, 0), cB + kstepB, voffB); PG8_STAGE(PG8_SA(1, 0), cA + kstepA, voffA); PG8_STAGE(PG8_SB(1, 1), cB + hstepB + kstepB, voffB);
        PG8_WAIT_V(6); PG8_BAR;
    }
    for (;;) {
        const bool has_next = S.next(ui + 1, nxt);
        if constexpr (GATHER) { if (has_next) PG8_GOFF(offN, nxt.pm); else { _Pragma("unroll") for (int _h = 0; _h < 2; ++_h) _Pragma("unroll") for (int _i = 0; _i < 2; ++_i) offN[_h][_i] = offC[_h][_i]; } }
        const char* nA = has_next ? (const char*)g.A + (size_t)nxt.pm * tstepA : cA; const char* nB = has_next ? (const char*)g.Bt + (size_t)nxt.pn * tstepB : cB;
#ifndef PROBE_KREP_G
#define PROBE_KREP_G 1
#endif
#ifndef PROBE_KREP_N
#define PROBE_KREP_N 1
#endif
#ifndef PROBE_KREP_D
#define PROBE_KREP_D 1
#endif
        constexpr int KREP = GATHER ? PROBE_KREP_G : (FP8 ? PROBE_KREP_D : PROBE_KREP_N);
        TIC(21)
        for (int pass = 0; pass < KREP; ++pass) {
        const bool fpass = (pass == KREP - 1);
        if (KREP > 1 && pass > 0) {
#pragma unroll
            for (int a = 0; a < 2; ++a)
#pragma unroll
                for (int b = 0; b < 2; ++b)
#pragma unroll
                    for (int m = 0; m < 4; ++m)
#pragma unroll
                        for (int n = 0; n < 2; ++n) acc[a][b][m][n] = (f32x4){0.f, 0.f, 0.f, 0.f}; }
        const int ntc = cur.nt > 0 ? cur.nt : nt;
        for (int t = 0; t < ntc; t += 2) {
            const bool lastk = (t == ntc - 2), last = lastk && fpass;
#ifdef PROBE_SHARED
            const char* xA = (!fpass && FP8 && !GATHER) ? (const char*)g.A + (size_t)(cur.pm & ~7) * tstepA : cA; const char* xB = (!fpass && FP8 && !GATHER) ? (const char*)g.Bt + (size_t)(cur.pn & ~3) * tstepB : cB;
#else
            const char* xA = cA; const char* xB = cB;
#endif
            const char* a1 = xA + (size_t)(t + 1) * kstepA;
            const char* a2 = lastk ? (fpass ? nA : cA) : xA + (size_t)(t + 2) * kstepA; const char* b2 = lastk ? (fpass ? nB : cB) : xB + (size_t)(t + 2) * kstepB;
            const char* a3 = a2 + kstepA; const char* b3 = b2 + kstepB;
            if (last && has_next) S.a_ready(nxt);
            if constexpr (SP2) {
            const int k2 = lastk ? 0 : t + 2;
            unsigned offS[2][2];
            if constexpr (GATHER) { _Pragma("unroll") for (int _h = 0; _h < 2; ++_h) _Pragma("unroll") for (int _i = 0; _i < 2; ++_i) offS[_h][_i] = last ? offN[_h][_i] : offC[_h][_i]; }
            PG8_LDB(B0, 0, 0); PG8_LDB(B1, 0, 1); PG8_SCHED; PG8_LDA(At, 0, 0); PG8_STAGE_A(PG8_SA(1, 1), 1, a1 + hstepA, t + 1, offC);
            PG8_WAIT_V(8); PG8_WAIT_L(0); PG8_BAR; PG8_MMA(0, 0, At, B0); PG8_MMA(0, 1, At, B1); PG8_BAR; PG8_SCHED;
            PG8_LDA(At, 0, 1); PG8_STAGE(PG8_SB(0, 0), b2, voffB); PG8_STAGE(PG8_SB(0, 1), b2 + hstepB, voffB); PG8_STAGE_A(PG8_SA(0, 0), 0, a2, k2, offS);
            PG8_WAIT_V(8); PG8_WAIT_L(0); PG8_BAR; PG8_MMA(1, 0, At, B0); PG8_MMA(1, 1, At, B1); PG8_BAR; PG8_SCHED;
            PG8_LDB(B0, 1, 0); PG8_LDB(B1, 1, 1); PG8_SCHED; PG8_LDA(At, 1, 0); PG8_STAGE_A(PG8_SA(0, 1), 1, a2 + hstepA, k2, offS);
            PG8_WAIT_V(8); PG8_WAIT_L(0); PG8_BAR; PG8_MMA(0, 0, At, B0); PG8_MMA(0, 1, At, B1); PG8_BAR; PG8_SCHED;
            PG8_LDA(At, 1, 1); PG8_STAGE(PG8_SB(1, 0), b3, voffB); PG8_STAGE(PG8_SB(1, 1), b3 + hstepB, voffB); PG8_STAGE_A(PG8_SA(1, 0), 0, a3, k2 + 1, offS);
            PG8_WAIT_V(8); PG8_WAIT_L(0); PG8_BAR; PG8_MMA(1, 0, At, B0); PG8_MMA(1, 1, At, B1); PG8_BAR; PG8_SCHED;
            } else {
            PG8_LDB(B0, 0, 0); PG8_SCHED; PG8_LDA(At, 0, 0); PG8_STAGE(PG8_SA(1, 1), a1 + hstepA, voffA);
            PG8_WAIT_L(8); PG8_BAR; PG8_WAIT_L(0); PG8_MMA(0, 0, At, B0); PG8_BAR; PG8_SCHED;
            PG8_LDB(B1, 0, 1); PG8_STAGE(PG8_SB(0, 0), b2, voffB);
            PG8_BAR; PG8_WAIT_L(0); PG8_MMA(0, 1, At, B1); PG8_BAR;
            PG8_LDA(At, 0, 1); PG8_STAGE(PG8_SA(0, 0), a2, voffA);
            PG8_BAR; PG8_WAIT_L(0); PG8_MMA(1, 0, At, B0); PG8_BAR; PG8_SCHED;
            PG8_STAGE(PG8_SB(0, 1), b2 + hstepB, voffB);
            PG8_WAIT_V(6); PG8_BAR; PG8_MMA(1, 1, At, B1); PG8_BAR;
            PG8_LDB(B0, 1, 0); PG8_SCHED; PG8_LDA(At, 1, 0); PG8_STAGE(PG8_SA(0, 1), a2 + hstepA, voffA);
            PG8_WAIT_L(8); PG8_BAR; PG8_WAIT_L(0); PG8_MMA(0, 0, At, B0); PG8_BAR; PG8_SCHED;
            PG8_LDB(B1, 1, 1); PG8_STAGE(PG8_SB(1, 0), b3, voffB);
            PG8_BAR; PG8_WAIT_L(0); PG8_MMA(0, 1, At, B1); PG8_BAR;
            PG8_LDA(At, 1, 1); PG8_STAGE(PG8_SA(1, 0), a3, voffA);
            PG8_BAR; PG8_WAIT_L(0); PG8_MMA(1, 0, At, B0); PG8_BAR; PG8_SCHED;
            PG8_STAGE(PG8_SB(1, 1), b3 + hstepB, voffB);
            PG8_WAIT_V(6); PG8_BAR; PG8_MMA(1, 1, At, B1); PG8_BAR;
            }
        }
        }
        if (FP8) { TOC(21) }
        if constexpr (ALIGN_EPI) { if (wr == 0) PG8_BAR; }
        TIC(22)
        E(acc, cur, wr, wc, fr, fq); S.done(cur);
        if (FP8) { TOC(22) }
        if (!has_next) break;
#pragma unroll
        for (int a = 0; a < 2; ++a)
#pragma unroll
            for (int b = 0; b < 2; ++b)
#pragma unroll
                for (int m = 0; m < 4; ++m)
#pragma unroll
                    for (int n = 0; n < 2; ++n) acc[a][b][m][n] = (f32x4){0.f, 0.f, 0.f, 0.f};
        cur = nxt; cA = nA; cB = nB; ++ui;
        if constexpr (GATHER) { _Pragma("unroll") for (int _h = 0; _h < 2; ++_h) _Pragma("unroll") for (int _i = 0; _i < 2; ++_i) offC[_h][_i] = offN[_h][_i]; }
        if constexpr (ALIGN_EPI) { if (wr == 1) PG8_BAR; }
    }
    PG8_WAIT_V(0);
    if constexpr (!ALIGN_EPI) { if (wr == 0) PG8_BAR; }
    PG8_BAR;
#undef PG8_SA
#undef PG8_SB
#undef PG8_STAGE
#undef PG8_STAGE_A
#undef PG8_GOFF
#undef PG8_LDA
#undef PG8_LDB
#undef PG8_MMA
#undef PG8_WAIT_V
#undef PG8_WAIT_L
#undef PG8_BAR
#undef PG8_SCHED
}
}

#define LAS __attribute__((address_space(3)))
typedef unsigned short bf16;
typedef float f4 __attribute__((ext_vector_type(4)));
typedef float f2 __attribute__((ext_vector_type(2)));
typedef float f32x16 __attribute__((ext_vector_type(16)));
typedef short bf16x8 __attribute__((ext_vector_type(8)));
typedef unsigned v4u __attribute__((ext_vector_type(4)));
typedef unsigned v2u __attribute__((ext_vector_type(2)));

constexpr int T = 65536, DM = 1024, SEQ = 8192, NPROJ = 2568;
constexpr int NE = 32;
constexpr float EPS = 1e-6f;
constexpr int NPH = 14;
constexpr int RCAP = 229376;
constexpr int LDS_BYTES = 155648;

constexpr size_t MiB = (size_t)1 << 20;
constexpr size_t OFF_GATES = 1 * MiB, OFF_MLG = 3 * MiB, OFF_MLA = 3 * MiB + 16384, OFF_MLM = 3 * MiB + 32768;
constexpr size_t OFF_MLNP = 4 * MiB, OFF_MLN = 6 * MiB, OFF_KT = 8 * MiB, OFF_S5E = 10 * MiB, OFF_RSTD2 = 26 * MiB;
constexpr size_t OFF_ENTE = 27 * MiB, OFF_ENTG = 28 * MiB, OFF_ENTR = 29 * MiB, OFF_SDEST = 30 * MiB;
constexpr size_t OFF_CNT = 31 * MiB, OFF_TILEE = 31 * MiB + 65536, OFF_NTILE = 31 * MiB + 131072, OFF_RGATE = 32 * MiB;
constexpr size_t OFF_WIN = 64 * MiB, OFF_WGLU = 70 * MiB, OFF_WOUT = 71 * MiB, OFF_WGU = 74 * MiB, OFF_WDN = 202 * MiB;
constexpr size_t OFF_S5M = 266 * MiB, OFF_S5P = 338 * MiB, OFF_H1 = 354 * MiB, OFF_QK = 482 * MiB, OFF_V = 610 * MiB, OFF_O = 674 * MiB, OFF_UG = 738 * MiB, OFF_YSG = 810 * MiB;
constexpr size_t OFF_H2 = 266 * MiB, OFF_R1 = 394 * MiB, OFF_R2 = 620 * MiB, WS_NEED = 1002 * MiB;
constexpr size_t OFF_MO = 874 * MiB;
constexpr size_t OFF_ROWMAP = 34 * MiB, OFF_RSTDS = 36 * MiB;
constexpr size_t OFF_QC = 874 * MiB, OFF_VT = 938 * MiB, OFF_KCTW = 810 * MiB;
constexpr size_t OUT_UP = 0, OUT_CST = 134217728;

struct KArgs { const float* in[26]; float* out; unsigned char* ws; int ph_lo, ph_hi; };
enum { I_X = 0, I_N1G, I_WIN, I_BIF, I_CONVW, I_CONVB, I_HNG, I_LRE, I_LIM, I_LDT, I_BRE, I_BIM, I_CRE, I_CIM, I_DSKIP, I_WGLU, I_BGLU, I_WOUT, I_N2G, I_WR, I_BR, I_WGU, I_BGU, I_WDN, I_BDN, I_NFG };

typedef float f32x2_t_ __attribute__((ext_vector_type(2))); typedef __bf16 bf16x2_t_ __attribute__((ext_vector_type(2)));
__device__ __forceinline__ unsigned f2bf(float f) { const f32x2_t_ v = {f, 0.f}; const bf16x2_t_ b = __builtin_convertvector(v, bf16x2_t_); return __builtin_bit_cast(unsigned, b) & 0xffffu; }
typedef float f32x2_t __attribute__((ext_vector_type(2))); typedef __bf16 bf16x2_t __attribute__((ext_vector_type(2)));
__device__ __forceinline__ unsigned pk2(float lo, float hi) { const f32x2_t v = {lo, hi}; const bf16x2_t b = __builtin_convertvector(v, bf16x2_t); return __builtin_bit_cast(unsigned, b); }
__device__ __forceinline__ unsigned pk4_fp8(float a, float b, float c, float d) { int r = 0; r = __builtin_amdgcn_cvt_pk_fp8_f32(a, b, r, false); r = __builtin_amdgcn_cvt_pk_fp8_f32(c, d, r, true); return (unsigned)r; }
constexpr float FP8_WSCALE = 64.f, FP8_ASCALE = 4.f, FP8_YSCALE = 16.f;
__device__ __forceinline__ float bf2f(unsigned b) { return __builtin_bit_cast(float, b << 16); }
__device__ __forceinline__ float bflo(unsigned w) { return __builtin_bit_cast(float, w << 16); }
__device__ __forceinline__ float bfhi(unsigned w) { return __builtin_bit_cast(float, w & 0xffff0000u); }
__device__ __forceinline__ float wave_sum(float v) {
#pragma unroll
    for (int o = 1; o < 64; o <<= 1) v += __shfl_xor(v, o);
    return v;
}
__device__ __forceinline__ float wave_max(float v) {
#pragma unroll
    for (int o = 1; o < 64; o <<= 1) v = fmaxf(v, __shfl_xor(v, o));
    return v;
}
__device__ __forceinline__ float sigmoidf_(float x) { return __builtin_amdgcn_rcpf(1.f + __expf(-x)); }
__device__ __forceinline__ float siluf_(float x) { return x * __builtin_amdgcn_rcpf(1.f + __expf(-x)); }
__device__ __forceinline__ float logsigmoidf_(float x) { return x >= 0.f ? -log1pf(expf(-x)) : x - log1pf(expf(x)); }
__device__ __forceinline__ float gelu_tanh(float x) { const float z = 0.7978845608028654f * (x + 0.044715f * x * x * x); const float e = __expf(2.f * z); return 0.5f * x * (2.f - 2.f * __builtin_amdgcn_rcpf(e + 1.f)); }
#define LDS_WAIT() asm volatile("s_waitcnt lgkmcnt(0)" ::: "memory")

struct TrLoc { const float* src; bf16* dst; int ldw, ldt; int fp8; int blk_n; };
__device__ __forceinline__ void tr_load(const TrLoc& t, int lane, float (&v)[32]) {
    unsigned off = (unsigned)((lane >> 5) * t.ldw + (lane & 31)) * 4u; const unsigned st = 8u * (unsigned)t.ldw;
#pragma unroll
    for (int i = 0; i < 32; ++i) { v[i] = *(const float*)((const char*)t.src + off); off += st; }
}
__device__ __forceinline__ void tr_finish(const TrLoc& t, LAS float* scr, int lane, const float (&v)[32]) {
#pragma unroll
    for (int i = 0; i < 32; ++i) scr[(2 * i + (lane >> 5)) * 33 + (lane & 31)] = v[i];
    LDS_WAIT(); asm volatile("" ::: "memory");
    const int c = lane & 7;
    if (t.fp8) {
#pragma unroll
        for (int j = 0; j < 4; ++j) { const int n = (lane >> 3) + 8 * j; const LAS float* s = scr + (8 * c) * 33 + n;
            v2u o; o.x = pk4_fp8(s[0 * 33] * FP8_WSCALE, s[1 * 33] * FP8_WSCALE, s[2 * 33] * FP8_WSCALE, s[3 * 33] * FP8_WSCALE); o.y = pk4_fp8(s[4 * 33] * FP8_WSCALE, s[5 * 33] * FP8_WSCALE, s[6 * 33] * FP8_WSCALE, s[7 * 33] * FP8_WSCALE);
            *(v2u*)((unsigned char*)t.dst + (size_t)n * t.ldt + 8 * c) = o; }
    } else {
#pragma unroll
        for (int j = 0; j < 4; ++j) { const int n = (lane >> 3) + 8 * j; const LAS float* s = scr + (8 * c) * 33 + n;
            v4u o; o.x = pk2(s[0 * 33], s[1 * 33]); o.y = pk2(s[2 * 33], s[3 * 33]); o.z = pk2(s[4 * 33], s[5 * 33]); o.w = pk2(s[6 * 33], s[7 * 33]);
            *(v4u*)(t.dst + (size_t)n * t.ldt + 8 * c) = o; }
    }
    LDS_WAIT(); asm volatile("" ::: "memory");
}

__device__ __forceinline__ void lam_pow(float lre, float lim, float dt, int n, float& re, float& im) {
    const float mag = expf(lre * dt * (float)n);
    double th = (double)lim * (double)dt * (double)n;
    th -= 6.283185307179586476925 * rint(th * 0.15915494309189533577);
    const float s = __sinf((float)th), c = __cosf((float)th);
    re = mag * c; im = mag * s;
}

__device__ __forceinline__ void phase0(const KArgs& a, LAS unsigned char* L, int G) {
    const int tid = otid(), lane = tid & 63, wave = __builtin_amdgcn_readfirstlane(tid >> 6);
    const int gw = blockIdx.x * 8 + wave, NGW = G * 8;
    unsigned char* ws = a.ws;
    TIC(11)
    {
        LAS float* scr = (LAS float*)(L + wave * 8448);
        constexpr int N_IN = 16 * 80, N_GLU = 8 * 16, N_OUT = 16 * 32, N_GU = 32 * 16 * 64, N_DN = 32 * 16 * 32;
        constexpr int NITEMS = N_IN + N_GLU + N_OUT + N_GU + N_DN;
        auto locate = [&](int it) -> TrLoc {
            int r = it;
            if (r < N_IN) { const int kb = r / 80, nb = r % 80, n0 = 32 * nb, sc = n0 < 2048 ? n0 : n0 + 8;
                return TrLoc{a.in[I_WIN] + (size_t)(64 * kb) * NPROJ + sc, (bf16*)(ws + OFF_WIN) + (((size_t)(n0 >> 8) * 16 + kb) * 256 + (n0 & 255)) * 64, NPROJ, 64, 0, n0 & 255}; } r -= N_IN;
            if (r < N_GLU) { const int kb = r / 16, nb = r % 16, n0 = 32 * nb;
                return TrLoc{a.in[I_WGLU] + (size_t)(64 * kb) * 512 + n0, (bf16*)(ws + OFF_WGLU) + (size_t)n0 * 512 + 64 * kb, 512, 512, 0, -1}; } r -= N_GLU;
            if (r < N_OUT) { const int kb = r / 32, nb = r % 32, n0 = 32 * nb;
                return TrLoc{a.in[I_WOUT] + (size_t)(64 * kb) * 1024 + n0, (bf16*)(ws + OFF_WOUT) + (size_t)n0 * 1024 + 64 * kb, 1024, 1024, 0, -1}; } r -= N_OUT;
            if (r < N_GU) { const int e = r / 1024, q = r % 1024, kb = q / 64, nb = q % 64, n0 = 32 * nb, pn = n0 >> 8, wi = n0 & 255;
                const int sc = wi < 128 ? 128 * pn + wi : 1024 + 128 * pn + (wi - 128);
                return TrLoc{a.in[I_WGU] + (size_t)e * 1024 * 2048 + (size_t)(64 * kb) * 2048 + sc, (bf16*)(ws + OFF_WGU + ((((size_t)e * 8 + (n0 >> 8)) * 8 + (kb >> 1)) * 256 + (n0 & 255)) * 128 + (kb & 1) * 64), 2048, 128, 1, n0 & 255}; } r -= N_GU;
            { const int e = r / 512, q = r % 512, kb = q / 32, nb = q % 32, n0 = 32 * nb;
                return TrLoc{a.in[I_WDN] + (size_t)e * 1024 * 1024 + (size_t)(64 * kb) * 1024 + n0, (bf16*)(ws + OFF_WDN + ((((size_t)e * 4 + (n0 >> 8)) * 8 + (kb >> 1)) * 256 + (n0 & 255)) * 128 + (kb & 1) * 64), 1024, 128, 1, n0 & 255}; }
        };
        if (gw < NITEMS) {
            TrLoc cur = locate(gw); float vc[32]; tr_load(cur, lane, vc);
            for (int it = gw; it < NITEMS; it += NGW) {
                const int itn = (it + NGW < NITEMS) ? it + NGW : it;
                const TrLoc nxt = locate(itn); float vn[32]; tr_load(nxt, lane, vn);
                tr_finish(cur, scr, lane, vc);
                cur = nxt;
#pragma unroll
                for (int i = 0; i < 32; ++i) vc[i] = vn[i];
            }
        }
    }
    TOC(11)
    __syncthreads();
    TIC(12)
    {
        const float* lre = a.in[I_LRE]; const float* lim = a.in[I_LIM]; const float* ldt = a.in[I_LDT];
        const float* bre = a.in[I_BRE]; const float* bim = a.in[I_BIM]; const float* cre = a.in[I_CRE]; const float* cim = a.in[I_CIM];
        const int gt = blockIdx.x * 512 + tid, GT = G * 512;
        float* KT = (float*)(ws + OFF_KT);
        for (int task4 = gt; task4 < 32 * 64 * 16 * 4; task4 += GT) {
            const int task = task4 >> 2, pq = task4 & 3;
            const int g = task >> 10, tau = (task >> 4) & 63, i = task & 15;
            const float dt = expf(ldt[g]);
            float acc[16];
#pragma unroll
            for (int j = 0; j < 16; ++j) acc[j] = 0.f;
#pragma unroll 2
            for (int p = pq * 16; p < pq * 16 + 16; ++p) {
                const float lr = lre[g * 64 + p], li = lim[g * 64 + p];
                float pr, pi; lam_pow(lr, li, dt, tau, pr, pi);
                float l1r, l1i; lam_pow(lr, li, dt, 1, l1r, l1i);
                const float nr = l1r - 1.f, ni = l1i, den = lr * lr + li * li;
                const float fr = (nr * lr + ni * li) / den, fi = (ni * lr - nr * li) / den;
                const float cr = cre[(g * 16 + i) * 64 + p], ci = cim[(g * 16 + i) * 64 + p];
                const float zr = cr * pr - ci * pi, zi = cr * pi + ci * pr;
                const float yr = zr * fr - zi * fi, yi = zr * fi + zi * fr;
                const f4* br4 = (const f4*)(bre + (size_t)(g * 64 + p) * 16); const f4* bi4 = (const f4*)(bim + (size_t)(g * 64 + p) * 16);
#pragma unroll
                for (int q = 0; q < 4; ++q) { const f4 x = br4[q], y = bi4[q];
                    acc[4 * q + 0] += yr * x.x - yi * y.x; acc[4 * q + 1] += yr * x.y - yi * y.y; acc[4 * q + 2] += yr * x.z - yi * y.z; acc[4 * q + 3] += yr * x.w - yi * y.w; }
            }
#pragma unroll
            for (int j = 0; j < 16; ++j) { acc[j] += __shfl_xor(acc[j], 1); acc[j] += __shfl_xor(acc[j], 2); }
            if (pq == 0) { f4* o = (f4*)(KT + (size_t)task * 16);
#pragma unroll
                for (int q = 0; q < 4; ++q) o[q] = (f4){acc[4 * q], acc[4 * q + 1], acc[4 * q + 2], acc[4 * q + 3]}; }
        }
        bf16* S5P = (bf16*)(ws + OFF_S5P);
        for (int task = gt; task < 32 * 64 * 64; task += GT) {
            const int g = task >> 12, p = (task >> 6) & 63, s = task & 63;
            const float dt = expf(ldt[g]); const float lr = lre[g * 64 + p], li = lim[g * 64 + p];
            float pr, pi; lam_pow(lr, li, dt, 63 - s, pr, pi);
            float l1r, l1i; lam_pow(lr, li, dt, 1, l1r, l1i);
            const float nr = l1r - 1.f, ni = l1i, den = lr * lr + li * li;
            const float fr = (nr * lr + ni * li) / den, fi = (ni * lr - nr * li) / den;
            const float yr = pr * fr - pi * fi, yi = pr * fi + pi * fr;
            const float* br = bre + (size_t)(g * 64 + p) * 16; const float* bi = bim + (size_t)(g * 64 + p) * 16;
            unsigned ore[8], oim[8];
#pragma unroll
            for (int j = 0; j < 8; ++j) { const float x0 = br[2 * j], y0 = bi[2 * j], x1 = br[2 * j + 1], y1 = bi[2 * j + 1];
                ore[j] = pk2(yr * x0 - yi * y0, yr * x1 - yi * y1); oim[j] = pk2(yr * y0 + yi * x0, yr * y1 + yi * x1); }
            v4u* d0 = (v4u*)(S5P + ((size_t)(g * 256 + 2 * p) * 1024 + s * 16)); v4u* d1 = (v4u*)(S5P + ((size_t)(g * 256 + 2 * p + 1) * 1024 + s * 16));
            d0[0] = (v4u){ore[0], ore[1], ore[2], ore[3]}; d0[1] = (v4u){ore[4], ore[5], ore[6], ore[7]};
            d1[0] = (v4u){oim[0], oim[1], oim[2], oim[3]}; d1[1] = (v4u){oim[4], oim[5], oim[6], oim[7]};
        }
        for (int task = gt; task < 32 * 128 * 128; task += GT) {
            const int g = task >> 14, r = (task >> 7) & 127, c8 = task & 127;
            *(v4u*)(S5P + ((size_t)(g * 256 + 128 + r) * 1024 + c8 * 8)) = (v4u){0u, 0u, 0u, 0u};
        }
        bf16* S5M = (bf16*)(ws + OFF_S5M);
        for (int task = gt; task < 32 * 64 * 64; task += GT) {
            const int g = task >> 12, t = (task >> 6) & 63, p = task & 63;
            const float dt = expf(ldt[g]); const float lr = lre[g * 64 + p], li = lim[g * 64 + p];
            float pr, pi; lam_pow(lr, li, dt, t + 1, pr, pi);
#pragma unroll
            for (int i = 0; i < 16; ++i) { const float cr = cre[(g * 16 + i) * 64 + p], ci = cim[(g * 16 + i) * 64 + p];
                *(unsigned*)(S5M + ((size_t)(g * 1024 + t * 16 + i) * 1152 + 2 * p)) = pk2(cr * pr - ci * pi, -(cr * pi + ci * pr)); }
        }
    }
    TOC(12) TIC(13)
    {
        LAS float* wif = (LAS float*)(L + 69632);
        const float* win = a.in[I_WIN];
        for (int idx = tid; idx < 8192; idx += 512) wif[idx] = win[(size_t)(idx >> 3) * NPROJ + 2048 + (idx & 7)];
        __syncthreads();
        const float* x = a.in[I_X]; const float* g1 = a.in[I_N1G]; const float* bif = a.in[I_BIF];
        bf16* H1 = (bf16*)(ws + OFF_H1); float* GATES = (float*)(ws + OFF_GATES);
        f4 gv[4];
#pragma unroll
        for (int j = 0; j < 4; ++j) gv[j] = ((const f4*)g1)[lane + 64 * j];
        for (int m0 = 2 * gw; m0 < T; m0 += 2 * NGW) {
            f4 v2[2][4];
#pragma unroll
            for (int rr = 0; rr < 2; ++rr) { const f4* xr = (const f4*)(x + (size_t)(m0 + rr) * DM) + lane;
#pragma unroll
                for (int j = 0; j < 4; ++j) v2[rr][j] = xr[64 * j]; }
#pragma unroll
            for (int rr = 0; rr < 2; ++rr) { const int m = m0 + rr;
            f4 v[4]; float ss = 0.f;
#pragma unroll
            for (int j = 0; j < 4; ++j) { v[j] = v2[rr][j]; ss += (v[j].x * v[j].x + v[j].y * v[j].y) + (v[j].z * v[j].z + v[j].w * v[j].w); }
            const float rstd = rsqrtf(wave_sum(ss) * (1.f / DM) + EPS);
            float ga[8];
#pragma unroll
            for (int c = 0; c < 8; ++c) ga[c] = 0.f;
            bf16* o8 = H1 + (((size_t)(m >> 8) * 16 + (lane >> 4)) * 256 + (m & 255)) * 64 + 4 * (lane & 15);
#pragma unroll
            for (int j = 0; j < 4; ++j) { v[j] = v[j] * rstd * gv[j];
                *(unsigned long long*)(o8 + (size_t)j * 4 * 256 * 64) = (unsigned long long)pk2(v[j].x, v[j].y) | ((unsigned long long)pk2(v[j].z, v[j].w) << 32);
#pragma unroll
                for (int e = 0; e < 4; ++e) { const int k = 4 * lane + 256 * j + e; const f4 w0 = *(const LAS f4*)(wif + k * 8), w1 = *(const LAS f4*)(wif + k * 8 + 4); const float hv = v[j][e];
                    ga[0] += hv * w0.x; ga[1] += hv * w0.y; ga[2] += hv * w0.z; ga[3] += hv * w0.w; ga[4] += hv * w1.x; ga[5] += hv * w1.y; ga[6] += hv * w1.z; ga[7] += hv * w1.w; }
            }
            float r4[4], r2[2], r1;
            { const bool hi = lane & 32;
#pragma unroll
              for (int i = 0; i < 4; ++i) { const float send = hi ? ga[i] : ga[i + 4], keep = hi ? ga[i + 4] : ga[i]; r4[i] = keep + __shfl_xor(send, 32); } }
            { const bool hi = lane & 16;
#pragma unroll
              for (int i = 0; i < 2; ++i) { const float send = hi ? r4[i] : r4[i + 2], keep = hi ? r4[i + 2] : r4[i]; r2[i] = keep + __shfl_xor(send, 16); } }
            { const bool hi = lane & 8; const float send = hi ? r2[0] : r2[1], keep = hi ? r2[1] : r2[0]; r1 = keep + __shfl_xor(send, 8); }
            r1 += __shfl_xor(r1, 4); r1 += __shfl_xor(r1, 2); r1 += __shfl_xor(r1, 1);
            if ((lane & 7) == 0) { const int c = (lane >> 3) & 7; GATES[(size_t)m * 8 + c] = r1 + bif[c]; }
            }
        }
    }
    TOC(13)
}

__device__ __forceinline__ void s5_expand(const KArgs& a, int G) {
    const float* KT = (const float*)(a.ws + OFF_KT); bf16* S5M = (bf16*)(a.ws + OFF_S5M);
    const int gt = blockIdx.x * 512 + otid(), GT = G * 512;
    for (int task = gt; task < 32 * 1024 * 64; task += GT) {
        const int s = task & 63, row = task >> 6, g = row >> 10, t = (row >> 4) & 63, i = row & 15;
        if (s >= ((t >> 4) + 1) * 16) continue;
        v4u o0 = (v4u){0u, 0u, 0u, 0u}, o1 = o0;
        if (s <= t) { const f4* k4 = (const f4*)(KT + ((size_t)((g * 64 + (t - s)) * 16 + i)) * 16); const f4 a0 = k4[0], a1 = k4[1], a2 = k4[2], a3 = k4[3];
            o0 = (v4u){pk2(a0.x, a0.y), pk2(a0.z, a0.w), pk2(a1.x, a1.y), pk2(a1.z, a1.w)}; o1 = (v4u){pk2(a2.x, a2.y), pk2(a2.z, a2.w), pk2(a3.x, a3.y), pk2(a3.z, a3.w)}; }
        v4u* d = (v4u*)(S5M + ((size_t)row * 1152 + 128 + s * 16)); d[0] = o0; d[1] = o1;
    }
}

using pg8::Unit; using pg8::cvt_pk_bf16;
struct EpiInProj {
    static constexpr bool PERM = true;
    bf16 *QK, *V, *O, *UG;
    __device__ __forceinline__ void operator()(const pg8::f32x4 (&acc)[2][2][4][2], const Unit& u, int wr, int wc, int fr, int fq) const {
        const int row0 = u.pm * 256 + wr * 64 + fr, c0 = wc * 32 + 8 * fq;
#pragma unroll
        for (int ai = 0; ai < 2; ++ai)
#pragma unroll
            for (int m = 0; m < 4; ++m) { const int row = row0 + ai * 128 + m * 16;
#pragma unroll
                for (int bj = 0; bj < 2; ++bj) { const pg8::f32x4 v0 = acc[ai][bj][m][0], v1 = acc[ai][bj][m][1];
                    v4u w; w.x = cvt_pk_bf16(v0[0], v0[1]); w.y = cvt_pk_bf16(v0[2], v0[3]); w.z = cvt_pk_bf16(v1[0], v1[1]); w.w = cvt_pk_bf16(v1[2], v1[3]);
                    const int col = c0 + bj * 128;
                    bf16* dst;
                    if (u.pn < 4) dst = QK + (size_t)row * 1024 + u.pn * 256 + col;
                    else if (u.pn < 6) dst = V + (size_t)row * 512 + (u.pn - 4) * 256 + col;
                    else if (u.pn < 8) dst = O + (size_t)row * 512 + (u.pn - 6) * 256 + col;
                    else { const int uc = (u.pn - 8) * 256 + col, g = uc >> 4, j = uc & 15; dst = UG + ((size_t)(g * 1024 + (row >> 6)) * 1152 + 128 + (row & 63) * 16 + j); }
                    *(v4u*)dst = w; } }
    }
};
struct EpiS5E {
    static constexpr bool PERM = false;
    float* E;
    __device__ __forceinline__ void operator()(const pg8::f32x4 (&acc)[2][2][4][2], const Unit& u, int wr, int wc, int fr, int fq) const {
        const int row0 = u.pm * 256 + wr * 64 + fr, col0 = wc * 32 + 4 * fq;
#pragma unroll
        for (int ai = 0; ai < 2; ++ai)
#pragma unroll
            for (int m = 0; m < 4; ++m) { float* rowp = E + (size_t)(row0 + ai * 128 + m * 16) * 128 + col0;
#pragma unroll
                for (int n = 0; n < 2; ++n) *(pg8::f32x4*)(rowp + n * 16) = acc[ai][0][m][n]; }
    }
};
struct EpiS5Y {
    static constexpr bool PERM = true;
    const bf16* UG; const float* dskip; bf16* YSG;
    __device__ __forceinline__ void operator()(const pg8::f32x4 (&acc)[2][2][4][2], const Unit& u, int wr, int wc, int fr, int fq) const {
        const int g = u.pm >> 2, row0 = u.pm * 256 + wr * 64 + fr, c0 = (u.pn & 3) * 256 + wc * 32 + 8 * fq;
#pragma unroll
        for (int ai = 0; ai < 2; ++ai)
#pragma unroll
            for (int m = 0; m < 4; ++m) { const int row = row0 + ai * 128 + m * 16, chunk = row & 1023;
#pragma unroll
                for (int bj = 0; bj < 2; ++bj) { const int n = c0 + bj * 128, t = n >> 4, i0 = n & 15;
                    const v4u uw = *(const v4u*)(UG + ((size_t)row * 1152 + 128 + n));
                    const f4 d0 = *(const f4*)(dskip + g * 16 + i0), d1 = *(const f4*)(dskip + g * 16 + i0 + 4);
                    const pg8::f32x4 v0 = acc[ai][bj][m][0], v1 = acc[ai][bj][m][1];
                    float y[8];
                    y[0] = v0[0] + d0.x * bflo(uw.x); y[1] = v0[1] + d0.y * bfhi(uw.x); y[2] = v0[2] + d0.z * bflo(uw.y); y[3] = v0[3] + d0.w * bfhi(uw.y);
                    y[4] = v1[0] + d1.x * bflo(uw.z); y[5] = v1[1] + d1.y * bfhi(uw.z); y[6] = v1[2] + d1.z * bflo(uw.w); y[7] = v1[3] + d1.w * bfhi(uw.w);
#pragma unroll
                    for (int e = 0; e < 8; ++e) y[e] = gelu_tanh(y[e]);
                    v4u w; w.x = cvt_pk_bf16(y[0], y[1]); w.y = cvt_pk_bf16(y[2], y[3]); w.z = cvt_pk_bf16(y[4], y[5]); w.w = cvt_pk_bf16(y[6], y[7]);
                    *(v4u*)(YSG + ((size_t)(chunk * 64 + t) * 512 + g * 16 + i0)) = w; } }
    }
};
struct EpiGlu {
    static constexpr bool PERM = true;
    const bf16* YSG; const float* bglu; bf16* MIX;
    __device__ __forceinline__ void operator()(const pg8::f32x4 (&acc)[2][2][4][2], const Unit& u, int wr, int wc, int fr, int fq) const {
        const int row0 = u.pm * 256 + wr * 64 + fr, c0 = u.pn * 256 + wc * 32 + 8 * fq;
#pragma unroll
        for (int ai = 0; ai < 2; ++ai)
#pragma unroll
            for (int m = 0; m < 4; ++m) { const int row = row0 + ai * 128 + m * 16;
#pragma unroll
                for (int bj = 0; bj < 2; ++bj) { const int col = c0 + bj * 128;
                    const v4u yw = *(const v4u*)(YSG + (size_t)row * 512 + col);
                    const f4 b0 = *(const f4*)(bglu + col), b1 = *(const f4*)(bglu + col + 4);
                    const pg8::f32x4 v0 = acc[ai][bj][m][0], v1 = acc[ai][bj][m][1];
                    float y[8];
                    y[0] = bflo(yw.x) * sigmoidf_(v0[0] + b0.x); y[1] = bfhi(yw.x) * sigmoidf_(v0[1] + b0.y); y[2] = bflo(yw.y) * sigmoidf_(v0[2] + b0.z); y[3] = bfhi(yw.y) * sigmoidf_(v0[3] + b0.w);
                    y[4] = bflo(yw.z) * sigmoidf_(v1[0] + b1.x); y[5] = bfhi(yw.z) * sigmoidf_(v1[1] + b1.y); y[6] = bflo(yw.w) * sigmoidf_(v1[2] + b1.z); y[7] = bfhi(yw.w) * sigmoidf_(v1[3] + b1.w);
                    v4u w; w.x = cvt_pk_bf16(y[0], y[1]); w.y = cvt_pk_bf16(y[2], y[3]); w.z = cvt_pk_bf16(y[4], y[5]); w.w = cvt_pk_bf16(y[6], y[7]);
                    *(v4u*)(MIX + (size_t)row * 1024 + 512 + col) = w; } }
    }
};
struct EpiOut {
    static constexpr bool PERM = true;
    bf16* MO;
    __device__ __forceinline__ void operator()(const pg8::f32x4 (&acc)[2][2][4][2], const Unit& u, int wr, int wc, int fr, int fq) const {
        const int row0 = u.pm * 256 + wr * 64 + fr, c0 = u.pn * 256 + wc * 32 + 8 * fq;
#pragma unroll
        for (int ai = 0; ai < 2; ++ai)
#pragma unroll
            for (int m = 0; m < 4; ++m) { bf16* rowp = MO + (size_t)(row0 + ai * 128 + m * 16) * 1024 + c0;
#pragma unroll
                for (int bj = 0; bj < 2; ++bj) { const pg8::f32x4 v0 = acc[ai][bj][m][0], v1 = acc[ai][bj][m][1];
                    v4u w; w.x = cvt_pk_bf16(v0[0], v0[1]); w.y = cvt_pk_bf16(v0[2], v0[3]); w.z = cvt_pk_bf16(v1[0], v1[1]); w.w = cvt_pk_bf16(v1[2], v1[3]);
                    *(v4u*)(rowp + bj * 128) = w; } }
    }
};
struct EpiMoeGU {
    static constexpr bool PERM = true;
    const float* bgu; unsigned char* ACT; const float* rstds;
    __device__ __forceinline__ void operator()(const pg8::f32x4 (&acc)[2][2][4][2], const Unit& u, int wr, int wc, int fr, int fq) const {
        const int e = u.pn >> 3, pnl = u.pn & 7, row0 = u.pm * 256 + wr * 64 + fr, c0 = pnl * 128 + wc * 32 + 8 * fq;
        const float* bg = bgu + (size_t)e * 2048 + c0; const float* bu = bg + 1024;
        const f4 g0 = *(const f4*)bg, g1 = *(const f4*)(bg + 4), u0 = *(const f4*)bu, u1 = *(const f4*)(bu + 4);
        const float gb[8] = {g0.x, g0.y, g0.z, g0.w, g1.x, g1.y, g1.z, g1.w}, ub[8] = {u0.x, u0.y, u0.z, u0.w, u1.x, u1.y, u1.z, u1.w};
        constexpr float inv = 1.f / (FP8_WSCALE * FP8_ASCALE);
#pragma unroll
        for (int ai = 0; ai < 2; ++ai)
#pragma unroll
            for (int m = 0; m < 4; ++m) { const int row = row0 + ai * 128 + m * 16; const float ri = rstds[row] * inv;
                float y[8];
#pragma unroll
                for (int n = 0; n < 2; ++n)
#pragma unroll
                    for (int q = 0; q < 4; ++q) { const int k = 4 * n + q;
                        const float gate = fminf(acc[ai][0][m][n][q] * ri + gb[k], 7.0f); const float up = fminf(fmaxf(acc[ai][1][m][n][q] * ri + ub[k], -7.0f), 7.0f);
                        y[k] = (up + 1.0f) * gate * sigmoidf_(1.702f * gate) * FP8_ASCALE; }
                v2u w; w.x = pk4_fp8(y[0], y[1], y[2], y[3]); w.y = pk4_fp8(y[4], y[5], y[6], y[7]);
                *(v2u*)(ACT + ((size_t)(u.pm * 8 + pnl) * 256 + (row & 255)) * 128 + (wc * 32 + 8 * fq)) = w; }
    }
};
struct EpiMoeDN {
    static constexpr bool PERM = true;
    const float* bdn; const float* rgate; unsigned char* YS;
    __device__ __forceinline__ void operator()(const pg8::f32x4 (&acc)[2][2][4][2], const Unit& u, int wr, int wc, int fr, int fq) const {
        const int e = u.pn >> 2, pnl = u.pn & 3, row0 = u.pm * 256 + wr * 64 + fr, c0 = pnl * 256 + wc * 32 + 8 * fq;
#pragma unroll
        for (int bj = 0; bj < 2; ++bj) { const int col = c0 + bj * 128;
            const f4 b0 = *(const f4*)(bdn + (size_t)e * 1024 + col), b1 = *(const f4*)(bdn + (size_t)e * 1024 + col + 4);
#pragma unroll
            for (int ai = 0; ai < 2; ++ai)
#pragma unroll
                for (int m = 0; m < 4; ++m) { const int row = row0 + ai * 128 + m * 16; const float gt = rgate[row];
                    const pg8::f32x4 v0 = acc[ai][bj][m][0] * (1.f / (FP8_WSCALE * FP8_ASCALE)), v1 = acc[ai][bj][m][1] * (1.f / (FP8_WSCALE * FP8_ASCALE));
                    const float gs = gt * FP8_YSCALE;
                    v2u w; w.x = pk4_fp8((v0[0] + b0.x) * gs, (v0[1] + b0.y) * gs, (v0[2] + b0.z) * gs, (v0[3] + b0.w) * gs);
                    w.y = pk4_fp8((v1[0] + b1.x) * gs, (v1[1] + b1.y) * gs, (v1[2] + b1.z) * gs, (v1[3] + b1.w) * gs);
                    *(v2u*)(YS + (size_t)row * 1024 + col) = w; } }
    }
};

struct S5EOrder {
    int G, c;
    __device__ __forceinline__ bool next(int i, Unit& u) const { const int x = c & 7, j = c >> 3; if (i > 0 || j >= 16) return false; const int g = x + 8 * (j >> 2); u.pm = g * 4 + (j & 3); u.pn = g; u.rd = 0; u.nt = 0; return true; }
    __device__ __forceinline__ void a_ready(const Unit&) const {}
    __device__ __forceinline__ void done(const Unit&) const {}
};
struct S5YOrder {
    int G, c;
    __device__ __forceinline__ bool next(int i, Unit& u) const { if (i >= 2) return false; const int x = c & 7, j = c >> 3, g = x + 8 * (2 * i + (j >> 4)), r = j & 15, b = i ? 3 - (r & 3) : (r & 3);
        u.pm = g * 4 + (r >> 2); u.pn = g * 4 + b; u.rd = i; u.nt = 6 + 4 * b; return true; }
    __device__ __forceinline__ void a_ready(const Unit&) const {}
    __device__ __forceinline__ void done(const Unit&) const {}
};
struct MoeOrder {
    const int* tile_e; int ntile, NT, G, c;
    unsigned* sync;
    __device__ __forceinline__ bool next(int i, Unit& u) const {
#ifdef HALF_CHIP
        const int x = c & 7, RT = 32 / NT; if ((c >> 3) >= 16) return false; const int j = (c >> 3) + 16 * (i & 1); i >>= 1;
#else
        const int x = c & 7, j = c >> 3, RT = 32 / NT;
#endif
#ifdef XCD_RANGE
        const int per = ((ntile + 8 * RT - 1) / (8 * RT)) * RT, kk = i * RT + j / NT;
        const int it = x * per + kk, pnl = j % NT;
        if (kk >= per || it >= ntile) return false;
#else
        const int it = (i * 8 + x) * RT + j / NT, pnl = j % NT;
        if (it >= ntile) return false;
#endif
#ifdef DN_REVERSE
        if (NT == 4) { const int itr = ntile - 1 - it; u.pm = itr; u.pn = tile_e[itr] * NT + pnl; u.rd = i; u.nt = 0; return true; }
#endif
        u.pm = it; u.pn = tile_e[it] * NT + pnl; u.rd = i; u.nt = 0; return true; }
    __device__ __forceinline__ void a_ready(const Unit&) const {}
    __device__ __forceinline__ void done(const Unit&) const {}
};

typedef short v4i16_t __attribute__((ext_vector_type(4)));
__device__ __forceinline__ bf16x8 tr_frag(const LAS unsigned char* img, int RS, int ks, int n0, int lane) {
    const int h = lane >> 5, blk = (lane >> 4) & 1, q = (lane & 15) >> 2, p = lane & 3;
    const LAS unsigned char* a0 = img + (16 * ks + 8 * h + q) * RS + (n0 + 16 * blk + 4 * p) * 2;
    const v4i16_t lo = __builtin_amdgcn_ds_read_tr16_b64_v4i16((LAS v4i16_t*)a0), hi = __builtin_amdgcn_ds_read_tr16_b64_v4i16((LAS v4i16_t*)(a0 + 4 * RS));
    return (bf16x8){lo[0], lo[1], lo[2], lo[3], hi[0], hi[1], hi[2], hi[3]};
}
__device__ __forceinline__ int tr_base(int RS, int lane) { const int h = lane >> 5, blk = (lane >> 4) & 1, q = (lane & 15) >> 2, p = lane & 3; return (8 * h + q) * RS + (16 * blk + 4 * p) * 2; }
__device__ __forceinline__ bf16x8 tr_frag_b(const LAS unsigned char* lanebase, int RS, int off) {
    const v4i16_t lo = __builtin_amdgcn_ds_read_tr16_b64_v4i16((LAS v4i16_t*)(lanebase + off)), hi = __builtin_amdgcn_ds_read_tr16_b64_v4i16((LAS v4i16_t*)(lanebase + off + 4 * RS));
    return (bf16x8){lo[0], lo[1], lo[2], lo[3], hi[0], hi[1], hi[2], hi[3]};
}
__device__ __forceinline__ v4u pack8(const float (&v)[8]) { v4u w; w.x = pk2(v[0], v[1]); w.y = pk2(v[2], v[3]); w.z = pk2(v[4], v[5]); w.w = pk2(v[6], v[7]); return w; }
constexpr int ML_KT = 0, ML_VT = 34816, ML_TILE = 17408;
constexpr int ML_CW = 69632;
constexpr int ML_GA = 74752;
constexpr int ML_PW = 79616;
struct KvRaw { v4u k[4][2]; v4u v[2]; unsigned m[4]; };
__device__ __forceinline__ void kv_load(KvRaw& R, const bf16* QKb  , const bf16* Vb  , int srow  , int col0) {
#pragma unroll
    for (int i = 0; i < 4; ++i) { const int r = srow - 3 + i; const v4u* p = (const v4u*)(QKb + (size_t)(r < 0 ? 0 : r) * 1024 + col0); R.k[i][0] = p[0]; R.k[i][1] = p[1]; R.m[i] = r < 0 ? 0u : 0xffffffffu; }
    const v4u* pv = (const v4u*)(Vb + (size_t)srow * 512 + col0); R.v[0] = pv[0]; R.v[1] = pv[1];
}
__device__ __forceinline__ void kv_conv(const KvRaw& R, const LAS float* cw, int col0, float mul, float (&o)[16]) {
#pragma unroll
    for (int q = 0; q < 4; ++q) { const f4 bv = *(const LAS f4*)(cw + 4 * 128 + col0 + 4 * q); o[4 * q] = bv.x; o[4 * q + 1] = bv.y; o[4 * q + 2] = bv.z; o[4 * q + 3] = bv.w; }
#pragma unroll
    for (int i = 0; i < 4; ++i) { const unsigned m = R.m[i];
        const unsigned xw[8] = {R.k[i][0].x & m, R.k[i][0].y & m, R.k[i][0].z & m, R.k[i][0].w & m, R.k[i][1].x & m, R.k[i][1].y & m, R.k[i][1].z & m, R.k[i][1].w & m};
#pragma unroll
        for (int q = 0; q < 4; ++q) { const f4 w = *(const LAS f4*)(cw + i * 128 + col0 + 4 * q);
            o[4 * q] += w.x * bflo(xw[2 * q]); o[4 * q + 1] += w.y * bfhi(xw[2 * q]); o[4 * q + 2] += w.z * bflo(xw[2 * q + 1]); o[4 * q + 3] += w.w * bfhi(xw[2 * q + 1]); } }
#pragma unroll
    for (int e = 0; e < 16; ++e) o[e] = siluf_(o[e]) * mul;
}
__device__ __forceinline__ void gate_part1(const float* GATES, int tok0, int h, int tid, float& bbw, float& ig, LAS float* scr, int nw) {
    const int lane = tid & 63, wave = tid >> 6;
    if (wave < nw) { const float fg = GATES[(size_t)(tok0 + tid) * 8 + 4 + h]; ig = GATES[(size_t)(tok0 + tid) * 8 + h];
        bbw = logsigmoidf_(fg);
#pragma unroll
        for (int o = 1; o < 64; o <<= 1) { const float t = __shfl_up(bbw, o); if (lane >= o) bbw += t; }
        if (lane == 63) scr[wave] = bbw; }
}
__device__ __forceinline__ void mlstm_state_item(const KArgs& a, LAS unsigned char* L, int item) {
    const int tid = otid(), lane = tid & 63, wave = tid >> 6;
    const int c = item & 63, bh = item >> 6, h = bh & 3, b = bh >> 2, tok0 = b * SEQ + c * 128;
    LAS float* cwk = (LAS float*)(L + ML_CW) + 640; LAS float* wsv = (LAS float*)(L + ML_GA); LAS float* scr = wsv + 1024;
    const bf16* QKb = (const bf16*)(a.ws + OFF_QK) + (size_t)(b * SEQ) * 1024 + 512 + h * 128; const bf16* Vb = (const bf16*)(a.ws + OFF_V) + (size_t)(b * SEQ) * 512 + h * 128;
    const int s = tid >> 3, col0 = (tid & 7) * 16;
    KvRaw R; kv_load(R, QKb, Vb, c * 128 + s, col0);
    if (tid < 160) { const int r = tid >> 5, q4 = (tid & 31) * 4; *(LAS f4*)(cwk + r * 128 + q4) = r < 4 ? *(const f4*)(a.in[I_CONVW] + r * 1024 + 512 + h * 128 + q4) : *(const f4*)(a.in[I_CONVB] + 512 + h * 128 + q4); }
    float bbw = 0.f, ig = 0.f; gate_part1((const float*)(a.ws + OFF_GATES), tok0, h, tid, bbw, ig, scr, 2);
    __syncthreads();
    float wl = -3.0e38f;
    if (wave < 2) { float off = 0.f;
#pragma unroll
        for (int w = 0; w < 2; ++w) if (w < wave) off += scr[w];
        const float g = scr[0] + scr[1]; wl = g - (bbw + off) + ig;
        const float wm = wave_max(wl); if (lane == 0) scr[8 + wave] = wm;
        if (tid == 0) ((float*)(a.ws + OFF_MLG))[item] = g; }
    __syncthreads();
    if (wave < 2) { const float amax = fmaxf(scr[8], scr[9]); wsv[tid] = expf(wl - amax); if (tid == 0) ((float*)(a.ws + OFF_MLA))[item] = amax; }
    __syncthreads();
    const int kdb = wave >> 1, vb0 = (wave & 1) * 2, r32 = lane & 31, hh = lane >> 5;
    f32x16 acc0, acc1;
#pragma unroll
    for (int i = 0; i < 16; ++i) { acc0[i] = 0.f; acc1[i] = 0.f; }
    float np = 0.f;
#pragma unroll 1
    for (int j = 0; j < 2; ++j) {
        LAS unsigned char* kt = L + ML_KT + (j & 1) * ML_TILE; LAS unsigned char* vt = L + ML_VT + (j & 1) * ML_TILE;
        { float o[16]; kv_conv(R, cwk, col0, 0.08838834764831845f * wsv[64 * j + s], o);
          const float o0[8] = {o[0], o[1], o[2], o[3], o[4], o[5], o[6], o[7]}, o1[8] = {o[8], o[9], o[10], o[11], o[12], o[13], o[14], o[15]};
          *(LAS v4u*)(kt + s * 272 + col0 * 2) = pack8(o0); *(LAS v4u*)(kt + s * 272 + col0 * 2 + 16) = pack8(o1);
          *(LAS v4u*)(vt + s * 272 + col0 * 2) = R.v[0]; *(LAS v4u*)(vt + s * 272 + col0 * 2 + 16) = R.v[1]; }
        kv_load(R, QKb, Vb, c * 128 + 64 + s, col0);
        __syncthreads();
#pragma unroll
        for (int ks = 0; ks < 4; ++ks) { const bf16x8 A = tr_frag(kt, 272, ks, kdb * 32, lane), B0 = tr_frag(vt, 272, ks, vb0 * 32, lane), B1 = tr_frag(vt, 272, ks, vb0 * 32 + 32, lane);
            acc0 = __builtin_amdgcn_mfma_f32_32x32x16_bf16(A, B0, acc0, 0, 0, 0); acc1 = __builtin_amdgcn_mfma_f32_32x32x16_bf16(A, B1, acc1, 0, 0, 0); }
        if (tid < 128) {
#pragma unroll 8
            for (int q = 0; q < 64; ++q) np += bf2f(*(const LAS bf16*)(kt + q * 272 + tid * 2)); }
    }
    {
        bf16* UP = (bf16*)((unsigned char*)a.out + OUT_UP) + (size_t)item * 16384;
#pragma unroll
        for (int q = 0; q < 4; ++q) { const int kd = kdb * 32 + 8 * q + 4 * hh;
            v2u w0; w0.x = pk2(acc0[4 * q], acc0[4 * q + 1]); w0.y = pk2(acc0[4 * q + 2], acc0[4 * q + 3]);
            v2u w1; w1.x = pk2(acc1[4 * q], acc1[4 * q + 1]); w1.y = pk2(acc1[4 * q + 2], acc1[4 * q + 3]);
            *(v2u*)(UP + (size_t)(vb0 * 32 + r32) * 128 + kd) = w0; *(v2u*)(UP + (size_t)((vb0 + 1) * 32 + r32) * 128 + kd) = w1; }
        if (tid < 128) ((float*)(a.ws + OFF_MLNP))[(size_t)item * 128 + tid] = np;
    }
    __syncthreads();
}

__device__ __forceinline__ void phase3(const KArgs& a, LAS unsigned char* L, int G) {
    const int tid = otid(), lane = tid & 63, wave = tid >> 6;
    LAS float* ga = (LAS float*)L; LAS float* aa = ga + 64; LAS float* dec = aa + 64; LAS float* scl = dec + 64;
    for (int w = blockIdx.x; w < 256; w += G) {
        const int bh = w >> 3, slice = w & 7;
        if (tid < 64) { ga[tid] = ((const float*)(a.ws + OFF_MLG))[bh * 64 + tid]; aa[tid] = ((const float*)(a.ws + OFF_MLA))[bh * 64 + tid]; }
        __syncthreads();
        if (tid == 0) { float m = 0.f; float* MLM = (float*)(a.ws + OFF_MLM);
            for (int c = 0; c < 64; ++c) { const float g = ga[c], am = aa[c], mn = fmaxf(g + m, am); dec[c] = expf(g + m - mn); scl[c] = expf(am - mn); if (slice == 0) MLM[bh * 64 + c] = m; m = mn; } }
        __syncthreads();
        {
            const size_t e0 = (size_t)bh * 64 * 16384 + slice * 2048 + tid * 4;
            const bf16* up = (const bf16*)((const unsigned char*)a.out + OUT_UP) + e0; bf16* cs = (bf16*)((unsigned char*)a.out + OUT_CST) + e0;
            float C0 = 0.f, C1 = 0.f, C2 = 0.f, C3 = 0.f;
            for (int c0 = 0; c0 < 64; c0 += 16) {
                v2u uv[16];
#pragma unroll
                for (int q = 0; q < 16; ++q) uv[q] = *(const v2u*)(up + (size_t)(c0 + q) * 16384);
#pragma unroll
                for (int q = 0; q < 16; ++q) { v2u o; o.x = pk2(C0, C1); o.y = pk2(C2, C3); *(v2u*)(cs + (size_t)(c0 + q) * 16384) = o;
                    const float d = dec[c0 + q], sc = scl[c0 + q];
                    C0 = d * C0 + sc * bflo(uv[q].x); C1 = d * C1 + sc * bfhi(uv[q].x); C2 = d * C2 + sc * bflo(uv[q].y); C3 = d * C3 + sc * bfhi(uv[q].y); }
            }
        }
        if (slice == 0 && tid < 128) { const float* np = (const float*)(a.ws + OFF_MLNP) + (size_t)bh * 64 * 128 + tid; float* ns = (float*)(a.ws + OFF_MLN) + (size_t)bh * 64 * 128 + tid; float n = 0.f;
            for (int c = 0; c < 64; ++c) { ns[c * 128] = n; n = dec[c] * n + scl[c] * np[c * 128]; } }
        __syncthreads();
    }
    if (wave == 7) for (int w = blockIdx.x; w < 256; w += G) {
        const int b = w >> 5, g = w & 31, p = lane;
        const float dt = expf(a.in[I_LDT][g]); float lr, li; lam_pow(a.in[I_LRE][g * 64 + p], a.in[I_LIM][g * 64 + p], dt, 64, lr, li);
        const float* E = (const float*)(a.ws + OFF_S5E) + ((size_t)(g * 1024 + b * 128) * 128 + 2 * p);
        bf16* UG = (bf16*)(a.ws + OFF_UG) + ((size_t)(g * 1024 + b * 128) * 1152 + 2 * p);
        float xr = 0.f, xi = 0.f;
        for (int c0 = 0; c0 < 128; c0 += 8) {
            f2 ev[8];
#pragma unroll
            for (int q = 0; q < 8; ++q) ev[q] = *(const f2*)(E + (size_t)(c0 + q) * 128);
#pragma unroll
            for (int q = 0; q < 8; ++q) { *(unsigned*)(UG + (size_t)(c0 + q) * 1152) = pk2(xr, xi);
                const float nr = lr * xr - li * xi + ev[q].x, ni = lr * xi + li * xr + ev[q].y; xr = nr; xi = ni; }
        }
    }
}

__device__ __forceinline__ void kq_load(KvRaw& R, const bf16* QKq, int srow, int col0) {
#pragma unroll
    for (int i = 0; i < 4; ++i) { const int r = srow - 3 + i; const v4u* p = (const v4u*)(QKq + (size_t)(r < 0 ? 0 : r) * 1024 + col0); R.k[i][0] = p[0]; R.k[i][1] = p[1]; R.m[i] = r < 0 ? 0u : 0xffffffffu; }
}
__device__ __forceinline__ bf16x8 tr16_frag(const LAS unsigned char* lanebase, int off) {
    const v4i16_t lo = __builtin_amdgcn_ds_read_tr16_b64_v4i16((LAS v4i16_t*)(lanebase + off)), hi = __builtin_amdgcn_ds_read_tr16_b64_v4i16((LAS v4i16_t*)(lanebase + off + 4 * 272));
    return (bf16x8){lo[0], lo[1], lo[2], lo[3], hi[0], hi[1], hi[2], hi[3]};
}
__device__ __forceinline__ void mlstm_out_item(const KArgs& a, LAS unsigned char* L, int item, int next_item, KvRaw& Ra, KvRaw& Rb, int& h_loaded) {
    const int tid = otid(), lane = tid & 63, wave = __builtin_amdgcn_readfirstlane(tid >> 6);
    const int c = item & 63, bh = item >> 6, h = bh & 3, b = bh >> 2, tok0 = b * SEQ + c * 128;
    const int fr = lane & 15, fq = lane >> 4;
    LAS float* cwq = (LAS float*)(L + ML_CW); LAS float* cwk = cwq + 640;
    LAS float* gcs = (LAS float*)(L + ML_GA); LAS float* grr = gcs + 256; LAS float* gsc = grr + 256; LAS float* gen = gsc + 256; LAS float* scr = gen + 256;
    LAS bf16* Pw = (LAS bf16*)(L + ML_PW + wave * 2304);
    const bf16* QKq = (const bf16*)(a.ws + OFF_QK) + (size_t)(b * SEQ) * 1024 + h * 128;
    const bf16* QKb = QKq + 512; const bf16* Vb = (const bf16*)(a.ws + OFF_V) + (size_t)(b * SEQ) * 512 + h * 128;
    const int s = tid >> 3, col0 = (tid & 7) * 16;
    TIC(31) TIC(36)
    if (h != h_loaded) {
    if (tid < 320) { const int t2 = tid < 160 ? tid : tid - 160, r = t2 >> 5, q4 = (t2 & 31) * 4, ch = (tid < 160 ? 0 : 512) + h * 128 + q4;
        *(LAS f4*)((tid < 160 ? cwq : cwk) + r * 128 + q4) = r < 4 ? *(const f4*)(a.in[I_CONVW] + r * 1024 + ch) : *(const f4*)(a.in[I_CONVB] + ch); }
    else if (tid < 352) *(LAS f4*)(scr + 64 + 4 * (tid - 320)) = *(const f4*)(a.in[I_HNG] + h * 128 + 4 * (tid - 320));
    h_loaded = h; }
    float bbw = 0.f, ig = 0.f; gate_part1((const float*)(a.ws + OFF_GATES), tok0, h, tid, bbw, ig, scr, 2);
    __syncthreads();
    float cs = 0.f, pmw = -3.0e38f, bb = 0.f;
    if (wave < 2) { const float off = wave ? scr[0] : 0.f;
        bb = bbw + off; cs = ig - bb; pmw = cs;
#pragma unroll
        for (int o = 1; o < 64; o <<= 1) { const float t = __shfl_up(pmw, o); if (lane >= o) pmw = fmaxf(pmw, t); }
        if (lane == 63) scr[8 + wave] = pmw; }
    {
        float o[16]; kv_conv(Ra, cwq, col0, 1.f, o);
        { const float o0[8] = {o[0], o[1], o[2], o[3], o[4], o[5], o[6], o[7]}, o1[8] = {o[8], o[9], o[10], o[11], o[12], o[13], o[14], o[15]};
          *(LAS v4u*)(L + s * 272 + col0 * 2) = pack8(o0); *(LAS v4u*)(L + s * 272 + col0 * 2 + 16) = pack8(o1); }
        kv_conv(Rb, cwq, col0, 1.f, o);
        { const float o0[8] = {o[0], o[1], o[2], o[3], o[4], o[5], o[6], o[7]}, o1[8] = {o[8], o[9], o[10], o[11], o[12], o[13], o[14], o[15]};
          *(LAS v4u*)(L + (64 + s) * 272 + col0 * 2) = pack8(o0); *(LAS v4u*)(L + (64 + s) * 272 + col0 * 2 + 16) = pack8(o1); }
    }
    KvRaw R; kv_load(R, QKb, Vb, c * 128 + s, col0);
    __syncthreads();
    TOC(31) TIC(32)
    bf16x8 Aq[4];
#pragma unroll
    for (int ks = 0; ks < 4; ++ks) Aq[ks] = *(const LAS bf16x8*)(L + (16 * wave + fr) * 272 + (32 * ks + 8 * fq) * 2);
    if (wave < 2) { const float pm = wave ? fmaxf(pmw, scr[8]) : pmw;
        const float mk = ((const float*)(a.ws + OFF_MLM))[item], rr = fmaxf(pm, mk);
        gcs[tid] = cs; grr[tid] = rr; gsc[tid] = expf(mk - rr); gen[tid] = expf(-bb - rr); }
    __syncthreads();
    TOC(32) TIC(33)
    pg8::f32x4 num[8]; float rs[4] = {0.f, 0.f, 0.f, 0.f};
#pragma unroll
    for (int cb = 0; cb < 8; ++cb) num[cb] = (pg8::f32x4){0.f, 0.f, 0.f, 0.f};
    const int jmax = wave >> 2;
#pragma unroll 1
    for (int j = 0; j < 2; ++j) {
        LAS unsigned char* kt = L + ML_KT + (j & 1) * ML_TILE; LAS unsigned char* vt = L + ML_VT + (j & 1) * ML_TILE;
        { float o[16]; kv_conv(R, cwk, col0, 0.08838834764831845f, o);
          const float o0[8] = {o[0], o[1], o[2], o[3], o[4], o[5], o[6], o[7]}, o1[8] = {o[8], o[9], o[10], o[11], o[12], o[13], o[14], o[15]};
          *(LAS v4u*)(kt + s * 272 + col0 * 2) = pack8(o0); *(LAS v4u*)(kt + s * 272 + col0 * 2 + 16) = pack8(o1);
          *(LAS v4u*)(vt + s * 272 + col0 * 2) = R.v[0]; *(LAS v4u*)(vt + s * 272 + col0 * 2 + 16) = R.v[1]; }
        kv_load(R, QKb, Vb, c * 128 + 64 + s, col0);
        __syncthreads();
        if (j <= jmax) {
            const LAS unsigned char* ktb = kt + fr * 272 + 16 * fq; const LAS unsigned char* vtb = vt + (8 * fq + (fr >> 2)) * 272 + 8 * (fr & 3);
            LAS bf16* pwb = Pw + (4 * fq) * 72 + fr; const LAS bf16* pab = Pw + fr * 72 + 8 * fq; const LAS float* grb = grr + 16 * wave + 4 * fq; const int tg0 = 16 * wave + 4 * fq;
            asm volatile("" : "+v"(ktb), "+v"(vtb), "+v"(pwb), "+v"(pab), "+v"(grb));
#pragma unroll
            for (int st = 0; st < 4; ++st) {
                pg8::f32x4 sacc = (pg8::f32x4){0.f, 0.f, 0.f, 0.f};
#pragma unroll
                for (int ks = 0; ks < 4; ++ks) { const bf16x8 Bk = *(const LAS bf16x8*)(ktb + st * 16 * 272 + 64 * ks); sacc = __builtin_amdgcn_mfma_f32_16x16x32_bf16(Aq[ks], Bk, sacc, 0, 0, 0); }
                const int sg = 64 * j + 16 * st + fr; const float csv = gcs[sg];
#pragma unroll
                for (int q = 0; q < 4; ++q) { const float ev = __expf(fminf(csv - grb[q], 0.f)); const float pv = (sg <= tg0 + q) ? sacc[q] * ev : 0.f; rs[q] += pv; pwb[q * 72 + 16 * st] = (bf16)f2bf(pv); }
            }
#pragma unroll
            for (int ks = 0; ks < 2; ++ks) { const bf16x8 Ap = *(const LAS bf16x8*)(pab + 32 * ks);
#pragma unroll
                for (int cb = 0; cb < 8; ++cb) num[cb] = __builtin_amdgcn_mfma_f32_16x16x32_bf16(Ap, tr16_frag(vtb, 32 * ks * 272 + 32 * cb), num[cb], 0, 0, 0); }
        }
    }
    TOC(33) TIC(34)
    v4u ow4[4];
    { const bf16* Op = (const bf16*)(a.ws + OFF_O) + (size_t)(tok0 + 16 * wave + (lane >> 2)) * 512 + h * 128 + (lane & 3) * 8;
#pragma unroll
      for (int i = 0; i < 4; ++i) ow4[i] = *(const v4u*)(Op + 32 * i); }
#pragma unroll
    for (int q = 0; q < 4; ++q) { rs[q] += __shfl_xor(rs[q], 1); rs[q] += __shfl_xor(rs[q], 2); rs[q] += __shfl_xor(rs[q], 4); rs[q] += __shfl_xor(rs[q], 8); }
    float sc_t[4], inv[4]; float ss[4] = {0.f, 0.f, 0.f, 0.f};
    {
        const float* nst = (const float*)(a.ws + OFF_MLN) + (size_t)item * 128 + 8 * fq;
        const bf16* CST = (const bf16*)((const unsigned char*)a.out + OUT_CST) + ((size_t)item * 128 + fr) * 128 + 8 * fq;
        f4 nv[8];
#pragma unroll
        for (int ks = 0; ks < 4; ++ks) { nv[2 * ks] = *(const f4*)(nst + ks * 32); nv[2 * ks + 1] = *(const f4*)(nst + ks * 32 + 4); }
        bf16x8 GA[2][4], GB[2][4];
#define LOAD_C(G, cb0) do { _Pragma("unroll") for (int c_ = 0; c_ < 2; ++c_) _Pragma("unroll") for (int ks = 0; ks < 4; ++ks) G[c_][ks] = *(const bf16x8*)(CST + (size_t)((cb0) + c_) * 16 * 128 + ks * 32); } while (0)
#define COMP_C(G, cb0) do { _Pragma("unroll") for (int c_ = 0; c_ < 2; ++c_) { pg8::f32x4 accC = (pg8::f32x4){0.f, 0.f, 0.f, 0.f}; \
        _Pragma("unroll") for (int ks = 0; ks < 4; ++ks) accC = __builtin_amdgcn_mfma_f32_16x16x32_bf16(Aq[ks], G[c_][ks], accC, 0, 0, 0); \
        _Pragma("unroll") for (int q = 0; q < 4; ++q) { const float v = (num[(cb0) + c_][q] + sc_t[q] * accC[q]) * inv[q]; num[(cb0) + c_][q] = v; ss[q] += v * v; } } } while (0)
        LOAD_C(GA, 0); LOAD_C(GB, 2);
        const unsigned msk = fr == 0 ? 0xffffffffu : 0u;
        pg8::f32x4 accn = (pg8::f32x4){0.f, 0.f, 0.f, 0.f};
#pragma unroll
        for (int ks = 0; ks < 4; ++ks) { const f4 n0 = nv[2 * ks], n1 = nv[2 * ks + 1];
            v4u w; w.x = pk2(n0.x, n0.y) & msk; w.y = pk2(n0.z, n0.w) & msk; w.z = pk2(n1.x, n1.y) & msk; w.w = pk2(n1.z, n1.w) & msk;
            accn = __builtin_amdgcn_mfma_f32_16x16x32_bf16(Aq[ks], __builtin_bit_cast(bf16x8, w), accn, 0, 0, 0); }
#pragma unroll
        for (int q = 0; q < 4; ++q) { const int tg = 16 * wave + 4 * fq + q; sc_t[q] = gsc[tg]; const float qn = __shfl(accn[q], lane & 48); const float den = rs[q] + sc_t[q] * qn; inv[q] = __builtin_amdgcn_rcpf(fmaxf(fabsf(den), gen[tg])); }
        COMP_C(GA, 0); LOAD_C(GA, 4);
        COMP_C(GB, 2); LOAD_C(GB, 6);
        COMP_C(GA, 4); COMP_C(GB, 6);
#undef LOAD_C
#undef COMP_C
    }
    TOC(34) TIC(35)
    { const int nc = next_item & 63, nbh = next_item >> 6, nh = nbh & 3, nb = nbh >> 2; const bf16* nq = (const bf16*)(a.ws + OFF_QK) + (size_t)(nb * SEQ) * 1024 + nh * 128;
      kq_load(Ra, nq, nc * 128 + s, col0); kq_load(Rb, nq, nc * 128 + 64 + s, col0); }
    __syncthreads();
    LAS float* Hw = (LAS float*)(L + wave * 8448);
    const LAS float* ghn = scr + 64;
#pragma unroll
    for (int q = 0; q < 4; ++q) { ss[q] += __shfl_xor(ss[q], 1); ss[q] += __shfl_xor(ss[q], 2); ss[q] += __shfl_xor(ss[q], 4); ss[q] += __shfl_xor(ss[q], 8);
        const float rstd = rsqrtf(ss[q] * (1.f / 128.f) + EPS);
#pragma unroll
        for (int cb = 0; cb < 8; ++cb) Hw[(4 * fq + q) * 132 + cb * 16 + fr] = num[cb][q] * rstd; }
    __syncthreads();
    {
        const int t = lane >> 2, vq = lane & 3;
        const LAS float* hg = ghn + vq * 8;
        bf16* MIX = (bf16*)(a.ws + OFF_H1) + (size_t)(tok0 + 16 * wave + t) * 1024 + h * 128 + vq * 8;
#pragma unroll
        for (int i = 0; i < 4; ++i) { const v4u ow = ow4[i]; const f4 h0 = *(const LAS f4*)(Hw + t * 132 + vq * 8 + 32 * i), h1 = *(const LAS f4*)(Hw + t * 132 + vq * 8 + 32 * i + 4);
            const f4 g0 = *(const LAS f4*)(hg + 32 * i), g1 = *(const LAS f4*)(hg + 32 * i + 4);
            float y[8];
            y[0] = sigmoidf_(bflo(ow.x)) * h0.x * g0.x; y[1] = sigmoidf_(bfhi(ow.x)) * h0.y * g0.y; y[2] = sigmoidf_(bflo(ow.y)) * h0.z * g0.z; y[3] = sigmoidf_(bfhi(ow.y)) * h0.w * g0.w;
            y[4] = sigmoidf_(bflo(ow.z)) * h1.x * g1.x; y[5] = sigmoidf_(bfhi(ow.z)) * h1.y * g1.y; y[6] = sigmoidf_(bflo(ow.w)) * h1.z * g1.z; y[7] = sigmoidf_(bfhi(ow.w)) * h1.w * g1.w;
            *(v4u*)(MIX + 32 * i) = pack8(y); }
    }
    __syncthreads();
    TOC(35) TOC(36)
}

template <int N, int MASK> __device__ __forceinline__ void rs_step(float* v, int lane) {
    const bool hi = (lane & MASK) != 0;
#pragma unroll
    for (int i = 0; i < N; ++i) { const float send = hi ? v[i] : v[i + N], keep = hi ? v[i + N] : v[i]; v[i] = keep + __shfl_xor(send, MASK); }
}
__device__ __forceinline__ void phase7(const KArgs& a, LAS unsigned char* L, int G) {
    const int tid = otid(), lane = tid & 63, wave = __builtin_amdgcn_readfirstlane(tid >> 6);
    LAS float* wrT = (LAS float*)L;
    LAS float* g2l = (LAS float*)(L + 131584);
    LAS unsigned char* le = L + 131584 + 4096;
    LAS int* lcnt = (LAS int*)(L + 131584 + 4096 + 1024);
    LAS float* sc = (LAS float*)(L + 131584 + 4096 + 1024 + 128) + wave * 528;
    const float* wr = a.in[I_WR]; const float* g2 = a.in[I_N2G]; const float* br = a.in[I_BR];
    for (int idx = tid; idx < 1024; idx += 512) g2l[idx] = g2[idx];
    for (int idx = tid; idx < 32768; idx += 512) wrT[(idx & 31) * 1028 + (idx >> 5)] = wr[idx] * g2[idx >> 5];
    const float* X1 = a.in[I_X]; const bf16* MO = (const bf16*)(a.ws + OFF_MO);
    unsigned char* H2 = a.ws + OFF_H2; float* RSTD = (float*)(a.ws + OFF_RSTD2);
    int* ENTE = (int*)(a.ws + OFF_ENTE); float* ENTG = (float*)(a.ws + OFF_ENTG); int* ENTR = (int*)(a.ws + OFF_ENTR); int* CNT = (int*)(a.ws + OFF_CNT);
    const int ti = lane & 31, kh = lane >> 5;
    for (int chunk = blockIdx.x; chunk < 256; chunk += G) {
        if (tid < 32) lcnt[tid] = 0;
        __syncthreads();
        {
            const int t0 = chunk * 256 + wave * 32;
            const float* xrow = X1 + (size_t)(t0 + ti) * DM + 512 * kh; const bf16* mrow = MO + (size_t)(t0 + ti) * DM + 512 * kh; unsigned char* hrow = H2 + (size_t)(t0 + ti) * DM + 512 * kh;
            const LAS float* wl = wrT + ti * 1028 + 512 * kh; const LAS float* gl = g2l + 512 * kh;
            f32x16 acc;
#pragma unroll
            for (int i = 0; i < 16; ++i) acc[i] = 0.f;
            float ssq = 0.f;
            f4 xc[16];
#define X1_LOAD(xr_, mr_, e0) do { _Pragma("unroll") for (int q = 0; q < 16; ++q) xr_[q] = *(const f4*)(xrow + (e0) + 4 * q); _Pragma("unroll") for (int q = 0; q < 8; ++q) mr_[q] = *(const v4u*)(mrow + (e0) + 8 * q); } while (0)
#define X1_ADD(dst, xr_, mr_) do { _Pragma("unroll") for (int q = 0; q < 8; ++q) { dst[2 * q].x = xr_[2 * q].x + bflo(mr_[q].x); dst[2 * q].y = xr_[2 * q].y + bfhi(mr_[q].x); dst[2 * q].z = xr_[2 * q].z + bflo(mr_[q].y); dst[2 * q].w = xr_[2 * q].w + bfhi(mr_[q].y); \
                dst[2 * q + 1].x = xr_[2 * q + 1].x + bflo(mr_[q].z); dst[2 * q + 1].y = xr_[2 * q + 1].y + bfhi(mr_[q].z); dst[2 * q + 1].z = xr_[2 * q + 1].z + bflo(mr_[q].w); dst[2 * q + 1].w = xr_[2 * q + 1].w + bfhi(mr_[q].w); } } while (0)
            { f4 x0[16]; v4u m0[8]; X1_LOAD(x0, m0, 0); X1_ADD(xc, x0, m0); }
#pragma unroll 1
            for (int c = 0; c < 8; ++c) {
                f4 xn[16]; v4u mn[8]; const int ne = 64 * (c < 7 ? c + 1 : 7);
                X1_LOAD(xn, mn, ne);
#pragma unroll
                for (int q4 = 0; q4 < 4; ++q4) { v4u hw;
#pragma unroll
                    for (int qq = 0; qq < 4; ++qq) { const int q = 4 * q4 + qq; const f4 w4 = *(const LAS f4*)(wl + 64 * c + 4 * q), g4 = *(const LAS f4*)(gl + 64 * c + 4 * q); const f4 x = xc[q];
                        acc = __builtin_amdgcn_mfma_f32_32x32x2f32(x.x, w4.x, acc, 0, 0, 0); acc = __builtin_amdgcn_mfma_f32_32x32x2f32(x.y, w4.y, acc, 0, 0, 0);
                        acc = __builtin_amdgcn_mfma_f32_32x32x2f32(x.z, w4.z, acc, 0, 0, 0); acc = __builtin_amdgcn_mfma_f32_32x32x2f32(x.w, w4.w, acc, 0, 0, 0);
                        ssq += (x.x * x.x + x.y * x.y) + (x.z * x.z + x.w * x.w);
                        hw[qq] = pk4_fp8(x.x * g4.x * FP8_ASCALE, x.y * g4.y * FP8_ASCALE, x.z * g4.z * FP8_ASCALE, x.w * g4.w * FP8_ASCALE); }
                    *(v4u*)(hrow + 64 * c + 16 * q4) = hw; }
                X1_ADD(xc, xn, mn);
            }
            ssq += __shfl_xor(ssq, 32);
            const float rstd = rsqrtf(ssq * (1.f / DM) + EPS);
            if (lane < 32) RSTD[t0 + lane] = rstd;
#pragma unroll
            for (int p = 0; p < 2; ++p) {
#pragma unroll
                for (int r8 = 0; r8 < 8; ++r8) { const int r = 8 * p + r8, rowl = (r & 3) + 8 * ((r >> 2) & 1) + 4 * kh; sc[rowl * 33 + ti] = acc[r]; }
                const float rs_t = __shfl(rstd, 16 * p + (lane & 15));
                if (lane < 16) {
                    float v[32];
#pragma unroll
                    for (int e = 0; e < 32; ++e) v[e] = sc[lane * 33 + e] * rs_t + br[e];
                    float tv[4]; int te[4];
#pragma unroll
                    for (int k = 0; k < 4; ++k) { float bv = v[0]; int be = 0;
#pragma unroll
                        for (int e = 1; e < 32; ++e) if (v[e] > bv) { bv = v[e]; be = e; }
                        tv[k] = bv; te[k] = be;
#pragma unroll
                        for (int e = 0; e < 32; ++e) v[e] = (e == be) ? -3.0e38f : v[e]; }
                    const float e1 = __expf(tv[1] - tv[0]), e2 = __expf(tv[2] - tv[0]), e3 = __expf(tv[3] - tv[0]), inv = __builtin_amdgcn_rcpf(1.f + e1 + e2 + e3);
                    const int tl = wave * 32 + 16 * p + lane, tt = chunk * 256 + tl;
                    *(int4*)(ENTE + (size_t)tt * 4) = make_int4(te[0], te[1], te[2], te[3]);
                    *(f4*)(ENTG + (size_t)tt * 4) = (f4){inv, e1 * inv, e2 * inv, e3 * inv};
                    *(LAS unsigned*)(le + tl * 4) = (unsigned)te[0] | ((unsigned)te[1] << 8) | ((unsigned)te[2] << 16) | ((unsigned)te[3] << 24);
                }
            }
        }
        __syncthreads();
#pragma unroll
        for (int q = 0; q < 2; ++q) { const int idx = tid + 512 * q; const int e = le[idx]; const int rk = __hip_atomic_fetch_add(&lcnt[e], 1, __ATOMIC_RELAXED, __HIP_MEMORY_SCOPE_WORKGROUP); ENTR[chunk * 1024 + idx] = rk; }
        __syncthreads();
        if (tid < 32) CNT[chunk * 32 + tid] = lcnt[tid];
        __syncthreads();
    }
}

__device__ __forceinline__ int wsum32(int v) { v += __shfl_xor(v, 1); v += __shfl_xor(v, 2); v += __shfl_xor(v, 4); v += __shfl_xor(v, 8); v += __shfl_xor(v, 16); return v; }
__device__ __forceinline__ int place_preamble(const KArgs& a, LAS unsigned char* L, bool write_tiles) {
    const int tid = otid();
    LAS int* tot = (LAS int*)L; LAS int* pst = tot + 64; LAS int* misc = pst + 96; LAS int* cntl = (LAS int*)(L + 1024);
    const int* CNT = (const int*)(a.ws + OFF_CNT); int* TILEE = (int*)(a.ws + OFF_TILEE); int* NTILE = (int*)(a.ws + OFF_NTILE);
    for (int i = tid; i < 8192; i += 512) cntl[i] = CNT[i];
    __syncthreads();
    if (tid < 64) { const int e = tid & 31;
        int all = 0; for (int c = 0; c < 256; ++c) all += cntl[c * 32 + e];
        int run = 0, best = 1 << 30, bestc = 192, bestrun = 0;
        for (int c = 0; c < 224; ++c) { run += cntl[c * 32 + e];
            if (c + 1 >= 160) { const int nA = wsum32((run + 255) >> 8), nB = wsum32((all - run + 255) >> 8);
                const int cost = ((nA + 31) >> 5) + ((nB + 31) >> 5) + ((nA + 63) >> 6) + ((nB + 63) >> 6);
                if (nA <= 800 && nB <= 544 && cost <= best) { best = cost; bestc = c + 1; bestrun = run; } } }
        if (best == (1 << 30)) { bestrun = 0; for (int c = 0; c < 192; ++c) bestrun += cntl[c * 32 + e]; }
        if (tid < 32) { tot[e] = bestrun; tot[32 + e] = all - bestrun; if (tid == 0) misc[0] = bestc; } }
    __syncthreads();
    if (tid < 2) { const int hf = tid; int run = 0;
        for (int e = 0; e < 32; ++e) { pst[hf * 32 + e] = run; run += ((tot[hf * 32 + e] + 255) >> 8) << 8; }
        misc[1 + hf] = run >> 8;
        if (write_tiles) { NTILE[hf] = run >> 8; if (hf == 0) NTILE[2] = misc[0]; } }
    __syncthreads();
    if (write_tiles) {
        for (int hf = 0; hf < 2; ++hf) for (int i = tid; i < misc[1 + hf]; i += 512) { int e = 0;
#pragma unroll
            for (int q = 1; q < 32; ++q) e = (pst[hf * 32 + q] <= (i << 8) && tot[hf * 32 + q] > 0) ? q : e;
            TILEE[hf * 1024 + i] = e; } }
    return misc[0];
}
__device__ __forceinline__ void phase8(const KArgs& a, LAS unsigned char* L, int G) {
    const int tid = otid();
    LAS int* tot = (LAS int*)L; LAS int* pst = tot + 64; LAS int* base = pst + 64; LAS int* cntl = (LAS int*)(L + 1024);
    const int* ENTE = (const int*)(a.ws + OFF_ENTE); const int* ENTR = (const int*)(a.ws + OFF_ENTR); const float* ENTG = (const float*)(a.ws + OFF_ENTG);
    int* SDEST = (int*)(a.ws + OFF_SDEST); float* RGATE = (float*)(a.ws + OFF_RGATE); int* ROWMAP = (int*)(a.ws + OFF_ROWMAP); float* RSTDS = (float*)(a.ws + OFF_RSTDS); const float* RSTD = (const float*)(a.ws + OFF_RSTD2);
    const int cA = place_preamble(a, L, blockIdx.x == 0);
    if (blockIdx.x == 0 && tid < 64) { const int hf = tid >> 5, t0 = tot[tid], p0 = pst[tid], pe = p0 + (((t0 + 255) >> 8) << 8);
        for (int r = p0 + t0; r < pe; ++r) { ROWMAP[hf * RCAP + r] = 0; RGATE[hf * RCAP + r] = 0.f; RSTDS[hf * RCAP + r] = 0.f; } }
    for (int chunk = blockIdx.x; chunk < 256; chunk += G) {
        const int hf = chunk >= cA ? 1 : 0;
        if (tid < 32) { int s = pst[hf * 32 + tid]; for (int c = hf ? cA : 0; c < chunk; ++c) s += cntl[c * 32 + tid]; base[tid] = s; }
        __syncthreads();
#pragma unroll
        for (int q = 0; q < 2; ++q) { const int gi = chunk * 1024 + tid + 512 * q; const int e = ENTE[gi]; const int d = base[e] + ENTR[gi]; SDEST[gi] = d; RGATE[hf * RCAP + d] = ENTG[gi]; ROWMAP[hf * RCAP + d] = gi >> 2; RSTDS[hf * RCAP + d] = RSTD[gi >> 2]; }
        __syncthreads();
    }
}

__device__ __forceinline__ void combine_half(const KArgs& a, int hf, const unsigned char* YS, int G) {
    const int tid = otid(), lane = tid & 63, wave = tid >> 6;
    const int gw = blockIdx.x * 8 + wave, NGW = G * 8;
    const int* SDEST = (const int*)(a.ws + OFF_SDEST); const float* gf = a.in[I_NFG];
    f4 gv[4];
#pragma unroll
    for (int j = 0; j < 4; ++j) gv[j] = ((const f4*)gf)[lane + 64 * j];
    const int cA = ((const int*)(a.ws + OFF_NTILE))[2], tbeg = hf ? cA * 256 : 0, tend = hf ? T : cA * 256;
    for (int t = tbeg + gw; t < tend; t += NGW) {
        f4* xr = (f4*)(a.out + (size_t)t * DM) + lane; const f4* xin = (const f4*)(a.in[I_X] + (size_t)t * DM) + lane; const v2u* mo8 = (const v2u*)((const bf16*)(a.ws + OFF_MO) + (size_t)t * DM) + lane;
        f4 v[4];
#pragma unroll
        for (int j = 0; j < 4; ++j) { v[j] = xin[64 * j]; const v2u w = mo8[64 * j]; v[j].x += bflo(w.x); v[j].y += bfhi(w.x); v[j].z += bflo(w.y); v[j].w += bfhi(w.y); }
#pragma unroll
        for (int k = 0; k < 4; ++k) { const int d = SDEST[t * 4 + k]; const unsigned* y4 = (const unsigned*)(YS + (size_t)d * DM) + lane;
#pragma unroll
            for (int j = 0; j < 4; ++j) { const int w = (int)y4[64 * j]; const f2 lo = __builtin_amdgcn_cvt_pk_f32_fp8(w, false), hi = __builtin_amdgcn_cvt_pk_f32_fp8(w, true);
                v[j].x += lo.x * (1.f / FP8_YSCALE); v[j].y += lo.y * (1.f / FP8_YSCALE); v[j].z += hi.x * (1.f / FP8_YSCALE); v[j].w += hi.y * (1.f / FP8_YSCALE); } }
        float ss = 0.f;
#pragma unroll
        for (int j = 0; j < 4; ++j) ss += (v[j].x * v[j].x + v[j].y * v[j].y) + (v[j].z * v[j].z + v[j].w * v[j].w);
        const float rstd = rsqrtf(wave_sum(ss) * (1.f / DM) + EPS);
#pragma unroll
        for (int j = 0; j < 4; ++j) xr[64 * j] = v[j] * rstd * gv[j];
    }
}

#define XB_TMO      128
#define XB_XCNT(j)  (256  + 64 * (j))
#define XB_XSUB(j)  (1280 + 64 * (j))
#define XB_XGEN(j)  (2304 + 64 * (j))
#define XB_TOP      3328
#define XB_TOPGEN   3392
#define XCD_BAR_WORDS 3456
#define XB_SPIN_CAP (1u << 18)

__device__ __forceinline__ unsigned xb_ld(unsigned* p)              { return __hip_atomic_load(p, __ATOMIC_RELAXED, __HIP_MEMORY_SCOPE_AGENT); }
__device__ __forceinline__ unsigned xb_add(unsigned* p, unsigned v) { return __hip_atomic_fetch_add(p, v, __ATOMIC_RELAXED, __HIP_MEMORY_SCOPE_AGENT); }
__device__ __forceinline__ unsigned xb_xcc_id() { return (unsigned)__builtin_amdgcn_s_getreg((3 << 11) | 20) & 0xFu; }
#define XB_SPIN(cond, bar) do { unsigned _sp = 0; while (cond) { __builtin_amdgcn_s_sleep(1); \
    if ((++_sp & 255u) == 0u) { if (xb_ld(&(bar)[XB_TMO])) break; if (_sp > XB_SPIN_CAP) { atomicAdd(&(bar)[XB_TMO], 1u); break; } } } } while (0)

struct XcdBarrier {
    unsigned* bar; unsigned x;
    volatile LAS unsigned* st;
};

__device__ __forceinline__ XcdBarrier xcd_barrier_post(unsigned* bar, volatile LAS unsigned* st) {
    XcdBarrier b; b.bar = bar; b.x = xb_xcc_id(); b.st = st;
    if (threadIdx.x == 0) (void)xb_add(&bar[XB_XCNT(b.x)], 1u);
    return b;
}
__device__ __forceinline__ void xcd_barrier_complete(unsigned* bar, unsigned x, unsigned& nloc, unsigned& nx) {
    const unsigned G = gridDim.x * gridDim.y * gridDim.z;
    unsigned sum, cnt, mine, sp = 0u;
    for (;;) {
        sum = 0u; cnt = 0u; mine = 0u;
#pragma unroll
        for (unsigned j = 0; j < 16; ++j) { const unsigned c = xb_ld(&bar[XB_XCNT(j)]); sum += c; cnt += (c > 0u) ? 1u : 0u; mine = (j == x) ? c : mine; }
        if (sum == G) break;
        __builtin_amdgcn_s_sleep(1);
        if ((++sp & 255u) == 0u) { if (xb_ld(&bar[XB_TMO])) break; if (sp > XB_SPIN_CAP) { atomicAdd(&bar[XB_TMO], 1u); break; } }
    }
    nloc = mine > 0u ? mine : 1u; nx = cnt > 0u ? cnt : 1u;
}

__device__ __forceinline__ void xcd_barrier(const XcdBarrier& b) {
    asm volatile("s_waitcnt vmcnt(0)" ::: "memory");
    __syncthreads();
    if (threadIdx.x == 0) {
        unsigned* bar = b.bar;
        __builtin_amdgcn_s_waitcnt(0);
        unsigned nloc = b.st[0], nx = b.st[1];
        if (nloc == 0u) { xcd_barrier_complete(bar, b.x, nloc, nx); b.st[0] = nloc; b.st[1] = nx; }
        const unsigned old = xb_add(&bar[XB_XSUB(b.x)], 1u);
        const unsigned gen = old / nloc;
        if (old + 1u == (gen + 1u) * nloc) {
            __builtin_amdgcn_fence(__ATOMIC_RELEASE, "agent");
            asm volatile("s_waitcnt vmcnt(0)" ::: "memory");
            const unsigned og = xb_add(&bar[XB_TOP], 1u);
            const unsigned tg = og / nx;
            if (og + 1u == (tg + 1u) * nx) xb_add(&bar[XB_TOPGEN], 1u);
            else XB_SPIN(xb_ld(&bar[XB_TOPGEN]) == tg, bar);
            __builtin_amdgcn_fence(__ATOMIC_ACQUIRE, "agent");
            xb_add(&bar[XB_XGEN(b.x)], 1u);
            asm volatile("s_waitcnt vmcnt(0)" ::: "memory");
        } else {
            XB_SPIN(xb_ld(&bar[XB_XGEN(b.x)]) == gen, bar);
            __builtin_amdgcn_fence(__ATOMIC_ACQUIRE, "agent");
            asm volatile("s_waitcnt vmcnt(0)" ::: "memory");
        }
    }
    __syncthreads();
}

#ifdef XCD_CONTIG
#define BX_EXPR ((int)blockIdx.x)
#else
#define BX_EXPR __builtin_amdgcn_readfirstlane((int)MISC[12])
#endif
#ifndef PROBE_MASK
#define PROBE_MASK 0u
#endif
#ifndef PROBE_REPS
#define PROBE_REPS 3
#endif
#ifndef MK_SINGLE
#define MK_SINGLE 1
#endif
__device__ __forceinline__ void touch_buffer(const unsigned char* p, size_t bytes, int G) {
    const size_t per = bytes / (size_t)G; const v4u* q = (const v4u*)(p + per * blockIdx.x) + otid();
    v4u acc = (v4u){0u, 0u, 0u, 0u};
    for (size_t i = 0; i < per / (512 * 16); i += 8) {
        v4u t[8];
#pragma unroll
        for (int k = 0; k < 8; ++k) t[k] = q[(i + k) * 512];
#pragma unroll
        for (int k = 0; k < 8; ++k) { acc.x |= t[k].x; acc.y |= t[k].y; acc.z |= t[k].z; acc.w |= t[k].w; }
    }
    asm volatile("" :: "v"(acc.x | acc.y | acc.z | acc.w));
}
typedef const __attribute__((address_space(4))) KArgs* KArgsP;
__device__ __forceinline__ KArgs kargs() {
#if defined(__HIP_DEVICE_COMPILE__)
    KArgsP p = (KArgsP)__builtin_amdgcn_kernarg_segment_ptr(); asm volatile("" : "+s"(p)); KArgs r; __builtin_memcpy(&r, (const __attribute__((address_space(4))) void*)p, sizeof(KArgs)); return r;
#else
    return KArgs{};
#endif
}
__global__ void __launch_bounds__(512, 2) mk_fwd(KArgs a_in) {
    extern __shared__ __attribute__((aligned(16))) unsigned char lds_raw[];
    LAS unsigned char* L = (LAS unsigned char*)lds_raw;
    cg::grid_group grid = cg::this_grid();
    const int ph_lo = a_in.ph_lo, ph_hi = a_in.ph_hi;
    volatile LAS unsigned* MISC = (volatile LAS unsigned*)(L + LDS_BYTES - 64);
    if (otid() < 16) MISC[otid()] = 0u;
    __syncthreads();
    XcdBarrier xbar = xcd_barrier_post((unsigned*)a_in.ws, MISC);
    if (otid() == 0) { MISC[10] = xb_add((unsigned*)a_in.ws + 3584 + 64 * (xbar.x & 7u), 1u); MISC[11] = xbar.x & 7u; MISC[12] = blockIdx.x; }
    __syncthreads();
#define IN(k) (ph_lo <= (k) && (k) < ph_hi)
#define SEAM(k) do { if (IN(k) && IN((k) + 1)) { if ((k) == 0) { grid.sync(); \
        if (otid() == 0) { bool ok = (gridDim.x == 256); for (int j_ = 0; j_ < 8; ++j_) ok = ok && (xb_ld((unsigned*)a_in.ws + 3584 + 64 * j_) == 32u); if (ok) MISC[12] = MISC[10] * 8u + MISC[11]; } __syncthreads(); } \
        else xcd_barrier(xbar); } } while (0)
#define PEND(k) do { if ((PROBE_MASK >> (k)) & 1u) { const unsigned long long t1_ = __builtin_amdgcn_s_memrealtime(); while (__builtin_amdgcn_s_memrealtime() < t1_ + (PROBE_REPS - 1) * (t1_ - t0_)) __builtin_amdgcn_s_sleep(8); } } while (0)
#define REP(k) for (int rep_ = 0, nrep_ = (((PROBE_MASK >> (k)) & 1u) ? PROBE_REPS : 1); rep_ < nrep_; ++rep_)
#define GBX const unsigned long long t0_ = PROBE_MASK ? __builtin_amdgcn_s_memrealtime() : 0ull; (void)t0_; const int G = gridDim.x, bx = BX_EXPR; const KArgs a = kargs(); unsigned char* ws = a.ws; (void)G; (void)bx; (void)ws
    if (IN(0)) { GBX; REP(0) phase0(a, L, G); }
    SEAM(0);
    if (IN(1)) { GBX; REP(1) {
        s5_expand(a, G);
        pg8::Gemm g{(const bf16*)(ws + OFF_H1), (const bf16*)(ws + OFF_WIN), 1024, 1024, 1024, nullptr, 0, 0}; pg8::StaticOrder S; S.init(T, 2560, G, bx);
        EpiInProj E{(bf16*)(ws + OFF_QK), (bf16*)(ws + OFF_V), (bf16*)(ws + OFF_O), (bf16*)(ws + OFF_UG)};
        pg8::gemm_phase<EpiInProj, pg8::StaticOrder, true, true, false, false, true, true>(L, g, S, E); }
    }
    SEAM(1);
    if (IN(2)) { GBX;
        REP(16) { if (G == 256) {
                const int slot = bx >> 3, x = bx & 7;
                if (slot < 16) { const int re = x + 8 * slot; for (int k = 0; k < 6; ++k) mlstm_state_item(a, L, re + 128 * k); }
                else { const int rn = x + 8 * (slot - 16); for (int k = 0; k < 10; ++k) mlstm_state_item(a, L, 768 + rn + 128 * k); } }
            else for (int item = bx; item < 2048; item += G) mlstm_state_item(a, L, item); }
        pg8::Gemm g{(const bf16*)(ws + OFF_UG) + 128, (const bf16*)(ws + OFF_S5P), 1152, 1024, 1024, nullptr, 0, 0}; S5EOrder S{G, bx};
        EpiS5E E{(float*)(ws + OFF_S5E)};
        REP(17) pg8::gemm_phase<EpiS5E, S5EOrder, true, true>(L, g, S, E);
    }
    SEAM(2);
    if (IN(3)) { GBX; REP(3) phase3(a, L, G); }
    SEAM(3);
    if (IN(4)) { GBX;
        REP(18) { int h_loaded = -1; KvRaw Ra, Rb;
            if (bx < 2048) { const int it0 = bx, c0 = it0 & 63, bh0 = it0 >> 6; const bf16* q0 = (const bf16*)(ws + OFF_QK) + (size_t)((bh0 >> 2) * SEQ) * 1024 + (bh0 & 3) * 128; const int s_ = otid() >> 3, col_ = (otid() & 7) * 16;
                kq_load(Ra, q0, c0 * 128 + s_, col_); kq_load(Rb, q0, c0 * 128 + 64 + s_, col_); }
            for (int item = bx; item < 2048; item += G) mlstm_out_item(a, L, item, item + G < 2048 ? item + G : item, Ra, Rb, h_loaded); }
        pg8::Gemm g{(const bf16*)(ws + OFF_UG), (const bf16*)(ws + OFF_S5M), 1152, 1152, 1152, nullptr, 0, 0}; S5YOrder S{G, bx};
        EpiS5Y E{(const bf16*)(ws + OFF_UG), a.in[I_DSKIP], (bf16*)(ws + OFF_YSG)};
        REP(19) pg8::gemm_phase<EpiS5Y, S5YOrder, true, true>(L, g, S, E);
    }
    SEAM(4);
    if (IN(5)) { GBX; REP(5) {
        pg8::Gemm g{(const bf16*)(ws + OFF_YSG), (const bf16*)(ws + OFF_WGLU), 512, 512, 512, nullptr, 0, 0}; pg8::StaticOrder S; S.init(T, 512, G, bx);
        EpiGlu E{(const bf16*)(ws + OFF_YSG), a.in[I_BGLU], (bf16*)(ws + OFF_H1)};
        pg8::gemm_phase<EpiGlu, pg8::StaticOrder, true, true>(L, g, S, E); }
    }
    SEAM(5);
    if (IN(6)) { GBX; REP(6) {
        pg8::Gemm g{(const bf16*)(ws + OFF_H1), (const bf16*)(ws + OFF_WOUT), 1024, 1024, 1024, nullptr, 0, 0}; pg8::StaticOrder S; S.init(T, 1024, G, bx);
        EpiOut E{(bf16*)(ws + OFF_MO)};
        pg8::gemm_phase<EpiOut, pg8::StaticOrder, true, true>(L, g, S, E); }
    }
    SEAM(6);
    if (IN(7)) { GBX; REP(7) phase7(a, L, G); }
    SEAM(7);
    if (IN(8)) { GBX; REP(8) phase8(a, L, G); }
    SEAM(8);
#pragma unroll 1
    for (int hf = 0; hf < 2; ++hf) {
        const int pb = 9 + 2 * hf;
        if (IN(pb)) { GBX;
            const int ntile = ((const int*)(ws + OFF_NTILE))[hf];
            pg8::Gemm g{(const bf16*)(ws + OFF_H2), (const bf16*)(ws + OFF_WGU), 1024, 1024, 1024, (const int*)(ws + OFF_ROWMAP) + hf * RCAP, 0, 0}; MoeOrder S{(const int*)(ws + OFF_TILEE) + hf * 1024, ntile, 8, G, bx, (unsigned*)ws + 4096 + 512 * (2 * hf)};
            EpiMoeGU E{a.in[I_BGU], ws + OFF_R1, (const float*)(ws + OFF_RSTDS) + hf * RCAP};
#ifdef TOUCH_WGU
            touch_buffer(ws + OFF_WGU, (size_t)134217728, G);
#endif
            REP(pb) pg8::gemm_phase<EpiMoeGU, MoeOrder, true, true, true, true, false, true>(L, g, S, E);
        }
        if (IN(pb) && hf == 1) { GBX; combine_half(a, 0, ws + OFF_R2, G); PEND(pb); }
        SEAM(pb);
        if (IN(pb + 1)) { GBX;
            const int ntile = ((const int*)(ws + OFF_NTILE))[hf];
            pg8::Gemm g{(const bf16*)(ws + OFF_R1), (const bf16*)(ws + OFF_WDN), 1024, 1024, 1024, nullptr, 1, 1}; MoeOrder S{(const int*)(ws + OFF_TILEE) + hf * 1024, ntile, 4, G, bx, (unsigned*)ws + 4096 + 512 * (2 * hf + 1)};
            EpiMoeDN E{a.in[I_BDN], (const float*)(ws + OFF_RGATE) + hf * RCAP, ws + OFF_R2};
            REP(pb + 1) pg8::gemm_phase<EpiMoeDN, MoeOrder, true, true, false, true, true, true>(L, g, S, E);
        }
        SEAM(pb + 1);
    }
    if (IN(13)) { GBX; combine_half(a, 1, ws + OFF_R2, G); PEND(13); }
    if (PROBE_SECT && blockIdx.x == 0 && otid() == 0) { const unsigned long long t1_ = __builtin_amdgcn_s_memrealtime(), w_ = (unsigned long long)(*PROBE_LDS_WORD) * PROBE_SCALE; while (__builtin_amdgcn_s_memrealtime() - t1_ < w_) __builtin_amdgcn_s_sleep(8); }
#undef IN
#undef SEAM
#undef GBX
#undef PEND
#undef REP
}

extern "C" void kernel_launch(void* const* d_in, const int* in_sizes, int n_in, void* d_out, int out_size, void* d_ws, size_t ws_size, hipStream_t stream) {
    static int grid = 0;
    if (grid == 0) {
        if (n_in != 26 || out_size != T * DM || ws_size < WS_NEED) { fprintf(stderr, "kernel_launch: unexpected problem (n_in %d, out %d, ws %zu)\n", n_in, out_size, ws_size); grid = -1; return; }
        int dev = 0, cus = 0, per_cu = 0;
        (void)hipGetDevice(&dev); (void)hipDeviceGetAttribute(&cus, hipDeviceAttributeMultiprocessorCount, dev);
        if (hipFuncSetAttribute((const void*)mk_fwd, hipFuncAttributeMaxDynamicSharedMemorySize, LDS_BYTES) != hipSuccess) { fprintf(stderr, "kernel_launch: hipFuncSetAttribute failed\n"); grid = -1; return; }
        if (hipOccupancyMaxActiveBlocksPerMultiprocessor(&per_cu, (const void*)mk_fwd, 512, LDS_BYTES) != hipSuccess || per_cu < 1) { fprintf(stderr, "kernel_launch: occupancy query says %d\n", per_cu); per_cu = 1; }
        (void)hipGetLastError();
        grid = cus;
    }
    if (grid < 0) return;
    if (hipMemsetAsync(d_ws, 0, 32768, stream) != hipSuccess) { fprintf(stderr, "kernel_launch: memset failed\n"); return; }
    KArgs a{};
    for (int i = 0; i < 26; ++i) a.in[i] = (const float*)d_in[i];
    a.out = (float*)d_out; a.ws = (unsigned char*)d_ws;
#if MK_SINGLE
    a.ph_lo = 0; a.ph_hi = NPH;
    void* args[] = {&a};
    hipError_t e = hipLaunchCooperativeKernel((const void*)mk_fwd, dim3(grid), dim3(512), args, LDS_BYTES, stream);
    if (e != hipSuccess) fprintf(stderr, "cooperative launch failed: %s (grid %d)\n", hipGetErrorString(e), grid);
#else
    for (int p = 0; p < NPH; ++p) { a.ph_lo = p; a.ph_hi = p + 1; hipLaunchKernelGGL(mk_fwd, dim3(grid), dim3(512), LDS_BYTES, stream, a); }
#endif
}
```

```cpp
#include <hip/hip_runtime.h>
#include <hip/hip_cooperative_groups.h>
#include <cstdio>
#include <cstdint>
namespace cg = cooperative_groups;
__device__ __forceinline__ int otid() { int t = (int)threadIdx.x; asm volatile("" : "+v"(t)); return t; }

#ifndef PROBE_SECT
#define PROBE_SECT 0
#endif
#ifndef PROBE_SCALE
#define PROBE_SCALE 16
#endif
#define PROBE_LDS_WORD ((volatile __attribute__((address_space(3))) unsigned*)(155648 - 32))
#define TIC(id) unsigned long long tic_##id = 0; if (PROBE_SECT == (id)) { __builtin_amdgcn_sched_barrier(0); tic_##id = __builtin_amdgcn_s_memrealtime(); __builtin_amdgcn_sched_barrier(0); }
#define TOC(id) if (PROBE_SECT == (id)) { __builtin_amdgcn_sched_barrier(0); asm volatile("s_waitcnt vmcnt(0) lgkmcnt(0)" ::: "memory"); const unsigned d_ = (unsigned)(__builtin_amdgcn_s_memrealtime() - tic_##id); if (blockIdx.x == 0 && threadIdx.x == 0) *PROBE_LDS_WORD += d_; __builtin_amdgcn_sched_barrier(0); }
namespace pg8 {
#define PG8_LAS __attribute__((address_space(3)))
typedef unsigned short bf16_t;
typedef short bf16x8 __attribute__((ext_vector_type(8)));
typedef float f32x4 __attribute__((ext_vector_type(4)));
typedef unsigned u32x4 __attribute__((ext_vector_type(4)));
typedef long lx2 __attribute__((ext_vector_type(2)));
constexpr int BM = 256, BK = 64, HALF = 128, HTB = HALF * BK * 2  , STAGE_BYTES = 8 * HTB, NXCD = 8, WGM = 8;

__host__ __device__ __forceinline__ int lds_byte(int r, int c) { const int st = (r >> 4) * 2 + (c >> 5), rr = r & 15, cc = c & 31, ob = rr * 64 + cc * 2; return st * 1024 + (ob ^ (((ob >> 9) & 1) << 5)); }
__host__ __device__ __forceinline__ void stage_rc(int b, int& R, int& C) { const int st = b / 1024, sb = b % 1024, swz = sb ^ (((sb >> 9) & 1) << 5); R = (st >> 1) * 16 + swz / 64; C = (st & 1) * 32 + (swz % 64) / 2; }
__host__ __device__ __forceinline__ int perm32(int rho) { const int n = rho >> 4, i = rho & 15; return 8 * (i >> 2) + 4 * n + (i & 3); }

struct Unit { int pm, pn, rd, nt; };
struct Gemm { const bf16_t* A; const bf16_t* Bt; int lda, ldb, K; const int* rowmap; int blkA, blkB; };

struct StaticOrder {
    int nM, nN, nwg, G, c;
    __host__ __device__ void init(int M, int N, int G_, int c_) { nM = M / BM; nN = N / BM; nwg = nM * nN; G = G_; c = c_; }
    __host__ __device__ bool next(int i, Unit& u) const {
        const long L = (long)i * G + c; if (L >= nwg) return false;
        int wgid = (int)L; { const int q = nwg / NXCD, r = nwg % NXCD, xcd = wgid % NXCD, off = wgid / NXCD; wgid = (xcd < r ? xcd * (q + 1) : r * (q + 1) + (xcd - r) * q) + off; }
        const int nig = WGM * nN, gid = wgid / nig, fm = gid * WGM, gsz = (nM - fm) < WGM ? (nM - fm) : WGM;
        u.pm = fm + ((wgid % nig) % gsz); u.pn = (wgid % nig) / gsz; u.rd = 0; u.nt = 0; return true;
    }
    __device__ __forceinline__ void a_ready(const Unit&) const {}
    __device__ __forceinline__ void done(const Unit&) const {}
};

__device__ __forceinline__ unsigned cvt_pk_bf16(float lo, float hi) { unsigned r; asm volatile("v_cvt_pk_bf16_f32 %0, %1, %2" : "=v"(r) : "v"(lo), "v"(hi)); return r; }

template <class Epi, class Sched, bool ALIGN_EPI = false, bool SP2 = false, bool GATHER = false, bool FP8 = false, bool BLKA = false, bool BLKB = false>
__device__ __forceinline__ void gemm_phase(PG8_LAS unsigned char* lds, const Gemm g, const Sched& S, const Epi& E) {
    const int tid = otid(), wid = __builtin_amdgcn_readfirstlane(tid >> 6), lane = tid & 63, wr = wid >> 2, wc = wid & 3, fr = lane & 15, fq = lane >> 4;
    const int K = g.K, nt = FP8 ? K / 128 : K / BK;
    const unsigned ldaB = BLKA ? 128u : (FP8 ? (unsigned)g.lda : 2u * (unsigned)g.lda), ldbB = BLKB ? 128u : (FP8 ? (unsigned)g.ldb : 2u * (unsigned)g.ldb);
    unsigned voffA[2], voffB[2];
#pragma unroll
    for (int i = 0; i < 2; ++i) { int R, C; stage_rc(tid * 16 + i * 8192, R, C); const int Rb = Epi::PERM ? ((R & ~31) + perm32(R & 31)) : R;
        voffA[i] = (unsigned)R * ldaB + 2u * (unsigned)C; voffB[i] = (unsigned)Rb * ldbB + 2u * (unsigned)C; }
    int gR0, gC0; stage_rc(tid * 16, gR0, gC0);
    const unsigned gRowBytes = ldaB, gColBytes = (unsigned)gC0 * 2u;
    unsigned offC[2][2], offN[2][2];
#define PG8_GOFF(dst, pm) do { if constexpr (GATHER) { _Pragma("unroll") for (int _h = 0; _h < 2; ++_h) _Pragma("unroll") for (int _i = 0; _i < 2; ++_i) \
        dst[_h][_i] = (unsigned)g.rowmap[(pm) * BM + _h * HALF + _i * 64 + gR0] * gRowBytes + gColBytes; } } while (0)
    constexpr size_t kstepA = BLKA ? (size_t)32768 : (size_t)128, kstepB = BLKB ? (size_t)32768 : (size_t)128;
    const size_t hstepA = (size_t)HALF * ldaB, hstepB = (size_t)HALF * ldbB;
    const size_t tstepA = BLKA ? (size_t)nt * 32768 : 2 * hstepA, tstepB = BLKB ? (size_t)nt * 32768 : 2 * hstepB;
    const unsigned ldsw = (unsigned)wid * 1024u;
    const int aoff = lds_byte(wr * 64 + fr, fq * 8), boff = lds_byte(wc * 32 + fr, fq * 8);
#define PG8_SA(b, h) (((b) * 2 + (h)) * HTB)
#define PG8_SB(b, h) ((4 + (b) * 2 + (h)) * HTB)
#ifndef PG8_AUX
#define PG8_AUX 0
#endif
#define PG8_STAGE(bufoff, gbase, voff) do { _Pragma("unroll") for (int _i = 0; _i < 2; ++_i) \
        __builtin_amdgcn_global_load_lds((const unsigned*)((const char*)(gbase) + (voff)[_i]), (PG8_LAS unsigned*)(lds + (bufoff) + ldsw + _i * 8192), 16, 0, FP8 ? PG8_AUX : 0); } while (0)
#define PG8_LDA(dst, b, h) do { _Pragma("unroll") for (int m = 0; m < 4; ++m) _Pragma("unroll") for (int k = 0; k < 2; ++k) dst[m][k] = *(const PG8_LAS bf16x8*)(lds + PG8_SA(b, h) + aoff + m * 2048 + k * 1024); } while (0)
#define PG8_LDB(dst, b, h) do { _Pragma("unroll") for (int n = 0; n < 2; ++n) _Pragma("unroll") for (int k = 0; k < 2; ++k) dst[n][k] = *(const PG8_LAS bf16x8*)(lds + PG8_SB(b, h) + boff + n * 2048 + k * 1024); } while (0)
#define PG8_MMA(ai, bj, At, Bt) do { __builtin_amdgcn_s_setprio(1); _Pragma("unroll") for (int m = 0; m < 4; ++m) _Pragma("unroll") for (int n = 0; n < 2; ++n) _Pragma("unroll") for (int k = 0; k < 2; ++k) { \
        if constexpr (FP8) { const lx2 a_ = __builtin_bit_cast(lx2, At[m][k]), b_ = __builtin_bit_cast(lx2, Bt[n][k]);        \
            acc[ai][bj][m][n] = __builtin_amdgcn_mfma_f32_16x16x32_fp8_fp8(b_.x, a_.x, acc[ai][bj][m][n], 0, 0, 0); acc[ai][bj][m][n] = __builtin_amdgcn_mfma_f32_16x16x32_fp8_fp8(b_.y, a_.y, acc[ai][bj][m][n], 0, 0, 0); } \
        else acc[ai][bj][m][n] = __builtin_amdgcn_mfma_f32_16x16x32_bf16(Bt[n][k], At[m][k], acc[ai][bj][m][n], 0, 0, 0); } __builtin_amdgcn_s_setprio(0); } while (0)
#define PG8_WAIT_V(n) asm volatile("s_waitcnt vmcnt(" #n ")" ::: "memory")
#define PG8_WAIT_L(n) asm volatile("s_waitcnt lgkmcnt(" #n ")" ::: "memory")
#define PG8_BAR __builtin_amdgcn_s_barrier()
#define PG8_SCHED __builtin_amdgcn_sched_barrier(0)
    Unit cur, nxt; int ui = 0;
    if (!S.next(0, cur)) return;
    f32x4 acc[2][2][4][2];
#pragma unroll
    for (int a = 0; a < 2; ++a)
#pragma unroll
        for (int b = 0; b < 2; ++b)
#pragma unroll
            for (int m = 0; m < 4; ++m)
#pragma unroll
                for (int n = 0; n < 2; ++n) acc[a][b][m][n] = (f32x4){0.f, 0.f, 0.f, 0.f};
    bf16x8 At[4][2], B0[2][2], B1[2][2];
    const char* cA = (const char*)g.A + (size_t)cur.pm * tstepA; const char* cB = (const char*)g.Bt + (size_t)cur.pn * tstepB;
    S.a_ready(cur);
    const char* gA = (const char*)g.A;
    PG8_GOFF(offC, cur.pm);
#define PG8_STAGE_A(bufoff, h, ptr_plain, kt, offs) do { if constexpr (GATHER) PG8_STAGE(bufoff, gA + (size_t)(kt) * kstepA, (offs)[h]); else PG8_STAGE(bufoff, ptr_plain, voffA); } while (0)
    if constexpr (SP2) {
        PG8_STAGE(PG8_SB(0, 0), cB, voffB); PG8_STAGE(PG8_SB(0, 1), cB + hstepB, voffB); PG8_STAGE_A(PG8_SA(0, 0), 0, cA, 0, offC); PG8_STAGE_A(PG8_SA(0, 1), 1, cA + hstepA, 0, offC);
        if (wr == 1) PG8_BAR;
        PG8_WAIT_V(2); PG8_BAR;
        PG8_STAGE(PG8_SB(1, 0), cB + kstepB, voffB); PG8_STAGE_A(PG8_SA(1, 0), 0, cA + kstepA, 1, offC); PG8_STAGE(PG8_SB(1, 1), cB + hstepB + kstepB, voffB);
        PG8_WAIT_V(6); PG8_BAR;
    } else {
        PG8_STAGE(PG8_SB(0, 0), cB, voffB); PG8_STAGE(PG8_SA(0, 0), cA, voffA); PG8_STAGE(PG8_SB(0, 1), cB + hstepB, voffB); PG8_STAGE(PG8_SA(0, 1), cA + hstepA, voffA);
        if (wr == 1) PG8_BAR;
        PG8_WAIT_V(4); PG8_BAR;
        PG8_STAGE(PG8_SB(1, 0), cB + kstepB, voffB); PG8_STAGE(PG8_SA(1, 0), cA + kstepA, voffA); PG8_STAGE(PG8_SB(1, 1), cB + hstepB + kstepB, voffB);
        PG8_WAIT_V(6); PG8_BAR;
    }
    for (;;) {
        const bool has_next = S.next(ui + 1, nxt);
        if constexpr (GATHER) { if (has_next) PG8_GOFF(offN, nxt.pm); else { _Pragma("unroll") for (int _h = 0; _h < 2; ++_h) _Pragma("unroll") for (int _i = 0; _i < 2; ++_i) offN[_h][_i] = offC[_h][_i]; } }
        const char* nA = has_next ? (const char*)g.A + (size_t)nxt.pm * tstepA : cA; const char* nB = has_next ? (const char*)g.Bt + (size_t)nxt.pn * tstepB : cB;
#ifndef PROBE_KREP_G
#define PROBE_KREP_G 1
#endif
#ifndef PROBE_KREP_N
#define PROBE_KREP_N 1
#endif
#ifndef PROBE_KREP_D
#define PROBE_KREP_D 1
#endif
        constexpr int KREP = GATHER ? PROBE_KREP_G : (FP8 ? PROBE_KREP_D : PROBE_KREP_N);
        TIC(21)
        for (int pass = 0; pass < KREP; ++pass) {
        const bool fpass = (pass == KREP - 1);
        if (KREP > 1 && pass > 0) {
#pragma unroll
            for (int a = 0; a < 2; ++a)
#pragma unroll
                for (int b = 0; b < 2; ++b)
#pragma unroll
                    for (int m = 0; m < 4; ++m)
#pragma unroll
                        for (int n = 0; n < 2; ++n) acc[a][b][m][n] = (f32x4){0.f, 0.f, 0.f, 0.f}; }
        const int ntc = cur.nt > 0 ? cur.nt : nt;
        for (int t = 0; t < ntc; t += 2) {
            const bool lastk = (t == ntc - 2), last = lastk && fpass;
#ifdef PROBE_SHARED
            const char* xA = (!fpass && FP8 && !GATHER) ? (const char*)g.A + (size_t)(cur.pm & ~7) * tstepA : cA; const char* xB = (!fpass && FP8 && !GATHER) ? (const char*)g.Bt + (size_t)(cur.pn & ~3) * tstepB : cB;
#else
            const char* xA = cA; const char* xB = cB;
#endif
            const char* a1 = xA + (size_t)(t + 1) * kstepA;
            const char* a2 = lastk ? (fpass ? nA : cA) : xA + (size_t)(t + 2) * kstepA; const char* b2 = lastk ? (fpass ? nB : cB) : xB + (size_t)(t + 2) * kstepB;
            const char* a3 = a2 + kstepA; const char* b3 = b2 + kstepB;
            if (last && has_next) S.a_ready(nxt);
            if constexpr (SP2) {
            const int k2 = lastk ? 0 : t + 2;
            unsigned offS[2][2];
            if constexpr (GATHER) { _Pragma("unroll") for (int _h = 0; _h < 2; ++_h) _Pragma("unroll") for (int _i = 0; _i < 2; ++_i) offS[_h][_i] = last ? offN[_h][_i] : offC[_h][_i]; }
            PG8_LDB(B0, 0, 0); PG8_LDB(B1, 0, 1); PG8_SCHED; PG8_LDA(At, 0, 0); PG8_STAGE_A(PG8_SA(1, 1), 1, a1 + hstepA, t + 1, offC);
            PG8_WAIT_V(8); PG8_WAIT_L(0); PG8_BAR; PG8_MMA(0, 0, At, B0); PG8_MMA(0, 1, At, B1); PG8_BAR; PG8_SCHED;
            PG8_LDA(At, 0, 1); PG8_STAGE(PG8_SB(0, 0), b2, voffB); PG8_STAGE(PG8_SB(0, 1), b2 + hstepB, voffB); PG8_STAGE_A(PG8_SA(0, 0), 0, a2, k2, offS);
            PG8_WAIT_V(8); PG8_WAIT_L(0); PG8_BAR; PG8_MMA(1, 0, At, B0); PG8_MMA(1, 1, At, B1); PG8_BAR; PG8_SCHED;
            PG8_LDB(B0, 1, 0); PG8_LDB(B1, 1, 1); PG8_SCHED; PG8_LDA(At, 1, 0); PG8_STAGE_A(PG8_SA(0, 1), 1, a2 + hstepA, k2, offS);
            PG8_WAIT_V(8); PG8_WAIT_L(0); PG8_BAR; PG8_MMA(0, 0, At, B0); PG8_MMA(0, 1, At, B1); PG8_BAR; PG8_SCHED;
            PG8_LDA(At, 1, 1); PG8_STAGE(PG8_SB(1, 0), b3, voffB); PG8_STAGE(PG8_SB(1, 1), b3 + hstepB, voffB); PG8_STAGE_A(PG8_SA(1, 0), 0, a3, k2 + 1, offS);
            PG8_WAIT_V(8); PG8_WAIT_L(0); PG8_BAR; PG8_MMA(1, 0, At, B0); PG8_MMA(1, 1, At, B1); PG8_BAR; PG8_SCHED;
            } else {
            PG8_LDB(B0, 0, 0); PG8_SCHED; PG8_LDA(At, 0, 0); PG8_STAGE(PG8_SA(1, 1), a1 + hstepA, voffA);
            PG8_WAIT_L(8); PG8_BAR; PG8_WAIT_L(0); PG8_MMA(0, 0, At, B0); PG8_BAR; PG8_SCHED;
            PG8_LDB(B1, 0, 1); PG8_STAGE(PG8_SB(0, 0), b2, voffB);
            PG8_BAR; PG8_WAIT_L(0); PG8_MMA(0, 1, At, B1); PG8_BAR;
            PG8_LDA(At, 0, 1); PG8_STAGE(PG8_SA(0, 0), a2, voffA);
            PG8_BAR; PG8_WAIT_L(0); PG8_MMA(1, 0, At, B0); PG8_BAR; PG8_SCHED;
            PG8_STAGE(PG8_SB(0, 1), b2 + hstepB, voffB);
            PG8_WAIT_V(6); PG8_BAR; PG8_MMA(1, 1, At, B1); PG8_BAR;
            PG8_LDB(B0, 1, 0); PG8_SCHED; PG8_LDA(At, 1, 0); PG8_STAGE(PG8_SA(0, 1), a2 + hstepA, voffA);
            PG8_WAIT_L(8); PG8_BAR; PG8_WAIT_L(0); PG8_MMA(0, 0, At, B0); PG8_BAR; PG8_SCHED;
            PG8_LDB(B1, 1, 1); PG8_STAGE(PG8_SB(1, 0), b3, voffB);
            PG8_BAR; PG8_WAIT_L(0); PG8_MMA(0, 1, At, B1); PG8_BAR;
            PG8_LDA(At, 1, 1); PG8_STAGE(PG8_SA(1, 0), a3, voffA);
            PG8_BAR; PG8_WAIT_L(0); PG8_MMA(1, 0, At, B0); PG8_BAR; PG8_SCHED;
            PG8_STAGE(PG8_SB(1, 1), b3 + hstepB, voffB);
            PG8_WAIT_V(6); PG8_BAR; PG8_MMA(1, 1, At, B1); PG8_BAR;
            }
        }
        }
        if (FP8) { TOC(21) }
        if constexpr (ALIGN_EPI) { if (wr == 0) PG8_BAR; }
        TIC(22)
        E(acc, cur, wr, wc, fr, fq); S.done(cur);
        if (FP8) { TOC(22) }
        if (!has_next) break;
#pragma unroll
        for (int a = 0; a < 2; ++a)
#pragma unroll
            for (int b = 0; b < 2; ++b)
#pragma unroll
                for (int m = 0; m < 4; ++m)
#pragma unroll
                    for (int n = 0; n < 2; ++n) acc[a][b][m][n] = (f32x4){0.f, 0.f, 0.f, 0.f};
        cur = nxt; cA = nA; cB = nB; ++ui;
        if constexpr (GATHER) { _Pragma("unroll") for (int _h = 0; _h < 2; ++_h) _Pragma("unroll") for (int _i = 0; _i < 2; ++_i) offC[_h][_i] = offN[_h][_i]; }
        if constexpr (ALIGN_EPI) { if (wr == 1) PG8_BAR; }
    }
    PG8_WAIT_V(0);
    if constexpr (!ALIGN_EPI) { if (wr == 0) PG8_BAR; }
    PG8_BAR;
#undef PG8_SA
#undef PG8_SB
#undef PG8_STAGE
#undef PG8_STAGE_A
#undef PG8_GOFF
#undef PG8_LDA
#undef PG8_LDB
#undef PG8_MMA
#undef PG8_WAIT_V
#undef PG8_WAIT_L
#undef PG8_BAR
#undef PG8_SCHED
}
}

#define LAS __attribute__((address_space(3)))
typedef unsigned short bf16;
typedef float f4 __attribute__((ext_vector_type(4)));
typedef float f2 __attribute__((ext_vector_type(2)));
typedef float f32x16 __attribute__((ext_vector_type(16)));
typedef short bf16x8 __attribute__((ext_vector_type(8)));
typedef unsigned v4u __attribute__((ext_vector_type(4)));
typedef unsigned v2u __attribute__((ext_vector_type(2)));

constexpr int T = 65536, DM = 1024, SEQ = 8192, NPROJ = 2568;
constexpr int NE = 32;
constexpr float EPS = 1e-6f;
constexpr int NPH = 14;
constexpr int RCAP = 229376;
constexpr int LDS_BYTES = 155648;

constexpr size_t MiB = (size_t)1 << 20;
constexpr size_t OFF_GATES = 1 * MiB, OFF_MLG = 3 * MiB, OFF_MLA = 3 * MiB + 16384, OFF_MLM = 3 * MiB + 32768;
constexpr size_t OFF_MLNP = 4 * MiB, OFF_MLN = 6 * MiB, OFF_KT = 8 * MiB, OFF_S5E = 10 * MiB, OFF_RSTD2 = 26 * MiB;
constexpr size_t OFF_ENTE = 27 * MiB, OFF_ENTG = 28 * MiB, OFF_ENTR = 29 * MiB, OFF_SDEST = 30 * MiB;
constexpr size_t OFF_CNT = 31 * MiB, OFF_TILEE = 31 * MiB + 65536, OFF_NTILE = 31 * MiB + 131072, OFF_RGATE = 32 * MiB;
constexpr size_t OFF_WIN = 64 * MiB, OFF_WGLU = 70 * MiB, OFF_WOUT = 71 * MiB, OFF_WGU = 74 * MiB, OFF_WDN = 202 * MiB;
constexpr size_t OFF_S5M = 266 * MiB, OFF_S5P = 338 * MiB, OFF_H1 = 354 * MiB, OFF_QK = 482 * MiB, OFF_V = 610 * MiB, OFF_O = 674 * MiB, OFF_UG = 738 * MiB, OFF_YSG = 810 * MiB;
constexpr size_t OFF_H2 = 266 * MiB, OFF_R1 = 394 * MiB, OFF_R2 = 620 * MiB, WS_NEED = 1002 * MiB;
constexpr size_t OFF_MO = 874 * MiB;
constexpr size_t OUT_X1LO = 0;
constexpr size_t OFF_ROWMAP = 34 * MiB, OFF_RSTDS = 36 * MiB;
constexpr size_t OFF_QC = 874 * MiB, OFF_VT = 938 * MiB, OFF_KCTW = 810 * MiB;
constexpr size_t OUT_UP = 0, OUT_CST = 134217728;

struct KArgs { const float* in[26]; float* out; unsigned char* ws; int ph_lo, ph_hi; };
enum { I_X = 0, I_N1G, I_WIN, I_BIF, I_CONVW, I_CONVB, I_HNG, I_LRE, I_LIM, I_LDT, I_BRE, I_BIM, I_CRE, I_CIM, I_DSKIP, I_WGLU, I_BGLU, I_WOUT, I_N2G, I_WR, I_BR, I_WGU, I_BGU, I_WDN, I_BDN, I_NFG };

typedef float f32x2_t_ __attribute__((ext_vector_type(2))); typedef __bf16 bf16x2_t_ __attribute__((ext_vector_type(2)));
__device__ __forceinline__ unsigned f2bf(float f) { const f32x2_t_ v = {f, 0.f}; const bf16x2_t_ b = __builtin_convertvector(v, bf16x2_t_); return __builtin_bit_cast(unsigned, b) & 0xffffu; }
typedef float f32x2_t __attribute__((ext_vector_type(2))); typedef __bf16 bf16x2_t __attribute__((ext_vector_type(2)));
__device__ __forceinline__ unsigned pk2(float lo, float hi) { const f32x2_t v = {lo, hi}; const bf16x2_t b = __builtin_convertvector(v, bf16x2_t); return __builtin_bit_cast(unsigned, b); }
__device__ __forceinline__ unsigned pk4_fp8(float a, float b, float c, float d) { int r = 0; r = __builtin_amdgcn_cvt_pk_fp8_f32(a, b, r, false); r = __builtin_amdgcn_cvt_pk_fp8_f32(c, d, r, true); return (unsigned)r; }
constexpr float FP8_WSCALE = 64.f, FP8_ASCALE = 4.f, FP8_YSCALE = 16.f;
__device__ __forceinline__ float bf2f(unsigned b) { return __builtin_bit_cast(float, b << 16); }
__device__ __forceinline__ float bflo(unsigned w) { return __builtin_bit_cast(float, w << 16); }
__device__ __forceinline__ float bfhi(unsigned w) { return __builtin_bit_cast(float, w & 0xffff0000u); }
__device__ __forceinline__ float wave_sum(float v) {
#pragma unroll
    for (int o = 1; o < 64; o <<= 1) v += __shfl_xor(v, o);
    return v;
}
__device__ __forceinline__ float wave_max(float v) {
#pragma unroll
    for (int o = 1; o < 64; o <<= 1) v = fmaxf(v, __shfl_xor(v, o));
    return v;
}
__device__ __forceinline__ float sigmoidf_(float x) { return __builtin_amdgcn_rcpf(1.f + __expf(-x)); }
__device__ __forceinline__ float siluf_(float x) { return x * __builtin_amdgcn_rcpf(1.f + __expf(-x)); }
__device__ __forceinline__ float logsigmoidf_(float x) { return x >= 0.f ? -log1pf(expf(-x)) : x - log1pf(expf(x)); }
__device__ __forceinline__ float gelu_tanh(float x) { const float z = 0.7978845608028654f * (x + 0.044715f * x * x * x); const float e = __expf(2.f * z); return 0.5f * x * (2.f - 2.f * __builtin_amdgcn_rcpf(e + 1.f)); }
#define LDS_WAIT() asm volatile("s_waitcnt lgkmcnt(0)" ::: "memory")

struct TrLoc { const float* src; bf16* dst; int ldw, ldt; int fp8; int blk_n; };
__device__ __forceinline__ void tr_load(const TrLoc& t, int lane, float (&v)[32]) {
    unsigned off = (unsigned)((lane >> 5) * t.ldw + (lane & 31)) * 4u; const unsigned st = 8u * (unsigned)t.ldw;
#pragma unroll
    for (int i = 0; i < 32; ++i) { v[i] = *(const float*)((const char*)t.src + off); off += st; }
}
__device__ __forceinline__ void tr_finish(const TrLoc& t, LAS float* scr, int lane, const float (&v)[32]) {
#pragma unroll
    for (int i = 0; i < 32; ++i) scr[(2 * i + (lane >> 5)) * 33 + (lane & 31)] = v[i];
    LDS_WAIT(); asm volatile("" ::: "memory");
    const int c = lane & 7;
    if (t.fp8) {
#pragma unroll
        for (int j = 0; j < 4; ++j) { const int n = (lane >> 3) + 8 * j; const LAS float* s = scr + (8 * c) * 33 + n;
            v2u o; o.x = pk4_fp8(s[0 * 33] * FP8_WSCALE, s[1 * 33] * FP8_WSCALE, s[2 * 33] * FP8_WSCALE, s[3 * 33] * FP8_WSCALE); o.y = pk4_fp8(s[4 * 33] * FP8_WSCALE, s[5 * 33] * FP8_WSCALE, s[6 * 33] * FP8_WSCALE, s[7 * 33] * FP8_WSCALE);
            *(v2u*)((unsigned char*)t.dst + (size_t)n * t.ldt + 8 * c) = o; }
    } else {
#pragma unroll
        for (int j = 0; j < 4; ++j) { const int n = (lane >> 3) + 8 * j; const LAS float* s = scr + (8 * c) * 33 + n;
            v4u o; o.x = pk2(s[0 * 33], s[1 * 33]); o.y = pk2(s[2 * 33], s[3 * 33]); o.z = pk2(s[4 * 33], s[5 * 33]); o.w = pk2(s[6 * 33], s[7 * 33]);
            *(v4u*)(t.dst + (size_t)n * t.ldt + 8 * c) = o; }
    }
    LDS_WAIT(); asm volatile("" ::: "memory");
}

__device__ __forceinline__ void lam_pow(float lre, float lim, float dt, int n, float& re, float& im) {
    const float mag = expf(lre * dt * (float)n);
    double th = (double)lim * (double)dt * (double)n;
    th -= 6.283185307179586476925 * rint(th * 0.15915494309189533577);
    const float s = __sinf((float)th), c = __cosf((float)th);
    re = mag * c; im = mag * s;
}

__device__ __forceinline__ void phase0(const KArgs& a, LAS unsigned char* L, int G) {
    const int tid = otid(), lane = tid & 63, wave = __builtin_amdgcn_readfirstlane(tid >> 6);
    const int gw = blockIdx.x * 8 + wave, NGW = G * 8;
    unsigned char* ws = a.ws;
    TIC(11)
    {
        LAS float* scr = (LAS float*)(L + wave * 8448);
        constexpr int N_IN = 16 * 80, N_GLU = 8 * 16, N_OUT = 16 * 32, N_GU = 32 * 16 * 64, N_DN = 32 * 16 * 32;
        constexpr int NITEMS = N_IN + N_GLU + N_OUT + N_GU + N_DN;
        auto locate = [&](int it) -> TrLoc {
            int r = it;
            if (r < N_IN) { const int kb = r / 80, nb = r % 80, n0 = 32 * nb, sc = n0 < 2048 ? n0 : n0 + 8;
                return TrLoc{a.in[I_WIN] + (size_t)(64 * kb) * NPROJ + sc, (bf16*)(ws + OFF_WIN) + (((size_t)(n0 >> 8) * 16 + kb) * 256 + (n0 & 255)) * 64, NPROJ, 64, 0, n0 & 255}; } r -= N_IN;
            if (r < N_GLU) { const int kb = r / 16, nb = r % 16, n0 = 32 * nb;
                return TrLoc{a.in[I_WGLU] + (size_t)(64 * kb) * 512 + n0, (bf16*)(ws + OFF_WGLU) + (size_t)n0 * 512 + 64 * kb, 512, 512, 0, -1}; } r -= N_GLU;
            if (r < N_OUT) { const int kb = r / 32, nb = r % 32, n0 = 32 * nb;
                return TrLoc{a.in[I_WOUT] + (size_t)(64 * kb) * 1024 + n0, (bf16*)(ws + OFF_WOUT) + (size_t)n0 * 1024 + 64 * kb, 1024, 1024, 0, -1}; } r -= N_OUT;
            if (r < N_GU) { const int e = r / 1024, q = r % 1024, kb = q / 64, nb = q % 64, n0 = 32 * nb, pn = n0 >> 8, wi = n0 & 255;
                const int sc = wi < 128 ? 128 * pn + wi : 1024 + 128 * pn + (wi - 128);
                return TrLoc{a.in[I_WGU] + (size_t)e * 1024 * 2048 + (size_t)(64 * kb) * 2048 + sc, (bf16*)(ws + OFF_WGU + ((((size_t)e * 8 + (n0 >> 8)) * 8 + (kb >> 1)) * 256 + (n0 & 255)) * 128 + (kb & 1) * 64), 2048, 128, 1, n0 & 255}; } r -= N_GU;
            { const int e = r / 512, q = r % 512, kb = q / 32, nb = q % 32, n0 = 32 * nb;
                return TrLoc{a.in[I_WDN] + (size_t)e * 1024 * 1024 + (size_t)(64 * kb) * 1024 + n0, (bf16*)(ws + OFF_WDN + ((((size_t)e * 4 + (n0 >> 8)) * 8 + (kb >> 1)) * 256 + (n0 & 255)) * 128 + (kb & 1) * 64), 1024, 128, 1, n0 & 255}; }
        };
        if (gw < NITEMS) {
            TrLoc cur = locate(gw); float vc[32]; tr_load(cur, lane, vc);
            for (int it = gw; it < NITEMS; it += NGW) {
                const int itn = (it + NGW < NITEMS) ? it + NGW : it;
                const TrLoc nxt = locate(itn); float vn[32]; tr_load(nxt, lane, vn);
                tr_finish(cur, scr, lane, vc);
                cur = nxt;
#pragma unroll
                for (int i = 0; i < 32; ++i) vc[i] = vn[i];
            }
        }
    }
    TOC(11)
    __syncthreads();
    TIC(12)
    {
        const float* lre = a.in[I_LRE]; const float* lim = a.in[I_LIM]; const float* ldt = a.in[I_LDT];
        const float* bre = a.in[I_BRE]; const float* bim = a.in[I_BIM]; const float* cre = a.in[I_CRE]; const float* cim = a.in[I_CIM];
        const int gt = blockIdx.x * 512 + tid, GT = G * 512;
        float* KT = (float*)(ws + OFF_KT);
        for (int task4 = gt; task4 < 32 * 64 * 16 * 4; task4 += GT) {
            const int task = task4 >> 2, pq = task4 & 3;
            const int g = task >> 10, tau = (task >> 4) & 63, i = task & 15;
            const float dt = expf(ldt[g]);
            float acc[16];
#pragma unroll
            for (int j = 0; j < 16; ++j) acc[j] = 0.f;
#pragma unroll 2
            for (int p = pq * 16; p < pq * 16 + 16; ++p) {
                const float lr = lre[g * 64 + p], li = lim[g * 64 + p];
                float pr, pi; lam_pow(lr, li, dt, tau, pr, pi);
                float l1r, l1i; lam_pow(lr, li, dt, 1, l1r, l1i);
                const float nr = l1r - 1.f, ni = l1i, den = lr * lr + li * li;
                const float fr = (nr * lr + ni * li) / den, fi = (ni * lr - nr * li) / den;
                const float cr = cre[(g * 16 + i) * 64 + p], ci = cim[(g * 16 + i) * 64 + p];
                const float zr = cr * pr - ci * pi, zi = cr * pi + ci * pr;
                const float yr = zr * fr - zi * fi, yi = zr * fi + zi * fr;
                const f4* br4 = (const f4*)(bre + (size_t)(g * 64 + p) * 16); const f4* bi4 = (const f4*)(bim + (size_t)(g * 64 + p) * 16);
#pragma unroll
                for (int q = 0; q < 4; ++q) { const f4 x = br4[q], y = bi4[q];
                    acc[4 * q + 0] += yr * x.x - yi * y.x; acc[4 * q + 1] += yr * x.y - yi * y.y; acc[4 * q + 2] += yr * x.z - yi * y.z; acc[4 * q + 3] += yr * x.w - yi * y.w; }
            }
#pragma unroll
            for (int j = 0; j < 16; ++j) { acc[j] += __shfl_xor(acc[j], 1); acc[j] += __shfl_xor(acc[j], 2); }
            if (pq == 0) { f4* o = (f4*)(KT + (size_t)task * 16);
#pragma unroll
                for (int q = 0; q < 4; ++q) o[q] = (f4){acc[4 * q], acc[4 * q + 1], acc[4 * q + 2], acc[4 * q + 3]}; }
        }
        bf16* S5P = (bf16*)(ws + OFF_S5P);
        for (int task = gt; task < 32 * 64 * 64; task += GT) {
            const int g = task >> 12, p = (task >> 6) & 63, s = task & 63;
            const float dt = expf(ldt[g]); const float lr = lre[g * 64 + p], li = lim[g * 64 + p];
            float pr, pi; lam_pow(lr, li, dt, 63 - s, pr, pi);
            float l1r, l1i; lam_pow(lr, li, dt, 1, l1r, l1i);
            const float nr = l1r - 1.f, ni = l1i, den = lr * lr + li * li;
            const float fr = (nr * lr + ni * li) / den, fi = (ni * lr - nr * li) / den;
            const float yr = pr * fr - pi * fi, yi = pr * fi + pi * fr;
            const float* br = bre + (size_t)(g * 64 + p) * 16; const float* bi = bim + (size_t)(g * 64 + p) * 16;
            unsigned ore[8], oim[8];
#pragma unroll
            for (int j = 0; j < 8; ++j) { const float x0 = br[2 * j], y0 = bi[2 * j], x1 = br[2 * j + 1], y1 = bi[2 * j + 1];
                ore[j] = pk2(yr * x0 - yi * y0, yr * x1 - yi * y1); oim[j] = pk2(yr * y0 + yi * x0, yr * y1 + yi * x1); }
            v4u* d0 = (v4u*)(S5P + ((size_t)(g * 256 + 2 * p) * 1024 + s * 16)); v4u* d1 = (v4u*)(S5P + ((size_t)(g * 256 + 2 * p + 1) * 1024 + s * 16));
            d0[0] = (v4u){ore[0], ore[1], ore[2], ore[3]}; d0[1] = (v4u){ore[4], ore[5], ore[6], ore[7]};
            d1[0] = (v4u){oim[0], oim[1], oim[2], oim[3]}; d1[1] = (v4u){oim[4], oim[5], oim[6], oim[7]};
        }
        for (int task = gt; task < 32 * 128 * 128; task += GT) {
            const int g = task >> 14, r = (task >> 7) & 127, c8 = task & 127;
            *(v4u*)(S5P + ((size_t)(g * 256 + 128 + r) * 1024 + c8 * 8)) = (v4u){0u, 0u, 0u, 0u};
        }
        bf16* S5M = (bf16*)(ws + OFF_S5M);
        for (int task = gt; task < 32 * 64 * 64; task += GT) {
            const int g = task >> 12, t = (task >> 6) & 63, p = task & 63;
            const float dt = expf(ldt[g]); const float lr = lre[g * 64 + p], li = lim[g * 64 + p];
            float pr, pi; lam_pow(lr, li, dt, t + 1, pr, pi);
#pragma unroll
            for (int i = 0; i < 16; ++i) { const float cr = cre[(g * 16 + i) * 64 + p], ci = cim[(g * 16 + i) * 64 + p];
                *(unsigned*)(S5M + ((size_t)(g * 1024 + t * 16 + i) * 1152 + 2 * p)) = pk2(cr * pr - ci * pi, -(cr * pi + ci * pr)); }
        }
    }
    TOC(12) TIC(13)
    {
        LAS float* wif = (LAS float*)(L + 69632);
        const float* win = a.in[I_WIN];
        for (int idx = tid; idx < 8192; idx += 512) wif[idx] = win[(size_t)(idx >> 3) * NPROJ + 2048 + (idx & 7)];
        __syncthreads();
        const float* x = a.in[I_X]; const float* g1 = a.in[I_N1G]; const float* bif = a.in[I_BIF];
        bf16* H1 = (bf16*)(ws + OFF_H1); float* GATES = (float*)(ws + OFF_GATES);
        f4 gv[4];
#pragma unroll
        for (int j = 0; j < 4; ++j) gv[j] = ((const f4*)g1)[lane + 64 * j];
        for (int m0 = 2 * gw; m0 < T; m0 += 2 * NGW) {
            f4 v2[2][4];
#pragma unroll
            for (int rr = 0; rr < 2; ++rr) { const f4* xr = (const f4*)(x + (size_t)(m0 + rr) * DM) + lane;
#pragma unroll
                for (int j = 0; j < 4; ++j) v2[rr][j] = xr[64 * j]; }
#pragma unroll
            for (int rr = 0; rr < 2; ++rr) { const int m = m0 + rr;
            f4 v[4]; float ss = 0.f;
#pragma unroll
            for (int j = 0; j < 4; ++j) { v[j] = v2[rr][j]; ss += (v[j].x * v[j].x + v[j].y * v[j].y) + (v[j].z * v[j].z + v[j].w * v[j].w); }
            const float rstd = rsqrtf(wave_sum(ss) * (1.f / DM) + EPS);
            float ga[8];
#pragma unroll
            for (int c = 0; c < 8; ++c) ga[c] = 0.f;
            bf16* o8 = H1 + (((size_t)(m >> 8) * 16 + (lane >> 4)) * 256 + (m & 255)) * 64 + 4 * (lane & 15);
#pragma unroll
            for (int j = 0; j < 4; ++j) { v[j] = v[j] * rstd * gv[j];
                *(unsigned long long*)(o8 + (size_t)j * 4 * 256 * 64) = (unsigned long long)pk2(v[j].x, v[j].y) | ((unsigned long long)pk2(v[j].z, v[j].w) << 32);
#pragma unroll
                for (int e = 0; e < 4; ++e) { const int k = 4 * lane + 256 * j + e; const f4 w0 = *(const LAS f4*)(wif + k * 8), w1 = *(const LAS f4*)(wif + k * 8 + 4); const float hv = v[j][e];
                    ga[0] += hv * w0.x; ga[1] += hv * w0.y; ga[2] += hv * w0.z; ga[3] += hv * w0.w; ga[4] += hv * w1.x; ga[5] += hv * w1.y; ga[6] += hv * w1.z; ga[7] += hv * w1.w; }
            }
            float r4[4], r2[2], r1;
            { const bool hi = lane & 32;
#pragma unroll
              for (int i = 0; i < 4; ++i) { const float send = hi ? ga[i] : ga[i + 4], keep = hi ? ga[i + 4] : ga[i]; r4[i] = keep + __shfl_xor(send, 32); } }
            { const bool hi = lane & 16;
#pragma unroll
              for (int i = 0; i < 2; ++i) { const float send = hi ? r4[i] : r4[i + 2], keep = hi ? r4[i + 2] : r4[i]; r2[i] = keep + __shfl_xor(send, 16); } }
            { const bool hi = lane & 8; const float send = hi ? r2[0] : r2[1], keep = hi ? r2[1] : r2[0]; r1 = keep + __shfl_xor(send, 8); }
            r1 += __shfl_xor(r1, 4); r1 += __shfl_xor(r1, 2); r1 += __shfl_xor(r1, 1);
            if ((lane & 7) == 0) { const int c = (lane >> 3) & 7; GATES[(size_t)m * 8 + c] = r1 + bif[c]; }
            }
        }
    }
    TOC(13)
}

__device__ __forceinline__ void s5_expand(const KArgs& a, int G) {
    const float* KT = (const float*)(a.ws + OFF_KT); bf16* S5M = (bf16*)(a.ws + OFF_S5M);
    const int gt = blockIdx.x * 512 + otid(), GT = G * 512;
    for (int task = gt; task < 32 * 1024 * 64; task += GT) {
        const int s = task & 63, row = task >> 6, g = row >> 10, t = (row >> 4) & 63, i = row & 15;
        if (s >= ((t >> 4) + 1) * 16) continue;
        v4u o0 = (v4u){0u, 0u, 0u, 0u}, o1 = o0;
        if (s <= t) { const f4* k4 = (const f4*)(KT + ((size_t)((g * 64 + (t - s)) * 16 + i)) * 16); const f4 a0 = k4[0], a1 = k4[1], a2 = k4[2], a3 = k4[3];
            o0 = (v4u){pk2(a0.x, a0.y), pk2(a0.z, a0.w), pk2(a1.x, a1.y), pk2(a1.z, a1.w)}; o1 = (v4u){pk2(a2.x, a2.y), pk2(a2.z, a2.w), pk2(a3.x, a3.y), pk2(a3.z, a3.w)}; }
        v4u* d = (v4u*)(S5M + ((size_t)row * 1152 + 128 + s * 16)); d[0] = o0; d[1] = o1;
    }
}

using pg8::Unit; using pg8::cvt_pk_bf16;
struct EpiInProj {
    static constexpr bool PERM = true;
    bf16 *QK, *V, *O, *UG;
    __device__ __forceinline__ void operator()(const pg8::f32x4 (&acc)[2][2][4][2], const Unit& u, int wr, int wc, int fr, int fq) const {
        const int row0 = u.pm * 256 + wr * 64 + fr, c0 = wc * 32 + 8 * fq;
#pragma unroll
        for (int ai = 0; ai < 2; ++ai)
#pragma unroll
            for (int m = 0; m < 4; ++m) { const int row = row0 + ai * 128 + m * 16;
#pragma unroll
                for (int bj = 0; bj < 2; ++bj) { const pg8::f32x4 v0 = acc[ai][bj][m][0], v1 = acc[ai][bj][m][1];
                    v4u w; w.x = cvt_pk_bf16(v0[0], v0[1]); w.y = cvt_pk_bf16(v0[2], v0[3]); w.z = cvt_pk_bf16(v1[0], v1[1]); w.w = cvt_pk_bf16(v1[2], v1[3]);
                    const int col = c0 + bj * 128;
                    bf16* dst;
                    if (u.pn < 4) dst = QK + (size_t)row * 1024 + u.pn * 256 + col;
                    else if (u.pn < 6) dst = V + (size_t)row * 512 + (u.pn - 4) * 256 + col;
                    else if (u.pn < 8) dst = O + (size_t)row * 512 + (u.pn - 6) * 256 + col;
                    else { const int uc = (u.pn - 8) * 256 + col, g = uc >> 4, j = uc & 15; dst = UG + ((size_t)(g * 1024 + (row >> 6)) * 1152 + 128 + (row & 63) * 16 + j); }
                    *(v4u*)dst = w; } }
    }
};
struct EpiS5E {
    static constexpr bool PERM = false;
    float* E;
    __device__ __forceinline__ void operator()(const pg8::f32x4 (&acc)[2][2][4][2], const Unit& u, int wr, int wc, int fr, int fq) const {
        const int row0 = u.pm * 256 + wr * 64 + fr, col0 = wc * 32 + 4 * fq;
#pragma unroll
        for (int ai = 0; ai < 2; ++ai)
#pragma unroll
            for (int m = 0; m < 4; ++m) { float* rowp = E + (size_t)(row0 + ai * 128 + m * 16) * 128 + col0;
#pragma unroll
                for (int n = 0; n < 2; ++n) *(pg8::f32x4*)(rowp + n * 16) = acc[ai][0][m][n]; }
    }
};
struct EpiS5Y {
    static constexpr bool PERM = true;
    const bf16* UG; const float* dskip; bf16* YSG;
    __device__ __forceinline__ void operator()(const pg8::f32x4 (&acc)[2][2][4][2], const Unit& u, int wr, int wc, int fr, int fq) const {
        const int g = u.pm >> 2, row0 = u.pm * 256 + wr * 64 + fr, c0 = (u.pn & 3) * 256 + wc * 32 + 8 * fq;
#pragma unroll
        for (int ai = 0; ai < 2; ++ai)
#pragma unroll
            for (int m = 0; m < 4; ++m) { const int row = row0 + ai * 128 + m * 16, chunk = row & 1023;
#pragma unroll
                for (int bj = 0; bj < 2; ++bj) { const int n = c0 + bj * 128, t = n >> 4, i0 = n & 15;
                    const v4u uw = *(const v4u*)(UG + ((size_t)row * 1152 + 128 + n));
                    const f4 d0 = *(const f4*)(dskip + g * 16 + i0), d1 = *(const f4*)(dskip + g * 16 + i0 + 4);
                    const pg8::f32x4 v0 = acc[ai][bj][m][0], v1 = acc[ai][bj][m][1];
                    float y[8];
                    y[0] = v0[0] + d0.x * bflo(uw.x); y[1] = v0[1] + d0.y * bfhi(uw.x); y[2] = v0[2] + d0.z * bflo(uw.y); y[3] = v0[3] + d0.w * bfhi(uw.y);
                    y[4] = v1[0] + d1.x * bflo(uw.z); y[5] = v1[1] + d1.y * bfhi(uw.z); y[6] = v1[2] + d1.z * bflo(uw.w); y[7] = v1[3] + d1.w * bfhi(uw.w);
#pragma unroll
                    for (int e = 0; e < 8; ++e) y[e] = gelu_tanh(y[e]);
                    v4u w; w.x = cvt_pk_bf16(y[0], y[1]); w.y = cvt_pk_bf16(y[2], y[3]); w.z = cvt_pk_bf16(y[4], y[5]); w.w = cvt_pk_bf16(y[6], y[7]);
                    *(v4u*)(YSG + ((size_t)(chunk * 64 + t) * 512 + g * 16 + i0)) = w; } }
    }
};
struct EpiGlu {
    static constexpr bool PERM = true;
    const bf16* YSG; const float* bglu; bf16* MIX;
    __device__ __forceinline__ void operator()(const pg8::f32x4 (&acc)[2][2][4][2], const Unit& u, int wr, int wc, int fr, int fq) const {
        const int row0 = u.pm * 256 + wr * 64 + fr, c0 = u.pn * 256 + wc * 32 + 8 * fq;
#pragma unroll
        for (int ai = 0; ai < 2; ++ai)
#pragma unroll
            for (int m = 0; m < 4; ++m) { const int row = row0 + ai * 128 + m * 16;
#pragma unroll
                for (int bj = 0; bj < 2; ++bj) { const int col = c0 + bj * 128;
                    const v4u yw = *(const v4u*)(YSG + (size_t)row * 512 + col);
                    const f4 b0 = *(const f4*)(bglu + col), b1 = *(const f4*)(bglu + col + 4);
                    const pg8::f32x4 v0 = acc[ai][bj][m][0], v1 = acc[ai][bj][m][1];
                    float y[8];
                    y[0] = bflo(yw.x) * sigmoidf_(v0[0] + b0.x); y[1] = bfhi(yw.x) * sigmoidf_(v0[1] + b0.y); y[2] = bflo(yw.y) * sigmoidf_(v0[2] + b0.z); y[3] = bfhi(yw.y) * sigmoidf_(v0[3] + b0.w);
                    y[4] = bflo(yw.z) * sigmoidf_(v1[0] + b1.x); y[5] = bfhi(yw.z) * sigmoidf_(v1[1] + b1.y); y[6] = bflo(yw.w) * sigmoidf_(v1[2] + b1.z); y[7] = bfhi(yw.w) * sigmoidf_(v1[3] + b1.w);
                    v4u w; w.x = cvt_pk_bf16(y[0], y[1]); w.y = cvt_pk_bf16(y[2], y[3]); w.z = cvt_pk_bf16(y[4], y[5]); w.w = cvt_pk_bf16(y[6], y[7]);
                    *(v4u*)(MIX + (size_t)row * 1024 + 512 + col) = w; } }
    }
};
struct EpiOut {
    static constexpr bool PERM = true;
    unsigned short* X1HI; unsigned char* X1LO; const float* X;
    __device__ __forceinline__ void operator()(const pg8::f32x4 (&acc)[2][2][4][2], const Unit& u, int wr, int wc, int fr, int fq) const {
        const int row0 = u.pm * 256 + wr * 64 + fr, c0 = u.pn * 256 + wc * 32 + 8 * fq;
#pragma unroll
        for (int ai = 0; ai < 2; ++ai) {
            f4 xv[4][2][2];
#pragma unroll
            for (int m = 0; m < 4; ++m)
#pragma unroll
                for (int bj = 0; bj < 2; ++bj) { const float* xp = X + (size_t)(row0 + ai * 128 + m * 16) * 1024 + c0 + bj * 128; xv[m][bj][0] = *(const f4*)xp; xv[m][bj][1] = *(const f4*)(xp + 4); }
#pragma unroll
            for (int m = 0; m < 4; ++m)
#pragma unroll
                for (int bj = 0; bj < 2; ++bj) { const pg8::f32x4 v0 = acc[ai][bj][m][0], v1 = acc[ai][bj][m][1]; const f4 x0 = xv[m][bj][0], x1 = xv[m][bj][1];
                    const unsigned b0 = __float_as_uint(x0.x + v0[0]), b1 = __float_as_uint(x0.y + v0[1]), b2 = __float_as_uint(x0.z + v0[2]), b3 = __float_as_uint(x0.w + v0[3]);
                    const unsigned b4 = __float_as_uint(x1.x + v1[0]), b5 = __float_as_uint(x1.y + v1[1]), b6 = __float_as_uint(x1.z + v1[2]), b7 = __float_as_uint(x1.w + v1[3]);
                    v4u w; w.x = __builtin_amdgcn_perm(b1, b0, 0x07060302u); w.y = __builtin_amdgcn_perm(b3, b2, 0x07060302u); w.z = __builtin_amdgcn_perm(b5, b4, 0x07060302u); w.w = __builtin_amdgcn_perm(b7, b6, 0x07060302u);
                    v2u l; l.x = __builtin_amdgcn_perm(__builtin_amdgcn_perm(b3, b2, 0x0c0c0501u), __builtin_amdgcn_perm(b1, b0, 0x0c0c0501u), 0x05040100u);
                    l.y = __builtin_amdgcn_perm(__builtin_amdgcn_perm(b7, b6, 0x0c0c0501u), __builtin_amdgcn_perm(b5, b4, 0x0c0c0501u), 0x05040100u);
                    const size_t o = (size_t)(row0 + ai * 128 + m * 16) * 1024 + c0 + bj * 128;
                    *(v4u*)(X1HI + o) = w; *(v2u*)(X1LO + o) = l; } }
    }
};
struct EpiMoeGU {
    static constexpr bool PERM = true;
    const float* bgu; unsigned char* ACT; const float* rstds;
    __device__ __forceinline__ void operator()(const pg8::f32x4 (&acc)[2][2][4][2], const Unit& u, int wr, int wc, int fr, int fq) const {
        const int e = u.pn >> 3, pnl = u.pn & 7, row0 = u.pm * 256 + wr * 64 + fr, c0 = pnl * 128 + wc * 32 + 8 * fq;
        const float* bg = bgu + (size_t)e * 2048 + c0; const float* bu = bg + 1024;
        const f4 g0 = *(const f4*)bg, g1 = *(const f4*)(bg + 4), u0 = *(const f4*)bu, u1 = *(const f4*)(bu + 4);
        const float gb[8] = {g0.x, g0.y, g0.z, g0.w, g1.x, g1.y, g1.z, g1.w}, ub[8] = {u0.x, u0.y, u0.z, u0.w, u1.x, u1.y, u1.z, u1.w};
        constexpr float inv = 1.f / (FP8_WSCALE * FP8_ASCALE);
#pragma unroll
        for (int ai = 0; ai < 2; ++ai)
#pragma unroll
            for (int m = 0; m < 4; ++m) { const int row = row0 + ai * 128 + m * 16; const float ri = rstds[row] * inv;
                float y[8];
#pragma unroll
                for (int n = 0; n < 2; ++n)
#pragma unroll
                    for (int q = 0; q < 4; ++q) { const int k = 4 * n + q;
                        const float gate = fminf(acc[ai][0][m][n][q] * ri + gb[k], 7.0f); const float up = fminf(fmaxf(acc[ai][1][m][n][q] * ri + ub[k], -7.0f), 7.0f);
                        y[k] = (up + 1.0f) * gate * sigmoidf_(1.702f * gate) * FP8_ASCALE; }
                v2u w; w.x = pk4_fp8(y[0], y[1], y[2], y[3]); w.y = pk4_fp8(y[4], y[5], y[6], y[7]);
                *(v2u*)(ACT + ((size_t)(u.pm * 8 + pnl) * 256 + (row & 255)) * 128 + (wc * 32 + 8 * fq)) = w; }
    }
};
struct EpiMoeDN {
    static constexpr bool PERM = true;
    const float* bdn; const float* rgate; unsigned char* YS;
    __device__ __forceinline__ void operator()(const pg8::f32x4 (&acc)[2][2][4][2], const Unit& u, int wr, int wc, int fr, int fq) const {
        const int e = u.pn >> 2, pnl = u.pn & 3, row0 = u.pm * 256 + wr * 64 + fr, c0 = pnl * 256 + wc * 32 + 8 * fq;
#pragma unroll
        for (int bj = 0; bj < 2; ++bj) { const int col = c0 + bj * 128;
            const f4 b0 = *(const f4*)(bdn + (size_t)e * 1024 + col), b1 = *(const f4*)(bdn + (size_t)e * 1024 + col + 4);
#pragma unroll
            for (int ai = 0; ai < 2; ++ai)
#pragma unroll
                for (int m = 0; m < 4; ++m) { const int row = row0 + ai * 128 + m * 16; const float gt = rgate[row];
                    const pg8::f32x4 v0 = acc[ai][bj][m][0] * (1.f / (FP8_WSCALE * FP8_ASCALE)), v1 = acc[ai][bj][m][1] * (1.f / (FP8_WSCALE * FP8_ASCALE));
                    const float gs = gt * FP8_YSCALE;
                    v2u w; w.x = pk4_fp8((v0[0] + b0.x) * gs, (v0[1] + b0.y) * gs, (v0[2] + b0.z) * gs, (v0[3] + b0.w) * gs);
                    w.y = pk4_fp8((v1[0] + b1.x) * gs, (v1[1] + b1.y) * gs, (v1[2] + b1.z) * gs, (v1[3] + b1.w) * gs);
                    *(v2u*)(YS + (size_t)row * 1024 + col) = w; } }
    }
};

struct S5EOrder {
    int G, c;
    __device__ __forceinline__ bool next(int i, Unit& u) const { const int x = c & 7, j = c >> 3; if (i > 0 || j >= 16) return false; const int g = x + 8 * (j >> 2); u.pm = g * 4 + (j & 3); u.pn = g; u.rd = 0; u.nt = 0; return true; }
    __device__ __forceinline__ void a_ready(const Unit&) const {}
    __device__ __forceinline__ void done(const Unit&) const {}
};
struct S5YOrder {
    int G, c;
    __device__ __forceinline__ bool next(int i, Unit& u) const { if (i >= 2) return false; const int x = c & 7, j = c >> 3, g = x + 8 * (2 * i + (j >> 4)), r = j & 15, b = i ? 3 - (r & 3) : (r & 3);
        u.pm = g * 4 + (r >> 2); u.pn = g * 4 + b; u.rd = i; u.nt = 6 + 4 * b; return true; }
    __device__ __forceinline__ void a_ready(const Unit&) const {}
    __device__ __forceinline__ void done(const Unit&) const {}
};
struct MoeOrder {
    const int* tile_e; int ntile, NT, G, c;
    unsigned* sync;
    __device__ __forceinline__ bool next(int i, Unit& u) const {
#ifdef HALF_CHIP
        const int x = c & 7, RT = 32 / NT; if ((c >> 3) >= 16) return false; const int j = (c >> 3) + 16 * (i & 1); i >>= 1;
#else
        const int x = c & 7, j = c >> 3, RT = 32 / NT;
#endif
#ifdef XCD_RANGE
        const int per = ((ntile + 8 * RT - 1) / (8 * RT)) * RT, kk = i * RT + j / NT;
        const int it = x * per + kk, pnl = j % NT;
        if (kk >= per || it >= ntile) return false;
#else
        const int it = (i * 8 + x) * RT + j / NT, pnl = j % NT;
        if (it >= ntile) return false;
#endif
#ifdef DN_REVERSE
        if (NT == 4) { const int itr = ntile - 1 - it; u.pm = itr; u.pn = tile_e[itr] * NT + pnl; u.rd = i; u.nt = 0; return true; }
#endif
        u.pm = it; u.pn = tile_e[it] * NT + pnl; u.rd = i; u.nt = 0; return true; }
    __device__ __forceinline__ void a_ready(const Unit&) const {}
    __device__ __forceinline__ void done(const Unit&) const {}
};

typedef short v4i16_t __attribute__((ext_vector_type(4)));
__device__ __forceinline__ bf16x8 tr_frag(const LAS unsigned char* img, int RS, int ks, int n0, int lane) {
    const int h = lane >> 5, blk = (lane >> 4) & 1, q = (lane & 15) >> 2, p = lane & 3;
    const LAS unsigned char* a0 = img + (16 * ks + 8 * h + q) * RS + (n0 + 16 * blk + 4 * p) * 2;
    const v4i16_t lo = __builtin_amdgcn_ds_read_tr16_b64_v4i16((LAS v4i16_t*)a0), hi = __builtin_amdgcn_ds_read_tr16_b64_v4i16((LAS v4i16_t*)(a0 + 4 * RS));
    return (bf16x8){lo[0], lo[1], lo[2], lo[3], hi[0], hi[1], hi[2], hi[3]};
}
__device__ __forceinline__ int tr_base(int RS, int lane) { const int h = lane >> 5, blk = (lane >> 4) & 1, q = (lane & 15) >> 2, p = lane & 3; return (8 * h + q) * RS + (16 * blk + 4 * p) * 2; }
__device__ __forceinline__ bf16x8 tr_frag_b(const LAS unsigned char* lanebase, int RS, int off) {
    const v4i16_t lo = __builtin_amdgcn_ds_read_tr16_b64_v4i16((LAS v4i16_t*)(lanebase + off)), hi = __builtin_amdgcn_ds_read_tr16_b64_v4i16((LAS v4i16_t*)(lanebase + off + 4 * RS));
    return (bf16x8){lo[0], lo[1], lo[2], lo[3], hi[0], hi[1], hi[2], hi[3]};
}
__device__ __forceinline__ v4u pack8(const float (&v)[8]) { v4u w; w.x = pk2(v[0], v[1]); w.y = pk2(v[2], v[3]); w.z = pk2(v[4], v[5]); w.w = pk2(v[6], v[7]); return w; }
constexpr int ML_KT = 0, ML_VT = 34816, ML_TILE = 17408;
constexpr int ML_CW = 69632;
constexpr int ML_GA = 74752;
constexpr int ML_PW = 79616;
struct KvRaw { v4u k[4][2]; v4u v[2]; unsigned m[4]; };
__device__ __forceinline__ void kv_load(KvRaw& R, const bf16* QKb  , const bf16* Vb  , int srow  , int col0) {
#pragma unroll
    for (int i = 0; i < 4; ++i) { const int r = srow - 3 + i; const v4u* p = (const v4u*)(QKb + (size_t)(r < 0 ? 0 : r) * 1024 + col0); R.k[i][0] = p[0]; R.k[i][1] = p[1]; R.m[i] = r < 0 ? 0u : 0xffffffffu; }
    const v4u* pv = (const v4u*)(Vb + (size_t)srow * 512 + col0); R.v[0] = pv[0]; R.v[1] = pv[1];
}
__device__ __forceinline__ void kv_conv(const KvRaw& R, const LAS float* cw, int col0, float mul, float (&o)[16]) {
#pragma unroll
    for (int q = 0; q < 4; ++q) { const f4 bv = *(const LAS f4*)(cw + 4 * 128 + col0 + 4 * q); o[4 * q] = bv.x; o[4 * q + 1] = bv.y; o[4 * q + 2] = bv.z; o[4 * q + 3] = bv.w; }
#pragma unroll
    for (int i = 0; i < 4; ++i) { const unsigned m = R.m[i];
        const unsigned xw[8] = {R.k[i][0].x & m, R.k[i][0].y & m, R.k[i][0].z & m, R.k[i][0].w & m, R.k[i][1].x & m, R.k[i][1].y & m, R.k[i][1].z & m, R.k[i][1].w & m};
#pragma unroll
        for (int q = 0; q < 4; ++q) { const f4 w = *(const LAS f4*)(cw + i * 128 + col0 + 4 * q);
            o[4 * q] += w.x * bflo(xw[2 * q]); o[4 * q + 1] += w.y * bfhi(xw[2 * q]); o[4 * q + 2] += w.z * bflo(xw[2 * q + 1]); o[4 * q + 3] += w.w * bfhi(xw[2 * q + 1]); } }
#pragma unroll
    for (int e = 0; e < 16; ++e) o[e] = siluf_(o[e]) * mul;
}
__device__ __forceinline__ void gate_part1(const float* GATES, int tok0, int h, int tid, float& bbw, float& ig, LAS float* scr, int nw) {
    const int lane = tid & 63, wave = tid >> 6;
    if (wave < nw) { const float fg = GATES[(size_t)(tok0 + tid) * 8 + 4 + h]; ig = GATES[(size_t)(tok0 + tid) * 8 + h];
        bbw = logsigmoidf_(fg);
#pragma unroll
        for (int o = 1; o < 64; o <<= 1) { const float t = __shfl_up(bbw, o); if (lane >= o) bbw += t; }
        if (lane == 63) scr[wave] = bbw; }
}
__device__ __forceinline__ void mlstm_state_item(const KArgs& a, LAS unsigned char* L, int item) {
    const int tid = otid(), lane = tid & 63, wave = tid >> 6;
    const int c = item & 63, bh = item >> 6, h = bh & 3, b = bh >> 2, tok0 = b * SEQ + c * 128;
    LAS float* cwk = (LAS float*)(L + ML_CW) + 640; LAS float* wsv = (LAS float*)(L + ML_GA); LAS float* scr = wsv + 1024;
    const bf16* QKb = (const bf16*)(a.ws + OFF_QK) + (size_t)(b * SEQ) * 1024 + 512 + h * 128; const bf16* Vb = (const bf16*)(a.ws + OFF_V) + (size_t)(b * SEQ) * 512 + h * 128;
    const int s = tid >> 3, col0 = (tid & 7) * 16;
    KvRaw R; kv_load(R, QKb, Vb, c * 128 + s, col0);
    if (tid < 160) { const int r = tid >> 5, q4 = (tid & 31) * 4; *(LAS f4*)(cwk + r * 128 + q4) = r < 4 ? *(const f4*)(a.in[I_CONVW] + r * 1024 + 512 + h * 128 + q4) : *(const f4*)(a.in[I_CONVB] + 512 + h * 128 + q4); }
    float bbw = 0.f, ig = 0.f; gate_part1((const float*)(a.ws + OFF_GATES), tok0, h, tid, bbw, ig, scr, 2);
    __syncthreads();
    float wl = -3.0e38f;
    if (wave < 2) { float off = 0.f;
#pragma unroll
        for (int w = 0; w < 2; ++w) if (w < wave) off += scr[w];
        const float g = scr[0] + scr[1]; wl = g - (bbw + off) + ig;
        const float wm = wave_max(wl); if (lane == 0) scr[8 + wave] = wm;
        if (tid == 0) ((float*)(a.ws + OFF_MLG))[item] = g; }
    __syncthreads();
    if (wave < 2) { const float amax = fmaxf(scr[8], scr[9]); wsv[tid] = expf(wl - amax); if (tid == 0) ((float*)(a.ws + OFF_MLA))[item] = amax; }
    __syncthreads();
    const int kdb = wave >> 1, vb0 = (wave & 1) * 2, r32 = lane & 31, hh = lane >> 5;
    f32x16 acc0, acc1;
#pragma unroll
    for (int i = 0; i < 16; ++i) { acc0[i] = 0.f; acc1[i] = 0.f; }
    float np = 0.f;
#pragma unroll 1
    for (int j = 0; j < 2; ++j) {
        LAS unsigned char* kt = L + ML_KT + (j & 1) * ML_TILE; LAS unsigned char* vt = L + ML_VT + (j & 1) * ML_TILE;
        { float o[16]; kv_conv(R, cwk, col0, 0.08838834764831845f * wsv[64 * j + s], o);
          const float o0[8] = {o[0], o[1], o[2], o[3], o[4], o[5], o[6], o[7]}, o1[8] = {o[8], o[9], o[10], o[11], o[12], o[13], o[14], o[15]};
          *(LAS v4u*)(kt + s * 272 + col0 * 2) = pack8(o0); *(LAS v4u*)(kt + s * 272 + col0 * 2 + 16) = pack8(o1);
          *(LAS v4u*)(vt + s * 272 + col0 * 2) = R.v[0]; *(LAS v4u*)(vt + s * 272 + col0 * 2 + 16) = R.v[1]; }
        kv_load(R, QKb, Vb, c * 128 + 64 + s, col0);
        __syncthreads();
#pragma unroll
        for (int ks = 0; ks < 4; ++ks) { const bf16x8 A = tr_frag(kt, 272, ks, kdb * 32, lane), B0 = tr_frag(vt, 272, ks, vb0 * 32, lane), B1 = tr_frag(vt, 272, ks, vb0 * 32 + 32, lane);
            acc0 = __builtin_amdgcn_mfma_f32_32x32x16_bf16(A, B0, acc0, 0, 0, 0); acc1 = __builtin_amdgcn_mfma_f32_32x32x16_bf16(A, B1, acc1, 0, 0, 0); }
        if (tid < 128) {
#pragma unroll 8
            for (int q = 0; q < 64; ++q) np += bf2f(*(const LAS bf16*)(kt + q * 272 + tid * 2)); }
    }
    {
        bf16* UP = (bf16*)((unsigned char*)a.out + OUT_UP) + (size_t)item * 16384;
#pragma unroll
        for (int q = 0; q < 4; ++q) { const int kd = kdb * 32 + 8 * q + 4 * hh;
            v2u w0; w0.x = pk2(acc0[4 * q], acc0[4 * q + 1]); w0.y = pk2(acc0[4 * q + 2], acc0[4 * q + 3]);
            v2u w1; w1.x = pk2(acc1[4 * q], acc1[4 * q + 1]); w1.y = pk2(acc1[4 * q + 2], acc1[4 * q + 3]);
            *(v2u*)(UP + (size_t)(vb0 * 32 + r32) * 128 + kd) = w0; *(v2u*)(UP + (size_t)((vb0 + 1) * 32 + r32) * 128 + kd) = w1; }
        if (tid < 128) ((float*)(a.ws + OFF_MLNP))[(size_t)item * 128 + tid] = np;
    }
    __syncthreads();
}

__device__ __forceinline__ void phase3(const KArgs& a, LAS unsigned char* L, int G) {
    const int tid = otid(), lane = tid & 63, wave = tid >> 6;
    LAS float* ga = (LAS float*)L; LAS float* aa = ga + 64; LAS float* dec = aa + 64; LAS float* scl = dec + 64;
    for (int w = blockIdx.x; w < 256; w += G) {
        const int bh = w >> 3, slice = w & 7;
        if (tid < 64) { ga[tid] = ((const float*)(a.ws + OFF_MLG))[bh * 64 + tid]; aa[tid] = ((const float*)(a.ws + OFF_MLA))[bh * 64 + tid]; }
        __syncthreads();
        if (tid == 0) { float m = 0.f; float* MLM = (float*)(a.ws + OFF_MLM);
            for (int c = 0; c < 64; ++c) { const float g = ga[c], am = aa[c], mn = fmaxf(g + m, am); dec[c] = expf(g + m - mn); scl[c] = expf(am - mn); if (slice == 0) MLM[bh * 64 + c] = m; m = mn; } }
        __syncthreads();
        {
            const size_t e0 = (size_t)bh * 64 * 16384 + slice * 2048 + tid * 4;
            const bf16* up = (const bf16*)((const unsigned char*)a.out + OUT_UP) + e0; bf16* cs = (bf16*)((unsigned char*)a.out + OUT_CST) + e0;
            float C0 = 0.f, C1 = 0.f, C2 = 0.f, C3 = 0.f;
            for (int c0 = 0; c0 < 64; c0 += 16) {
                v2u uv[16];
#pragma unroll
                for (int q = 0; q < 16; ++q) uv[q] = *(const v2u*)(up + (size_t)(c0 + q) * 16384);
#pragma unroll
                for (int q = 0; q < 16; ++q) { v2u o; o.x = pk2(C0, C1); o.y = pk2(C2, C3); *(v2u*)(cs + (size_t)(c0 + q) * 16384) = o;
                    const float d = dec[c0 + q], sc = scl[c0 + q];
                    C0 = d * C0 + sc * bflo(uv[q].x); C1 = d * C1 + sc * bfhi(uv[q].x); C2 = d * C2 + sc * bflo(uv[q].y); C3 = d * C3 + sc * bfhi(uv[q].y); }
            }
        }
        if (slice == 0 && tid < 128) { const float* np = (const float*)(a.ws + OFF_MLNP) + (size_t)bh * 64 * 128 + tid; float* ns = (float*)(a.ws + OFF_MLN) + (size_t)bh * 64 * 128 + tid; float n = 0.f;
            for (int c = 0; c < 64; ++c) { ns[c * 128] = n; n = dec[c] * n + scl[c] * np[c * 128]; } }
        __syncthreads();
    }
    if (wave == 7) for (int w = blockIdx.x; w < 256; w += G) {
        const int b = w >> 5, g = w & 31, p = lane;
        const float dt = expf(a.in[I_LDT][g]); float lr, li; lam_pow(a.in[I_LRE][g * 64 + p], a.in[I_LIM][g * 64 + p], dt, 64, lr, li);
        const float* E = (const float*)(a.ws + OFF_S5E) + ((size_t)(g * 1024 + b * 128) * 128 + 2 * p);
        bf16* UG = (bf16*)(a.ws + OFF_UG) + ((size_t)(g * 1024 + b * 128) * 1152 + 2 * p);
        float xr = 0.f, xi = 0.f;
        for (int c0 = 0; c0 < 128; c0 += 8) {
            f2 ev[8];
#pragma unroll
            for (int q = 0; q < 8; ++q) ev[q] = *(const f2*)(E + (size_t)(c0 + q) * 128);
#pragma unroll
            for (int q = 0; q < 8; ++q) { *(unsigned*)(UG + (size_t)(c0 + q) * 1152) = pk2(xr, xi);
                const float nr = lr * xr - li * xi + ev[q].x, ni = lr * xi + li * xr + ev[q].y; xr = nr; xi = ni; }
        }
    }
}

__device__ __forceinline__ void kq_load(KvRaw& R, const bf16* QKq, int srow, int col0) {
#pragma unroll
    for (int i = 0; i < 4; ++i) { const int r = srow - 3 + i; const v4u* p = (const v4u*)(QKq + (size_t)(r < 0 ? 0 : r) * 1024 + col0); R.k[i][0] = p[0]; R.k[i][1] = p[1]; R.m[i] = r < 0 ? 0u : 0xffffffffu; }
}
__device__ __forceinline__ bf16x8 tr16_frag(const LAS unsigned char* lanebase, int off) {
    const v4i16_t lo = __builtin_amdgcn_ds_read_tr16_b64_v4i16((LAS v4i16_t*)(lanebase + off)), hi = __builtin_amdgcn_ds_read_tr16_b64_v4i16((LAS v4i16_t*)(lanebase + off + 4 * 272));
    return (bf16x8){lo[0], lo[1], lo[2], lo[3], hi[0], hi[1], hi[2], hi[3]};
}
__device__ __forceinline__ void mlstm_out_item(const KArgs& a, LAS unsigned char* L, int item, int next_item, KvRaw& Ra, KvRaw& Rb, int& h_loaded) {
    const int tid = otid(), lane = tid & 63, wave = __builtin_amdgcn_readfirstlane(tid >> 6);
    const int c = item & 63, bh = item >> 6, h = bh & 3, b = bh >> 2, tok0 = b * SEQ + c * 128;
    const int fr = lane & 15, fq = lane >> 4;
    LAS float* cwq = (LAS float*)(L + ML_CW); LAS float* cwk = cwq + 640;
    LAS float* gcs = (LAS float*)(L + ML_GA); LAS float* grr = gcs + 256; LAS float* gsc = grr + 256; LAS float* gen = gsc + 256; LAS float* scr = gen + 256;
    LAS bf16* Pw = (LAS bf16*)(L + ML_PW + wave * 2304);
    const bf16* QKq = (const bf16*)(a.ws + OFF_QK) + (size_t)(b * SEQ) * 1024 + h * 128;
    const bf16* QKb = QKq + 512; const bf16* Vb = (const bf16*)(a.ws + OFF_V) + (size_t)(b * SEQ) * 512 + h * 128;
    const int s = tid >> 3, col0 = (tid & 7) * 16;
    TIC(31) TIC(36)
    if (h != h_loaded) {
    if (tid < 320) { const int t2 = tid < 160 ? tid : tid - 160, r = t2 >> 5, q4 = (t2 & 31) * 4, ch = (tid < 160 ? 0 : 512) + h * 128 + q4;
        *(LAS f4*)((tid < 160 ? cwq : cwk) + r * 128 + q4) = r < 4 ? *(const f4*)(a.in[I_CONVW] + r * 1024 + ch) : *(const f4*)(a.in[I_CONVB] + ch); }
    else if (tid < 352) *(LAS f4*)(scr + 64 + 4 * (tid - 320)) = *(const f4*)(a.in[I_HNG] + h * 128 + 4 * (tid - 320));
    h_loaded = h; }
    float bbw = 0.f, ig = 0.f; gate_part1((const float*)(a.ws + OFF_GATES), tok0, h, tid, bbw, ig, scr, 2);
    __syncthreads();
    float cs = 0.f, pmw = -3.0e38f, bb = 0.f;
    if (wave < 2) { const float off = wave ? scr[0] : 0.f;
        bb = bbw + off; cs = ig - bb; pmw = cs;
#pragma unroll
        for (int o = 1; o < 64; o <<= 1) { const float t = __shfl_up(pmw, o); if (lane >= o) pmw = fmaxf(pmw, t); }
        if (lane == 63) scr[8 + wave] = pmw; }
    {
        float o[16]; kv_conv(Ra, cwq, col0, 1.f, o);
        { const float o0[8] = {o[0], o[1], o[2], o[3], o[4], o[5], o[6], o[7]}, o1[8] = {o[8], o[9], o[10], o[11], o[12], o[13], o[14], o[15]};
          *(LAS v4u*)(L + s * 272 + col0 * 2) = pack8(o0); *(LAS v4u*)(L + s * 272 + col0 * 2 + 16) = pack8(o1); }
        kv_conv(Rb, cwq, col0, 1.f, o);
        { const float o0[8] = {o[0], o[1], o[2], o[3], o[4], o[5], o[6], o[7]}, o1[8] = {o[8], o[9], o[10], o[11], o[12], o[13], o[14], o[15]};
          *(LAS v4u*)(L + (64 + s) * 272 + col0 * 2) = pack8(o0); *(LAS v4u*)(L + (64 + s) * 272 + col0 * 2 + 16) = pack8(o1); }
    }
    KvRaw R; kv_load(R, QKb, Vb, c * 128 + s, col0);
    __syncthreads();
    TOC(31) TIC(32)
    bf16x8 Aq[4];
#pragma unroll
    for (int ks = 0; ks < 4; ++ks) Aq[ks] = *(const LAS bf16x8*)(L + (16 * wave + fr) * 272 + (32 * ks + 8 * fq) * 2);
    if (wave < 2) { const float pm = wave ? fmaxf(pmw, scr[8]) : pmw;
        const float mk = ((const float*)(a.ws + OFF_MLM))[item], rr = fmaxf(pm, mk);
        gcs[tid] = cs; grr[tid] = rr; gsc[tid] = expf(mk - rr); gen[tid] = expf(-bb - rr); }
    __syncthreads();
    TOC(32) TIC(33)
    pg8::f32x4 num[8]; float rs[4] = {0.f, 0.f, 0.f, 0.f};
#pragma unroll
    for (int cb = 0; cb < 8; ++cb) num[cb] = (pg8::f32x4){0.f, 0.f, 0.f, 0.f};
    const int jmax = wave >> 2;
#pragma unroll 1
    for (int j = 0; j < 2; ++j) {
        LAS unsigned char* kt = L + ML_KT + (j & 1) * ML_TILE; LAS unsigned char* vt = L + ML_VT + (j & 1) * ML_TILE;
        { float o[16]; kv_conv(R, cwk, col0, 0.08838834764831845f, o);
          const float o0[8] = {o[0], o[1], o[2], o[3], o[4], o[5], o[6], o[7]}, o1[8] = {o[8], o[9], o[10], o[11], o[12], o[13], o[14], o[15]};
          *(LAS v4u*)(kt + s * 272 + col0 * 2) = pack8(o0); *(LAS v4u*)(kt + s * 272 + col0 * 2 + 16) = pack8(o1);
          *(LAS v4u*)(vt + s * 272 + col0 * 2) = R.v[0]; *(LAS v4u*)(vt + s * 272 + col0 * 2 + 16) = R.v[1]; }
        kv_load(R, QKb, Vb, c * 128 + 64 + s, col0);
        __syncthreads();
        if (j <= jmax) {
            const LAS unsigned char* ktb = kt + fr * 272 + 16 * fq; const LAS unsigned char* vtb = vt + (8 * fq + (fr >> 2)) * 272 + 8 * (fr & 3);
            LAS bf16* pwb = Pw + (4 * fq) * 72 + fr; const LAS bf16* pab = Pw + fr * 72 + 8 * fq; const LAS float* grb = grr + 16 * wave + 4 * fq; const int tg0 = 16 * wave + 4 * fq;
            asm volatile("" : "+v"(ktb), "+v"(vtb), "+v"(pwb), "+v"(pab), "+v"(grb));
#pragma unroll
            for (int st = 0; st < 4; ++st) {
                pg8::f32x4 sacc = (pg8::f32x4){0.f, 0.f, 0.f, 0.f};
#pragma unroll
                for (int ks = 0; ks < 4; ++ks) { const bf16x8 Bk = *(const LAS bf16x8*)(ktb + st * 16 * 272 + 64 * ks); sacc = __builtin_amdgcn_mfma_f32_16x16x32_bf16(Aq[ks], Bk, sacc, 0, 0, 0); }
                const int sg = 64 * j + 16 * st + fr; const float csv = gcs[sg];
#pragma unroll
                for (int q = 0; q < 4; ++q) { const float ev = __expf(fminf(csv - grb[q], 0.f)); const float pv = (sg <= tg0 + q) ? sacc[q] * ev : 0.f; rs[q] += pv; pwb[q * 72 + 16 * st] = (bf16)f2bf(pv); }
            }
#pragma unroll
            for (int ks = 0; ks < 2; ++ks) { const bf16x8 Ap = *(const LAS bf16x8*)(pab + 32 * ks);
#pragma unroll
                for (int cb = 0; cb < 8; ++cb) num[cb] = __builtin_amdgcn_mfma_f32_16x16x32_bf16(Ap, tr16_frag(vtb, 32 * ks * 272 + 32 * cb), num[cb], 0, 0, 0); }
        }
    }
    TOC(33) TIC(34)
    v4u ow4[4];
    { const bf16* Op = (const bf16*)(a.ws + OFF_O) + (size_t)(tok0 + 16 * wave + (lane >> 2)) * 512 + h * 128 + (lane & 3) * 8;
#pragma unroll
      for (int i = 0; i < 4; ++i) ow4[i] = *(const v4u*)(Op + 32 * i); }
#pragma unroll
    for (int q = 0; q < 4; ++q) { rs[q] += __shfl_xor(rs[q], 1); rs[q] += __shfl_xor(rs[q], 2); rs[q] += __shfl_xor(rs[q], 4); rs[q] += __shfl_xor(rs[q], 8); }
    float sc_t[4], inv[4]; float ss[4] = {0.f, 0.f, 0.f, 0.f};
    {
        const float* nst = (const float*)(a.ws + OFF_MLN) + (size_t)item * 128 + 8 * fq;
        const bf16* CST = (const bf16*)((const unsigned char*)a.out + OUT_CST) + ((size_t)item * 128 + fr) * 128 + 8 * fq;
        f4 nv[8];
#pragma unroll
        for (int ks = 0; ks < 4; ++ks) { nv[2 * ks] = *(const f4*)(nst + ks * 32); nv[2 * ks + 1] = *(const f4*)(nst + ks * 32 + 4); }
        bf16x8 GA[2][4], GB[2][4];
#define LOAD_C(G, cb0) do { _Pragma("unroll") for (int c_ = 0; c_ < 2; ++c_) _Pragma("unroll") for (int ks = 0; ks < 4; ++ks) G[c_][ks] = *(const bf16x8*)(CST + (size_t)((cb0) + c_) * 16 * 128 + ks * 32); } while (0)
#define COMP_C(G, cb0) do { _Pragma("unroll") for (int c_ = 0; c_ < 2; ++c_) { pg8::f32x4 accC = (pg8::f32x4){0.f, 0.f, 0.f, 0.f}; \
        _Pragma("unroll") for (int ks = 0; ks < 4; ++ks) accC = __builtin_amdgcn_mfma_f32_16x16x32_bf16(Aq[ks], G[c_][ks], accC, 0, 0, 0); \
        _Pragma("unroll") for (int q = 0; q < 4; ++q) { const float v = (num[(cb0) + c_][q] + sc_t[q] * accC[q]) * inv[q]; num[(cb0) + c_][q] = v; ss[q] += v * v; } } } while (0)
        LOAD_C(GA, 0); LOAD_C(GB, 2);
        const unsigned msk = fr == 0 ? 0xffffffffu : 0u;
        pg8::f32x4 accn = (pg8::f32x4){0.f, 0.f, 0.f, 0.f};
#pragma unroll
        for (int ks = 0; ks < 4; ++ks) { const f4 n0 = nv[2 * ks], n1 = nv[2 * ks + 1];
            v4u w; w.x = pk2(n0.x, n0.y) & msk; w.y = pk2(n0.z, n0.w) & msk; w.z = pk2(n1.x, n1.y) & msk; w.w = pk2(n1.z, n1.w) & msk;
            accn = __builtin_amdgcn_mfma_f32_16x16x32_bf16(Aq[ks], __builtin_bit_cast(bf16x8, w), accn, 0, 0, 0); }
#pragma unroll
        for (int q = 0; q < 4; ++q) { const int tg = 16 * wave + 4 * fq + q; sc_t[q] = gsc[tg]; const float qn = __shfl(accn[q], lane & 48); const float den = rs[q] + sc_t[q] * qn; inv[q] = __builtin_amdgcn_rcpf(fmaxf(fabsf(den), gen[tg])); }
        COMP_C(GA, 0); LOAD_C(GA, 4);
        COMP_C(GB, 2); LOAD_C(GB, 6);
        COMP_C(GA, 4); COMP_C(GB, 6);
#undef LOAD_C
#undef COMP_C
    }
    TOC(34) TIC(35)
    { const int nc = next_item & 63, nbh = next_item >> 6, nh = nbh & 3, nb = nbh >> 2; const bf16* nq = (const bf16*)(a.ws + OFF_QK) + (size_t)(nb * SEQ) * 1024 + nh * 128;
      kq_load(Ra, nq, nc * 128 + s, col0); kq_load(Rb, nq, nc * 128 + 64 + s, col0); }
    __syncthreads();
    LAS float* Hw = (LAS float*)(L + wave * 8448);
    const LAS float* ghn = scr + 64;
#pragma unroll
    for (int q = 0; q < 4; ++q) { ss[q] += __shfl_xor(ss[q], 1); ss[q] += __shfl_xor(ss[q], 2); ss[q] += __shfl_xor(ss[q], 4); ss[q] += __shfl_xor(ss[q], 8);
        const float rstd = rsqrtf(ss[q] * (1.f / 128.f) + EPS);
#pragma unroll
        for (int cb = 0; cb < 8; ++cb) Hw[(4 * fq + q) * 132 + cb * 16 + fr] = num[cb][q] * rstd; }
    __syncthreads();
    {
        const int t = lane >> 2, vq = lane & 3;
        const LAS float* hg = ghn + vq * 8;
        bf16* MIX = (bf16*)(a.ws + OFF_H1) + (size_t)(tok0 + 16 * wave + t) * 1024 + h * 128 + vq * 8;
#pragma unroll
        for (int i = 0; i < 4; ++i) { const v4u ow = ow4[i]; const f4 h0 = *(const LAS f4*)(Hw + t * 132 + vq * 8 + 32 * i), h1 = *(const LAS f4*)(Hw + t * 132 + vq * 8 + 32 * i + 4);
            const f4 g0 = *(const LAS f4*)(hg + 32 * i), g1 = *(const LAS f4*)(hg + 32 * i + 4);
            float y[8];
            y[0] = sigmoidf_(bflo(ow.x)) * h0.x * g0.x; y[1] = sigmoidf_(bfhi(ow.x)) * h0.y * g0.y; y[2] = sigmoidf_(bflo(ow.y)) * h0.z * g0.z; y[3] = sigmoidf_(bfhi(ow.y)) * h0.w * g0.w;
            y[4] = sigmoidf_(bflo(ow.z)) * h1.x * g1.x; y[5] = sigmoidf_(bfhi(ow.z)) * h1.y * g1.y; y[6] = sigmoidf_(bflo(ow.w)) * h1.z * g1.z; y[7] = sigmoidf_(bfhi(ow.w)) * h1.w * g1.w;
            *(v4u*)(MIX + 32 * i) = pack8(y); }
    }
    __syncthreads();
    TOC(35) TOC(36)
}

template <int N, int MASK> __device__ __forceinline__ void rs_step(float* v, int lane) {
    const bool hi = (lane & MASK) != 0;
#pragma unroll
    for (int i = 0; i < N; ++i) { const float send = hi ? v[i] : v[i + N], keep = hi ? v[i + N] : v[i]; v[i] = keep + __shfl_xor(send, MASK); }
}
__device__ __forceinline__ void phase7(const KArgs& a, LAS unsigned char* L, int G) {
    const int tid = otid(), lane = tid & 63, wave = __builtin_amdgcn_readfirstlane(tid >> 6);
    LAS float* wrT = (LAS float*)L;
    LAS float* g2l = (LAS float*)(L + 131584);
    LAS unsigned char* le = L + 131584 + 4096;
    LAS int* lcnt = (LAS int*)(L + 131584 + 4096 + 1024);
    LAS float* sc = (LAS float*)(L + 131584 + 4096 + 1024 + 128) + wave * 528;
    const float* wr = a.in[I_WR]; const float* g2 = a.in[I_N2G]; const float* br = a.in[I_BR];
    for (int idx = tid; idx < 1024; idx += 512) g2l[idx] = g2[idx];
    for (int idx = tid; idx < 32768; idx += 512) wrT[(idx & 31) * 1028 + (idx >> 5)] = wr[idx] * g2[idx >> 5];
    const unsigned short* X1HI = (const unsigned short*)(a.ws + OFF_MO); const unsigned char* X1LO = (const unsigned char*)a.out + OUT_X1LO;
    unsigned char* H2 = a.ws + OFF_H2; float* RSTD = (float*)(a.ws + OFF_RSTD2);
    int* ENTE = (int*)(a.ws + OFF_ENTE); float* ENTG = (float*)(a.ws + OFF_ENTG); int* ENTR = (int*)(a.ws + OFF_ENTR); int* CNT = (int*)(a.ws + OFF_CNT);
    const int ti = lane & 31, kh = lane >> 5;
    for (int chunk = blockIdx.x; chunk < 256; chunk += G) {
        if (tid < 32) lcnt[tid] = 0;
        __syncthreads();
        {
            const int t0 = chunk * 256 + wave * 32;
            const unsigned short* xrow = X1HI + (size_t)(t0 + ti) * DM + 512 * kh; const unsigned char* mrow = X1LO + (size_t)(t0 + ti) * DM + 512 * kh; unsigned char* hrow = H2 + (size_t)(t0 + ti) * DM + 512 * kh;
            const LAS float* wl = wrT + ti * 1028 + 512 * kh; const LAS float* gl = g2l + 512 * kh;
            f32x16 acc;
#pragma unroll
            for (int i = 0; i < 16; ++i) acc[i] = 0.f;
            float ssq = 0.f;
            f4 xc[16];
#define X1_LOAD(xr_, mr_, e0) do { _Pragma("unroll") for (int q = 0; q < 8; ++q) xr_[q] = *(const v4u*)(xrow + (e0) + 8 * q); _Pragma("unroll") for (int q = 0; q < 4; ++q) mr_[q] = *(const v4u*)(mrow + (e0) + 16 * q); } while (0)
#define X1_EL(hw, lw, j, odd) __uint_as_float(__builtin_amdgcn_perm(hw, lw, ((odd) ? 0x07060000u : 0x05040000u) | ((unsigned)(j) << 8) | 0x0cu))
#define X1_ADD(dst, xr_, mr_) do { _Pragma("unroll") for (int q = 0; q < 16; ++q) { const unsigned h0 = xr_[q >> 1][2 * (q & 1)], h1 = xr_[q >> 1][2 * (q & 1) + 1], lw = mr_[q >> 2][q & 3]; \
                dst[q].x = X1_EL(h0, lw, 0, 0); dst[q].y = X1_EL(h0, lw, 1, 1); dst[q].z = X1_EL(h1, lw, 2, 0); dst[q].w = X1_EL(h1, lw, 3, 1); } } while (0)
            { v4u x0[8], m0[4]; X1_LOAD(x0, m0, 0); X1_ADD(xc, x0, m0); }
#pragma unroll 1
            for (int c = 0; c < 8; ++c) {
                v4u xn[8], mn[4]; const int ne = 64 * (c < 7 ? c + 1 : 7);
                X1_LOAD(xn, mn, ne);
#pragma unroll
                for (int q4 = 0; q4 < 4; ++q4) { v4u hw;
#pragma unroll
                    for (int qq = 0; qq < 4; ++qq) { const int q = 4 * q4 + qq; const f4 w4 = *(const LAS f4*)(wl + 64 * c + 4 * q), g4 = *(const LAS f4*)(gl + 64 * c + 4 * q); const f4 x = xc[q];
                        acc = __builtin_amdgcn_mfma_f32_32x32x2f32(x.x, w4.x, acc, 0, 0, 0); acc = __builtin_amdgcn_mfma_f32_32x32x2f32(x.y, w4.y, acc, 0, 0, 0);
                        acc = __builtin_amdgcn_mfma_f32_32x32x2f32(x.z, w4.z, acc, 0, 0, 0); acc = __builtin_amdgcn_mfma_f32_32x32x2f32(x.w, w4.w, acc, 0, 0, 0);
                        ssq += (x.x * x.x + x.y * x.y) + (x.z * x.z + x.w * x.w);
                        hw[qq] = pk4_fp8(x.x * g4.x * FP8_ASCALE, x.y * g4.y * FP8_ASCALE, x.z * g4.z * FP8_ASCALE, x.w * g4.w * FP8_ASCALE); }
                    *(v4u*)(hrow + 64 * c + 16 * q4) = hw; }
                X1_ADD(xc, xn, mn);
            }
            ssq += __shfl_xor(ssq, 32);
            const float rstd = rsqrtf(ssq * (1.f / DM) + EPS);
            if (lane < 32) RSTD[t0 + lane] = rstd;
#pragma unroll
            for (int p = 0; p < 2; ++p) {
#pragma unroll
                for (int r8 = 0; r8 < 8; ++r8) { const int r = 8 * p + r8, rowl = (r & 3) + 8 * ((r >> 2) & 1) + 4 * kh; sc[rowl * 33 + ti] = acc[r]; }
                const float rs_t = __shfl(rstd, 16 * p + (lane & 15));
                if (lane < 16) {
                    float v[32];
#pragma unroll
                    for (int e = 0; e < 32; ++e) v[e] = sc[lane * 33 + e] * rs_t + br[e];
                    float tv[4]; int te[4];
#pragma unroll
                    for (int k = 0; k < 4; ++k) { float bv = v[0]; int be = 0;
#pragma unroll
                        for (int e = 1; e < 32; ++e) if (v[e] > bv) { bv = v[e]; be = e; }
                        tv[k] = bv; te[k] = be;
#pragma unroll
                        for (int e = 0; e < 32; ++e) v[e] = (e == be) ? -3.0e38f : v[e]; }
                    const float e1 = __expf(tv[1] - tv[0]), e2 = __expf(tv[2] - tv[0]), e3 = __expf(tv[3] - tv[0]), inv = __builtin_amdgcn_rcpf(1.f + e1 + e2 + e3);
                    const int tl = wave * 32 + 16 * p + lane, tt = chunk * 256 + tl;
                    *(int4*)(ENTE + (size_t)tt * 4) = make_int4(te[0], te[1], te[2], te[3]);
                    *(f4*)(ENTG + (size_t)tt * 4) = (f4){inv, e1 * inv, e2 * inv, e3 * inv};
                    *(LAS unsigned*)(le + tl * 4) = (unsigned)te[0] | ((unsigned)te[1] << 8) | ((unsigned)te[2] << 16) | ((unsigned)te[3] << 24);
                }
            }
        }
        __syncthreads();
#pragma unroll
        for (int q = 0; q < 2; ++q) { const int idx = tid + 512 * q; const int e = le[idx]; const int rk = __hip_atomic_fetch_add(&lcnt[e], 1, __ATOMIC_RELAXED, __HIP_MEMORY_SCOPE_WORKGROUP); ENTR[chunk * 1024 + idx] = rk; }
        __syncthreads();
        if (tid < 32) CNT[chunk * 32 + tid] = lcnt[tid];
        __syncthreads();
    }
}

__device__ __forceinline__ int wsum32(int v) { v += __shfl_xor(v, 1); v += __shfl_xor(v, 2); v += __shfl_xor(v, 4); v += __shfl_xor(v, 8); v += __shfl_xor(v, 16); return v; }
__device__ __forceinline__ int place_preamble(const KArgs& a, LAS unsigned char* L, bool write_tiles) {
    const int tid = otid();
    LAS int* tot = (LAS int*)L; LAS int* pst = tot + 64; LAS int* misc = pst + 96; LAS int* cntl = (LAS int*)(L + 1024);
    const int* CNT = (const int*)(a.ws + OFF_CNT); int* TILEE = (int*)(a.ws + OFF_TILEE); int* NTILE = (int*)(a.ws + OFF_NTILE);
    for (int i = tid; i < 8192; i += 512) cntl[i] = CNT[i];
    __syncthreads();
    if (tid < 64) { const int e = tid & 31;
        int all = 0; for (int c = 0; c < 256; ++c) all += cntl[c * 32 + e];
        int run = 0, best = 1 << 30, bestc = 192, bestrun = 0;
        for (int c = 0; c < 224; ++c) { run += cntl[c * 32 + e];
            if (c + 1 >= 160) { const int nA = wsum32((run + 255) >> 8), nB = wsum32((all - run + 255) >> 8);
                const int cost = ((nA + 31) >> 5) + ((nB + 31) >> 5) + ((nA + 63) >> 6) + ((nB + 63) >> 6);
                if (nA <= 800 && nB <= 544 && cost <= best) { best = cost; bestc = c + 1; bestrun = run; } } }
        if (best == (1 << 30)) { bestrun = 0; for (int c = 0; c < 192; ++c) bestrun += cntl[c * 32 + e]; }
        if (tid < 32) { tot[e] = bestrun; tot[32 + e] = all - bestrun; if (tid == 0) misc[0] = bestc; } }
    __syncthreads();
    if (tid < 2) { const int hf = tid; int run = 0;
        for (int e = 0; e < 32; ++e) { pst[hf * 32 + e] = run; run += ((tot[hf * 32 + e] + 255) >> 8) << 8; }
        misc[1 + hf] = run >> 8;
        if (write_tiles) { NTILE[hf] = run >> 8; if (hf == 0) NTILE[2] = misc[0]; } }
    __syncthreads();
    if (write_tiles) {
        for (int hf = 0; hf < 2; ++hf) for (int i = tid; i < misc[1 + hf]; i += 512) { int e = 0;
#pragma unroll
            for (int q = 1; q < 32; ++q) e = (pst[hf * 32 + q] <= (i << 8) && tot[hf * 32 + q] > 0) ? q : e;
            TILEE[hf * 1024 + i] = e; } }
    return misc[0];
}
__device__ __forceinline__ void phase8(const KArgs& a, LAS unsigned char* L, int G) {
    const int tid = otid();
    LAS int* tot = (LAS int*)L; LAS int* pst = tot + 64; LAS int* base = pst + 64; LAS int* cntl = (LAS int*)(L + 1024);
    const int* ENTE = (const int*)(a.ws + OFF_ENTE); const int* ENTR = (const int*)(a.ws + OFF_ENTR); const float* ENTG = (const float*)(a.ws + OFF_ENTG);
    int* SDEST = (int*)(a.ws + OFF_SDEST); float* RGATE = (float*)(a.ws + OFF_RGATE); int* ROWMAP = (int*)(a.ws + OFF_ROWMAP); float* RSTDS = (float*)(a.ws + OFF_RSTDS); const float* RSTD = (const float*)(a.ws + OFF_RSTD2);
    const int cA = place_preamble(a, L, blockIdx.x == 0);
    if (blockIdx.x == 0 && tid < 64) { const int hf = tid >> 5, t0 = tot[tid], p0 = pst[tid], pe = p0 + (((t0 + 255) >> 8) << 8);
        for (int r = p0 + t0; r < pe; ++r) { ROWMAP[hf * RCAP + r] = 0; RGATE[hf * RCAP + r] = 0.f; RSTDS[hf * RCAP + r] = 0.f; } }
    for (int chunk = blockIdx.x; chunk < 256; chunk += G) {
        const int hf = chunk >= cA ? 1 : 0;
        if (tid < 32) { int s = pst[hf * 32 + tid]; for (int c = hf ? cA : 0; c < chunk; ++c) s += cntl[c * 32 + tid]; base[tid] = s; }
        __syncthreads();
#pragma unroll
        for (int q = 0; q < 2; ++q) { const int gi = chunk * 1024 + tid + 512 * q; const int e = ENTE[gi]; const int d = base[e] + ENTR[gi]; SDEST[gi] = d; RGATE[hf * RCAP + d] = ENTG[gi]; ROWMAP[hf * RCAP + d] = gi >> 2; RSTDS[hf * RCAP + d] = RSTD[gi >> 2]; }
        __syncthreads();
    }
}

__device__ __forceinline__ void combine_half(const KArgs& a, int hf, const unsigned char* YS, int G) {
    const int tid = otid(), lane = tid & 63, wave = tid >> 6;
    const int gw = blockIdx.x * 8 + wave, NGW = G * 8;
    const int* SDEST = (const int*)(a.ws + OFF_SDEST); const float* gf = a.in[I_NFG];
    f4 gv[4];
#pragma unroll
    for (int j = 0; j < 4; ++j) gv[j] = ((const f4*)gf)[lane + 64 * j];
    const int cA = ((const int*)(a.ws + OFF_NTILE))[2], tbeg = hf ? cA * 256 : 0, tend = hf ? T : cA * 256;
    for (int t = tbeg + gw; t < tend; t += NGW) {
        f4* xr = (f4*)(a.out + (size_t)t * DM) + lane; const v2u* mo8 = (const v2u*)((const unsigned short*)(a.ws + OFF_MO) + (size_t)t * DM) + lane;
        f4 v[4];
#pragma unroll
        for (int j = 0; j < 4; ++j) { const v2u w = mo8[64 * j]; v[j].x = __uint_as_float((w.x << 16) | 0x8000u); v[j].y = __uint_as_float((w.x & 0xFFFF0000u) | 0x8000u); v[j].z = __uint_as_float((w.y << 16) | 0x8000u); v[j].w = __uint_as_float((w.y & 0xFFFF0000u) | 0x8000u); }
#pragma unroll
        for (int k = 0; k < 4; ++k) { const int d = SDEST[t * 4 + k]; const unsigned* y4 = (const unsigned*)(YS + (size_t)d * DM) + lane;
#pragma unroll
            for (int j = 0; j < 4; ++j) { const int w = (int)y4[64 * j]; const f2 lo = __builtin_amdgcn_cvt_pk_f32_fp8(w, false), hi = __builtin_amdgcn_cvt_pk_f32_fp8(w, true);
                v[j].x += lo.x * (1.f / FP8_YSCALE); v[j].y += lo.y * (1.f / FP8_YSCALE); v[j].z += hi.x * (1.f / FP8_YSCALE); v[j].w += hi.y * (1.f / FP8_YSCALE); } }
        float ss = 0.f;
#pragma unroll
        for (int j = 0; j < 4; ++j) ss += (v[j].x * v[j].x + v[j].y * v[j].y) + (v[j].z * v[j].z + v[j].w * v[j].w);
        const float rstd = rsqrtf(wave_sum(ss) * (1.f / DM) + EPS);
#pragma unroll
        for (int j = 0; j < 4; ++j) xr[64 * j] = v[j] * rstd * gv[j];
    }
}

#define XB_TMO      128
#define XB_XCNT(j)  (256  + 64 * (j))
#define XB_XSUB(j)  (1280 + 64 * (j))
#define XB_XGEN(j)  (2304 + 64 * (j))
#define XB_TOP      3328
#define XB_TOPGEN   3392
#define XCD_BAR_WORDS 3456
#define XB_SPIN_CAP (1u << 18)

__device__ __forceinline__ unsigned xb_ld(unsigned* p)              { return __hip_atomic_load(p, __ATOMIC_RELAXED, __HIP_MEMORY_SCOPE_AGENT); }
__device__ __forceinline__ unsigned xb_add(unsigned* p, unsigned v) { return __hip_atomic_fetch_add(p, v, __ATOMIC_RELAXED, __HIP_MEMORY_SCOPE_AGENT); }
__device__ __forceinline__ unsigned xb_xcc_id() { return (unsigned)__builtin_amdgcn_s_getreg((3 << 11) | 20) & 0xFu; }
#define XB_SPIN(cond, bar) do { unsigned _sp = 0; while (cond) { __builtin_amdgcn_s_sleep(1); \
    if ((++_sp & 255u) == 0u) { if (xb_ld(&(bar)[XB_TMO])) break; if (_sp > XB_SPIN_CAP) { atomicAdd(&(bar)[XB_TMO], 1u); break; } } } } while (0)

struct XcdBarrier {
    unsigned* bar; unsigned x;
    volatile LAS unsigned* st;
};

__device__ __forceinline__ XcdBarrier xcd_barrier_post(unsigned* bar, volatile LAS unsigned* st) {
    XcdBarrier b; b.bar = bar; b.x = xb_xcc_id(); b.st = st;
    if (threadIdx.x == 0) (void)xb_add(&bar[XB_XCNT(b.x)], 1u);
    return b;
}
__device__ __forceinline__ void xcd_barrier_complete(unsigned* bar, unsigned x, unsigned& nloc, unsigned& nx) {
    const unsigned G = gridDim.x * gridDim.y * gridDim.z;
    unsigned sum, cnt, mine, sp = 0u;
    for (;;) {
        sum = 0u; cnt = 0u; mine = 0u;
#pragma unroll
        for (unsigned j = 0; j < 16; ++j) { const unsigned c = xb_ld(&bar[XB_XCNT(j)]); sum += c; cnt += (c > 0u) ? 1u : 0u; mine = (j == x) ? c : mine; }
        if (sum == G) break;
        __builtin_amdgcn_s_sleep(1);
        if ((++sp & 255u) == 0u) { if (xb_ld(&bar[XB_TMO])) break; if (sp > XB_SPIN_CAP) { atomicAdd(&bar[XB_TMO], 1u); break; } }
    }
    nloc = mine > 0u ? mine : 1u; nx = cnt > 0u ? cnt : 1u;
}

__device__ __forceinline__ void xcd_barrier(const XcdBarrier& b) {
    asm volatile("s_waitcnt vmcnt(0)" ::: "memory");
    __syncthreads();
    if (threadIdx.x == 0) {
        unsigned* bar = b.bar;
        __builtin_amdgcn_s_waitcnt(0);
        unsigned nloc = b.st[0], nx = b.st[1];
        if (nloc == 0u) { xcd_barrier_complete(bar, b.x, nloc, nx); b.st[0] = nloc; b.st[1] = nx; }
        const unsigned old = xb_add(&bar[XB_XSUB(b.x)], 1u);
        const unsigned gen = old / nloc;
        if (old + 1u == (gen + 1u) * nloc) {
            __builtin_amdgcn_fence(__ATOMIC_RELEASE, "agent");
            asm volatile("s_waitcnt vmcnt(0)" ::: "memory");
            const unsigned og = xb_add(&bar[XB_TOP], 1u);
            const unsigned tg = og / nx;
            if (og + 1u == (tg + 1u) * nx) xb_add(&bar[XB_TOPGEN], 1u);
            else XB_SPIN(xb_ld(&bar[XB_TOPGEN]) == tg, bar);
            __builtin_amdgcn_fence(__ATOMIC_ACQUIRE, "agent");
            xb_add(&bar[XB_XGEN(b.x)], 1u);
            asm volatile("s_waitcnt vmcnt(0)" ::: "memory");
        } else {
            XB_SPIN(xb_ld(&bar[XB_XGEN(b.x)]) == gen, bar);
            __builtin_amdgcn_fence(__ATOMIC_ACQUIRE, "agent");
            asm volatile("s_waitcnt vmcnt(0)" ::: "memory");
        }
    }
    __syncthreads();
}

#ifdef XCD_CONTIG
#define BX_EXPR ((int)blockIdx.x)
#else
#define BX_EXPR __builtin_amdgcn_readfirstlane((int)MISC[12])
#endif
#ifndef PROBE_MASK
#define PROBE_MASK 0u
#endif
#ifndef PROBE_REPS
#define PROBE_REPS 3
#endif
#ifndef MK_SINGLE
#define MK_SINGLE 1
#endif
__device__ __forceinline__ void touch_buffer(const unsigned char* p, size_t bytes, int G) {
    const size_t per = bytes / (size_t)G; const v4u* q = (const v4u*)(p + per * blockIdx.x) + otid();
    v4u acc = (v4u){0u, 0u, 0u, 0u};
    for (size_t i = 0; i < per / (512 * 16); i += 8) {
        v4u t[8];
#pragma unroll
        for (int k = 0; k < 8; ++k) t[k] = q[(i + k) * 512];
#pragma unroll
        for (int k = 0; k < 8; ++k) { acc.x |= t[k].x; acc.y |= t[k].y; acc.z |= t[k].z; acc.w |= t[k].w; }
    }
    asm volatile("" :: "v"(acc.x | acc.y | acc.z | acc.w));
}
typedef const __attribute__((address_space(4))) KArgs* KArgsP;
__device__ __forceinline__ KArgs kargs() {
#if defined(__HIP_DEVICE_COMPILE__)
    KArgsP p = (KArgsP)__builtin_amdgcn_kernarg_segment_ptr(); asm volatile("" : "+s"(p)); KArgs r; __builtin_memcpy(&r, (const __attribute__((address_space(4))) void*)p, sizeof(KArgs)); return r;
#else
    return KArgs{};
#endif
}
__global__ void __launch_bounds__(512, 2) mk_fwd(KArgs a_in) {
    extern __shared__ __attribute__((aligned(16))) unsigned char lds_raw[];
    LAS unsigned char* L = (LAS unsigned char*)lds_raw;
    cg::grid_group grid = cg::this_grid();
    const int ph_lo = a_in.ph_lo, ph_hi = a_in.ph_hi;
    volatile LAS unsigned* MISC = (volatile LAS unsigned*)(L + LDS_BYTES - 64);
    if (otid() < 16) MISC[otid()] = 0u;
    __syncthreads();
    XcdBarrier xbar = xcd_barrier_post((unsigned*)a_in.ws, MISC);
    if (otid() == 0) { MISC[10] = xb_add((unsigned*)a_in.ws + 3584 + 64 * (xbar.x & 7u), 1u); MISC[11] = xbar.x & 7u; MISC[12] = blockIdx.x; }
    __syncthreads();
#define IN(k) (ph_lo <= (k) && (k) < ph_hi)
#define SEAM(k) do { if (IN(k) && IN((k) + 1)) { if ((k) == 0) { grid.sync(); \
        if (otid() == 0) { bool ok = (gridDim.x == 256); for (int j_ = 0; j_ < 8; ++j_) ok = ok && (xb_ld((unsigned*)a_in.ws + 3584 + 64 * j_) == 32u); if (ok) MISC[12] = MISC[10] * 8u + MISC[11]; } __syncthreads(); } \
        else xcd_barrier(xbar); } } while (0)
#define PEND(k) do { if ((PROBE_MASK >> (k)) & 1u) { const unsigned long long t1_ = __builtin_amdgcn_s_memrealtime(); while (__builtin_amdgcn_s_memrealtime() < t1_ + (PROBE_REPS - 1) * (t1_ - t0_)) __builtin_amdgcn_s_sleep(8); } } while (0)
#define REP(k) for (int rep_ = 0, nrep_ = (((PROBE_MASK >> (k)) & 1u) ? PROBE_REPS : 1); rep_ < nrep_; ++rep_)
#define GBX const unsigned long long t0_ = PROBE_MASK ? __builtin_amdgcn_s_memrealtime() : 0ull; (void)t0_; const int G = gridDim.x, bx = BX_EXPR; const KArgs a = kargs(); unsigned char* ws = a.ws; (void)G; (void)bx; (void)ws
    if (IN(0)) { GBX; REP(0) phase0(a, L, G); }
    SEAM(0);
    if (IN(1)) { GBX; REP(1) {
        s5_expand(a, G);
        pg8::Gemm g{(const bf16*)(ws + OFF_H1), (const bf16*)(ws + OFF_WIN), 1024, 1024, 1024, nullptr, 0, 0}; pg8::StaticOrder S; S.init(T, 2560, G, bx);
        EpiInProj E{(bf16*)(ws + OFF_QK), (bf16*)(ws + OFF_V), (bf16*)(ws + OFF_O), (bf16*)(ws + OFF_UG)};
        pg8::gemm_phase<EpiInProj, pg8::StaticOrder, true, true, false, false, true, true>(L, g, S, E); }
    }
    SEAM(1);
    if (IN(2)) { GBX;
        REP(16) { if (G == 256) {
                const int slot = bx >> 3, x = bx & 7;
                if (slot < 16) { const int re = x + 8 * slot; for (int k = 0; k < 6; ++k) mlstm_state_item(a, L, re + 128 * k); }
                else { const int rn = x + 8 * (slot - 16); for (int k = 0; k < 10; ++k) mlstm_state_item(a, L, 768 + rn + 128 * k); } }
            else for (int item = bx; item < 2048; item += G) mlstm_state_item(a, L, item); }
        pg8::Gemm g{(const bf16*)(ws + OFF_UG) + 128, (const bf16*)(ws + OFF_S5P), 1152, 1024, 1024, nullptr, 0, 0}; S5EOrder S{G, bx};
        EpiS5E E{(float*)(ws + OFF_S5E)};
        REP(17) pg8::gemm_phase<EpiS5E, S5EOrder, true, true>(L, g, S, E);
    }
    SEAM(2);
    if (IN(3)) { GBX; REP(3) phase3(a, L, G); }
    SEAM(3);
    if (IN(4)) { GBX;
        REP(18) { int h_loaded = -1; KvRaw Ra, Rb;
            if (bx < 2048) { const int it0 = bx, c0 = it0 & 63, bh0 = it0 >> 6; const bf16* q0 = (const bf16*)(ws + OFF_QK) + (size_t)((bh0 >> 2) * SEQ) * 1024 + (bh0 & 3) * 128; const int s_ = otid() >> 3, col_ = (otid() & 7) * 16;
                kq_load(Ra, q0, c0 * 128 + s_, col_); kq_load(Rb, q0, c0 * 128 + 64 + s_, col_); }
            for (int item = bx; item < 2048; item += G) mlstm_out_item(a, L, item, item + G < 2048 ? item + G : item, Ra, Rb, h_loaded); }
        pg8::Gemm g{(const bf16*)(ws + OFF_UG), (const bf16*)(ws + OFF_S5M), 1152, 1152, 1152, nullptr, 0, 0}; S5YOrder S{G, bx};
        EpiS5Y E{(const bf16*)(ws + OFF_UG), a.in[I_DSKIP], (bf16*)(ws + OFF_YSG)};
        REP(19) pg8::gemm_phase<EpiS5Y, S5YOrder, true, true>(L, g, S, E);
    }
    SEAM(4);
    if (IN(5)) { GBX; REP(5) {
        pg8::Gemm g{(const bf16*)(ws + OFF_YSG), (const bf16*)(ws + OFF_WGLU), 512, 512, 512, nullptr, 0, 0}; pg8::StaticOrder S; S.init(T, 512, G, bx);
        EpiGlu E{(const bf16*)(ws + OFF_YSG), a.in[I_BGLU], (bf16*)(ws + OFF_H1)};
        pg8::gemm_phase<EpiGlu, pg8::StaticOrder, true, true>(L, g, S, E); }
    }
    SEAM(5);
    if (IN(6)) { GBX; REP(6) {
        pg8::Gemm g{(const bf16*)(ws + OFF_H1), (const bf16*)(ws + OFF_WOUT), 1024, 1024, 1024, nullptr, 0, 0}; pg8::StaticOrder S; S.init(T, 1024, G, bx);
        EpiOut E{(unsigned short*)(ws + OFF_MO), (unsigned char*)a.out + OUT_X1LO, a.in[I_X]};
        pg8::gemm_phase<EpiOut, pg8::StaticOrder, true, true>(L, g, S, E); }
    }
    SEAM(6);
    if (IN(7)) { GBX; REP(7) phase7(a, L, G); }
    SEAM(7);
    if (IN(8)) { GBX; REP(8) phase8(a, L, G); }
    SEAM(8);
#pragma unroll 1
    for (int hf = 0; hf < 2; ++hf) {
        const int pb = 9 + 2 * hf;
        if (IN(pb)) { GBX;
            const int ntile = ((const int*)(ws + OFF_NTILE))[hf];
            pg8::Gemm g{(const bf16*)(ws + OFF_H2), (const bf16*)(ws + OFF_WGU), 1024, 1024, 1024, (const int*)(ws + OFF_ROWMAP) + hf * RCAP, 0, 0}; MoeOrder S{(const int*)(ws + OFF_TILEE) + hf * 1024, ntile, 8, G, bx, (unsigned*)ws + 4096 + 512 * (2 * hf)};
            EpiMoeGU E{a.in[I_BGU], ws + OFF_R1, (const float*)(ws + OFF_RSTDS) + hf * RCAP};
#ifdef TOUCH_WGU
            touch_buffer(ws + OFF_WGU, (size_t)134217728, G);
#endif
            REP(pb) pg8::gemm_phase<EpiMoeGU, MoeOrder, true, true, true, true, false, true>(L, g, S, E);
        }
        if (IN(pb) && hf == 1) { GBX; combine_half(a, 0, ws + OFF_R2, G); PEND(pb); }
        SEAM(pb);
        if (IN(pb + 1)) { GBX;
            const int ntile = ((const int*)(ws + OFF_NTILE))[hf];
            pg8::Gemm g{(const bf16*)(ws + OFF_R1), (const bf16*)(ws + OFF_WDN), 1024, 1024, 1024, nullptr, 1, 1}; MoeOrder S{(const int*)(ws + OFF_TILEE) + hf * 1024, ntile, 4, G, bx, (unsigned*)ws + 4096 + 512 * (2 * hf + 1)};
            EpiMoeDN E{a.in[I_BDN], (const float*)(ws + OFF_RGATE) + hf * RCAP, ws + OFF_R2};
            REP(pb + 1) pg8::gemm_phase<EpiMoeDN, MoeOrder, true, true, false, true, true, true>(L, g, S, E);
        }
        SEAM(pb + 1);
    }
    if (IN(13)) { GBX; combine_half(a, 1, ws + OFF_R2, G); PEND(13); }
    if (PROBE_SECT && blockIdx.x == 0 && otid() == 0) { const unsigned long long t1_ = __builtin_amdgcn_s_memrealtime(), w_ = (unsigned long long)(*PROBE_LDS_WORD) * PROBE_SCALE; while (__builtin_amdgcn_s_memrealtime() - t1_ < w_) __builtin_amdgcn_s_sleep(8); }
#undef IN
#undef SEAM
#undef GBX
#undef PEND
#undef REP
}

extern "C" void kernel_launch(void* const* d_in, const int* in_sizes, int n_in, void* d_out, int out_size, void* d_ws, size_t ws_size, hipStream_t stream) {
    static int grid = 0;
    if (grid == 0) {
        if (n_in != 26 || out_size != T * DM || ws_size < WS_NEED) { fprintf(stderr, "kernel_launch: unexpected problem (n_in %d, out %d, ws %zu)\n", n_in, out_size, ws_size); grid = -1; return; }
        int dev = 0, cus = 0, per_cu = 0;
        (void)hipGetDevice(&dev); (void)hipDeviceGetAttribute(&cus, hipDeviceAttributeMultiprocessorCount, dev);
        if (hipFuncSetAttribute((const void*)mk_fwd, hipFuncAttributeMaxDynamicSharedMemorySize, LDS_BYTES) != hipSuccess) { fprintf(stderr, "kernel_launch: hipFuncSetAttribute failed\n"); grid = -1; return; }
        if (hipOccupancyMaxActiveBlocksPerMultiprocessor(&per_cu, (const void*)mk_fwd, 512, LDS_BYTES) != hipSuccess || per_cu < 1) { fprintf(stderr, "kernel_launch: occupancy query says %d\n", per_cu); per_cu = 1; }
        (void)hipGetLastError();
        grid = cus;
    }
    if (grid < 0) return;
    if (hipMemsetAsync(d_ws, 0, 32768, stream) != hipSuccess) { fprintf(stderr, "kernel_launch: memset failed\n"); return; }
    KArgs a{};
    for (int i = 0; i < 26; ++i) a.in[i] = (const float*)d_in[i];
    a.out = (float*)d_out; a.ws = (unsigned char*)d_ws;
#if MK_SINGLE
    a.ph_lo = 0; a.ph_hi = NPH;
    void* args[] = {&a};
    hipError_t e = hipLaunchCooperativeKernel((const void*)mk_fwd, dim3(grid), dim3(512), args, LDS_BYTES, stream);
    if (e != hipSuccess) fprintf(stderr, "cooperative launch failed: %s (grid %d)\n", hipGetErrorString(e), grid);
#else
    for (int p = 0; p < NPH; ++p) { a.ph_lo = p; a.ph_hi = p + 1; hipLaunchKernelGGL(mk_fwd, dim3(grid), dim3(512), LDS_BYTES, stream, a); }
#endif
}
```
